# Optimizing an MI355X kernel written in HIP

```python
import math
import jax, jax.numpy as jnp
from jax import lax
import numpy as np

D_MODEL = 1024
BATCH = 16
SEQ = 2048
DEPTH = 4

MIX_WIDTH = 2 * D_MODEL
SSD_WIDTH = MIX_WIDTH // 2
SSD_HEAD_DIM = 64
SSD_HEADS = SSD_WIDTH // SSD_HEAD_DIM
SSD_GROUPS = 2
SSD_HEADS_PER_GROUP = SSD_HEADS // SSD_GROUPS
SSD_STATE = 128
SSD_CONV = 4
SSD_CHUNK = 128
SSD_CONV_DIM = SSD_WIDTH + 2 * SSD_GROUPS * SSD_STATE
HGRN_WIDTH = MIX_WIDTH // 4
HGRN_HEAD_DIM = 128
HGRN_HEADS = HGRN_WIDTH // HGRN_HEAD_DIM
HGRN_CHUNK = 64
S5_WIDTH = MIX_WIDTH - SSD_WIDTH - HGRN_WIDTH
S5_GROUP_SIZE = 16
S5_GROUPS = S5_WIDTH // S5_GROUP_SIZE
S5_STATE = 64
S5_MIN_NEG = 1e-4

IN_COLS = SSD_WIDTH + SSD_CONV_DIM + SSD_HEADS + 4 * HGRN_WIDTH + 2 * S5_WIDTH
EPS = 1e-6

kernel_name = "hybrid_ssd_hgrn2_s5_parallel_heads"


def _in_proj_splits():
    widths = [SSD_WIDTH, SSD_CONV_DIM, SSD_HEADS, HGRN_WIDTH, HGRN_WIDTH,
              HGRN_WIDTH, HGRN_WIDTH, S5_WIDTH, S5_WIDTH]
    pts, acc = [], 0
    for w in widths[:-1]:
        acc += w
        pts.append(acc)
    return pts


def rms_norm(x, w):
    xf = x.astype(jnp.float32)
    y = xf * lax.rsqrt(jnp.mean(xf * xf, axis=-1, keepdims=True) + EPS)
    return (y * w.astype(jnp.float32)).astype(x.dtype)


def grouped_rms_norm(x, w, n_groups):
    shp = x.shape
    xf = x.astype(jnp.float32).reshape(shp[:-1] + (n_groups, shp[-1] // n_groups))
    y = xf * lax.rsqrt(jnp.mean(xf * xf, axis=-1, keepdims=True) + EPS)
    return (y.reshape(shp) * w.astype(jnp.float32)).astype(x.dtype)


def causal_depthwise_conv(x, w, b):
    out = lax.conv_general_dilated(
        x, w[:, None, :].astype(x.dtype), window_strides=(1,),
        padding=[(SSD_CONV - 1, 0)], dimension_numbers=("NWC", "WIO", "NWC"),
        feature_group_count=x.shape[-1])
    return out + b.astype(x.dtype)


def ssd_mixer(z, xbc, dt_raw, conv_w, conv_b, dt_bias, a_log, d_skip, norm_w):
    bsz, seqlen, _ = xbc.shape
    nc = seqlen // SSD_CHUNK
    G, R, P, N, T = SSD_GROUPS, SSD_HEADS_PER_GROUP, SSD_HEAD_DIM, SSD_STATE, SSD_CHUNK
    xbc = jax.nn.silu(causal_depthwise_conv(xbc, conv_w, conv_b))
    xs, b_in, c_in = jnp.split(xbc, [SSD_WIDTH, SSD_WIDTH + G * N], axis=-1)
    xs = xs.reshape(bsz, nc, T, G, R, P)
    b_in = b_in.reshape(bsz, nc, T, G, N)
    c_in = c_in.reshape(bsz, nc, T, G, N)
    dt = jax.nn.softplus(dt_raw.astype(jnp.float32) + dt_bias.astype(jnp.float32))
    dt = dt.reshape(bsz, nc, T, G, R)
    a = -jnp.exp(a_log.astype(jnp.float32)).reshape(G, R)
    a_cum = jnp.cumsum(dt * a, axis=2)
    mask = jnp.tril(jnp.ones((T, T), dtype=bool))[:, :, None, None]
    seg = a_cum[:, :, :, None] - a_cum[:, :, None, :]
    decay = jnp.exp(jnp.where(mask, seg, -jnp.inf))
    x_dt = xs * dt[..., None]
    scores = jnp.einsum("bclgn,bcsgn->bclsg", c_in, b_in)
    y_diag = jnp.einsum("bclsg,bclsgr,bcsgrp->bclgrp", scores, decay, x_dt)
    decay_to_end = jnp.exp(a_cum[:, :, -1:] - a_cum)
    chunk_states = jnp.einsum("bclgn,bclgr,bclgrp->bcgrpn", b_in, decay_to_end, x_dt)
    chunk_decay = jnp.exp(a_cum[:, :, -1])

    def step(h, inp):
        dec, st = inp
        return dec[..., None, None] * h + st, h

    h0 = jnp.zeros((bsz, G, R, P, N), chunk_states.dtype)
    _, prev = lax.scan(step, h0, (jnp.moveaxis(chunk_decay, 1, 0),
                                  jnp.moveaxis(chunk_states, 1, 0)))
    prev = jnp.moveaxis(prev, 0, 1)
    y_off = jnp.einsum("bclgn,bcgrpn,bclgr->bclgrp", c_in, prev, jnp.exp(a_cum))
    y = y_diag + y_off + d_skip.reshape(G, R)[:, :, None] * xs
    y = y.reshape(bsz, seqlen, SSD_WIDTH)
    return grouped_rms_norm(y * jax.nn.silu(z), norm_w, SSD_GROUPS)


def hgrn2_mixer(q, f_raw, i_in, g, lb, norm_w):
    bsz, seqlen, _ = q.shape
    nc = seqlen // HGRN_CHUNK
    H, Dh, T = HGRN_HEADS, HGRN_HEAD_DIM, HGRN_CHUNK
    q = jax.nn.silu(q)
    lbf = lb.astype(jnp.float32)
    log_f = jnp.logaddexp(jnp.log(lbf), jnp.log1p(-lbf) + jax.nn.log_sigmoid(f_raw.astype(jnp.float32)))
    k = -jnp.expm1(log_f)

    def to_chunks(t):
        return t.reshape(bsz, nc, T, H, Dh).transpose(1, 0, 3, 2, 4)

    mask = jnp.tril(jnp.ones((T, T), dtype=bool))[:, :, None]

    def step(state, inp):
        qc, kc, vc, lfc = inp
        cum = jnp.cumsum(lfc, axis=2)
        decay = jnp.exp(jnp.where(mask, cum[:, :, :, None, :] - cum[:, :, None, :, :], -jnp.inf))
        attn = jnp.einsum("bhlk,bhsk,bhlsk->bhls", qc, kc, decay)
        o = (jnp.einsum("bhls,bhsv->bhlv", attn, vc)
             + jnp.einsum("bhlk,bhkv->bhlv", qc * jnp.exp(cum), state))
        last = cum[:, :, -1:, :]
        state = (jnp.exp(last[:, :, 0, :])[..., None] * state
                 + jnp.einsum("bhsk,bhsv->bhkv", kc * jnp.exp(last - cum), vc))
        return state, o

    state0 = jnp.zeros((bsz, H, Dh, Dh), jnp.float32)
    _, o = lax.scan(step, state0, (to_chunks(q), to_chunks(k), to_chunks(i_in), to_chunks(log_f)))
    o = o.transpose(1, 0, 3, 2, 4).reshape(bsz, seqlen, HGRN_WIDTH)
    return grouped_rms_norm(o, norm_w, HGRN_HEADS) * jax.nn.silu(g)


def s5_mixer(u, gate, lam_re, lam_im, log_step, b_re, b_im, c_re, c_im, d_skip, glu_w, glu_b, norm_w):
    bsz, seqlen, _ = u.shape
    G, P, Hg = S5_GROUPS, S5_STATE, S5_GROUP_SIZE
    uf = u.astype(jnp.float32)
    lr = jnp.minimum(lam_re.astype(jnp.float32), -S5_MIN_NEG)
    li = lam_im.astype(jnp.float32)
    step = jnp.exp(log_step.astype(jnp.float32))[:, None]
    mag = jnp.exp(lr * step)
    ang = li * step
    ab_re, ab_im = mag * jnp.cos(ang), mag * jnp.sin(ang)
    den = lr * lr + li * li
    num_re, num_im = ab_re - 1.0, ab_im
    co_re = (num_re * lr + num_im * li) / den
    co_im = (num_im * lr - num_re * li) / den
    bb_re = co_re[..., None] * b_re - co_im[..., None] * b_im
    bb_im = co_re[..., None] * b_im + co_im[..., None] * b_re
    ug = uf.reshape(bsz, seqlen, G, Hg)
    bu_re = jnp.einsum("blgh,gph->lbgp", ug, bb_re)
    bu_im = jnp.einsum("blgh,gph->lbgp", ug, bb_im)
    a_re = jnp.broadcast_to(ab_re, (seqlen, 1, G, P))
    a_im = jnp.broadcast_to(ab_im, (seqlen, 1, G, P))

    def combine(e_i, e_j):
        ar_i, ai_i, br_i, bi_i = e_i
        ar_j, ai_j, br_j, bi_j = e_j
        return (ar_j * ar_i - ai_j * ai_i,
                ar_j * ai_i + ai_j * ar_i,
                ar_j * br_i - ai_j * bi_i + br_j,
                ar_j * bi_i + ai_j * br_i + bi_j)

    _, _, s_re, s_im = lax.associative_scan(combine, (a_re, a_im, bu_re, bu_im), axis=0)
    y = jnp.einsum("lbgp,ghp->blgh", s_re, c_re) - jnp.einsum("lbgp,ghp->blgh", s_im, c_im)
    y = y.reshape(bsz, seqlen, S5_WIDTH) + d_skip * uf
    y = jax.nn.gelu(y)
    hg = y @ glu_w + glu_b
    val, gt = jnp.split(hg, 2, axis=-1)
    y = val * jax.nn.sigmoid(gt) * jax.nn.silu(gate)
    return rms_norm(y, norm_w)


def setup_inputs(seed: int = 0) -> dict:
    key = jax.random.key(seed)
    ks = jax.random.split(key, 24)
    f32 = jnp.float32
    nrm = lambda k, shp, s: s * jax.random.normal(k, shp, f32)
    dt0 = jnp.exp(jax.random.uniform(ks[6], (DEPTH, SSD_HEADS), f32, math.log(1e-3), math.log(1e-1)))
    lam_im0 = math.pi * jnp.arange(S5_STATE, dtype=f32)
    return {
        "x": jax.random.normal(ks[0], (BATCH, SEQ, D_MODEL), f32),
        "pre_norm_w": 1.0 + nrm(ks[1], (DEPTH, D_MODEL), 0.02),
        "post_norm_w": 1.0 + nrm(ks[2], (DEPTH, D_MODEL), 0.02),
        "w_in": nrm(ks[3], (DEPTH, D_MODEL, IN_COLS), D_MODEL ** -0.5),
        "w_out": nrm(ks[4], (DEPTH, MIX_WIDTH, D_MODEL), MIX_WIDTH ** -0.5),
        "ssd_conv_w": nrm(ks[5], (DEPTH, SSD_CONV, SSD_CONV_DIM), SSD_CONV ** -0.5),
        "ssd_conv_b": nrm(ks[7], (DEPTH, SSD_CONV_DIM), 0.02),
        "ssd_dt_bias": dt0 + jnp.log(-jnp.expm1(-dt0)),
        "ssd_a_log": jnp.log(jax.random.uniform(ks[8], (DEPTH, SSD_HEADS), f32, 1.0, 16.0)),
        "ssd_d": 1.0 + nrm(ks[9], (DEPTH, SSD_HEADS), 0.02),
        "ssd_norm_w": 1.0 + nrm(ks[10], (DEPTH, SSD_WIDTH), 0.02),
        "hgrn_lower_bounds": nrm(ks[11], (DEPTH, HGRN_WIDTH), 0.1),
        "hgrn_norm_w": 1.0 + nrm(ks[12], (DEPTH, HGRN_WIDTH), 0.02),
        "s5_lambda_re": -0.5 + nrm(ks[13], (DEPTH, S5_GROUPS, S5_STATE), 0.01),
        "s5_lambda_im": lam_im0 + nrm(ks[14], (DEPTH, S5_GROUPS, S5_STATE), 0.01),
        "s5_log_step": jax.random.uniform(ks[15], (DEPTH, S5_GROUPS), f32, math.log(1e-3), math.log(1e-1)),
        "s5_b_re": nrm(ks[16], (DEPTH, S5_GROUPS, S5_STATE, S5_GROUP_SIZE), (2 * S5_GROUP_SIZE) ** -0.5),
        "s5_b_im": nrm(ks[17], (DEPTH, S5_GROUPS, S5_STATE, S5_GROUP_SIZE), (2 * S5_GROUP_SIZE) ** -0.5),
        "s5_c_re": nrm(ks[18], (DEPTH, S5_GROUPS, S5_GROUP_SIZE, S5_STATE), S5_STATE ** -0.5),
        "s5_c_im": nrm(ks[19], (DEPTH, S5_GROUPS, S5_GROUP_SIZE, S5_STATE), S5_STATE ** -0.5),
        "s5_d": jax.random.normal(ks[20], (DEPTH, S5_WIDTH), f32),
        "s5_glu_w": nrm(ks[21], (DEPTH, S5_WIDTH, 2 * S5_WIDTH), S5_WIDTH ** -0.5),
        "s5_glu_b": nrm(ks[22], (DEPTH, 2 * S5_WIDTH), 0.02),
        "s5_norm_w": 1.0 + nrm(ks[23], (DEPTH, S5_WIDTH), 0.02),
    }


def reference(x, pre_norm_w, post_norm_w, w_in, w_out, ssd_conv_w, ssd_conv_b, ssd_dt_bias,
              ssd_a_log, ssd_d, ssd_norm_w, hgrn_lower_bounds, hgrn_norm_w, s5_lambda_re,
              s5_lambda_im, s5_log_step, s5_b_re, s5_b_im, s5_c_re, s5_c_im, s5_d, s5_glu_w,
              s5_glu_b, s5_norm_w):
    lb_all = jnp.cumsum(jax.nn.softmax(hgrn_lower_bounds.astype(jnp.float32), axis=0), axis=0)
    lb_all = lb_all - lb_all[0:1]
    splits = _in_proj_splits()
    for l in range(DEPTH):
        h = rms_norm(x, pre_norm_w[l])
        proj = h @ w_in[l]
        z, xbc, dt_raw, q, f_raw, i_in, g, u, s5_gate = jnp.split(proj, splits, axis=-1)
        y_ssd = ssd_mixer(z, xbc, dt_raw, ssd_conv_w[l], ssd_conv_b[l], ssd_dt_bias[l],
                          ssd_a_log[l], ssd_d[l], ssd_norm_w[l])
        y_hgrn = hgrn2_mixer(q, f_raw, i_in, g, lb_all[l], hgrn_norm_w[l])
        y_s5 = s5_mixer(u, s5_gate, s5_lambda_re[l], s5_lambda_im[l], s5_log_step[l],
                        s5_b_re[l], s5_b_im[l], s5_c_re[l], s5_c_im[l], s5_d[l],
                        s5_glu_w[l], s5_glu_b[l], s5_norm_w[l])
        mix = jnp.concatenate([y_ssd, y_hgrn, y_s5], axis=-1).astype(x.dtype)
        x = x + rms_norm(mix @ w_out[l], post_norm_w[l])
    return x
```

```cpp
#include <hip/hip_runtime.h>
#include <hip/hip_cooperative_groups.h>
#include <cstdio>
namespace cg = cooperative_groups;
__device__ __forceinline__ int lt_tid() { int t = threadIdx.x; asm volatile("" : "+v"(t)); return t; }
__device__ __forceinline__ int lt_bid() { int t = blockIdx.x; asm volatile("" : "+s"(t)); return t; }
namespace pg8 {
#define PG8_LAS __attribute__((address_space(3)))
typedef unsigned short bf16_t;
typedef short bf16x8 __attribute__((ext_vector_type(8)));
typedef float f32x4 __attribute__((ext_vector_type(4)));
typedef unsigned u32x4 __attribute__((ext_vector_type(4)));
constexpr int BM = 256, BK = 64, HALF = 128, HTB = HALF * BK * 2  , STAGE_BYTES = 8 * HTB, NXCD = 8, WGM = 8;

__host__ __device__ __forceinline__ int lds_byte(int r, int c) { const int st = (r >> 4) * 2 + (c >> 5), rr = r & 15, cc = c & 31, ob = rr * 64 + cc * 2; return st * 1024 + (ob ^ (((ob >> 9) & 1) << 5)); }
__host__ __device__ __forceinline__ void stage_rc(int b, int& R, int& C) { const int st = b / 1024, sb = b % 1024, swz = sb ^ (((sb >> 9) & 1) << 5); R = (st >> 1) * 16 + swz / 64; C = (st & 1) * 32 + (swz % 64) / 2; }
__host__ __device__ __forceinline__ int perm32(int rho) { const int n = rho >> 4, i = rho & 15; return 8 * (i >> 2) + 4 * n + (i & 3); }

struct Unit { int pm, pn; };
struct Gemm { const bf16_t* A; const bf16_t* Bt; int M, N, K, lda; };

struct StaticOrder {
    int nM, nN, nwg, G, c;
    __host__ __device__ void init(int M, int N, int G_, int c_) { nM = M / BM; nN = N / BM; nwg = nM * nN; G = G_; c = c_; }
    __host__ __device__ bool next(int i, Unit& u) const {
        const long L = (long)i * G + c; if (L >= nwg) return false;
        int wgid = (int)L; { const int q = nwg / NXCD, r = nwg % NXCD, xcd = wgid % NXCD, off = wgid / NXCD; wgid = (xcd < r ? xcd * (q + 1) : r * (q + 1) + (xcd - r) * q) + off; }
        const int nig = WGM * nN, gid = wgid / nig, fm = gid * WGM, gsz = (nM - fm) < WGM ? (nM - fm) : WGM;
        u.pm = fm + ((wgid % nig) % gsz); u.pn = (wgid % nig) / gsz; return true;
    }
    __device__ __forceinline__ void a_ready(const Unit&) const {}
    __device__ __forceinline__ void done(const Unit&) const {}
};

__device__ __forceinline__ unsigned cvt_pk_bf16(float lo, float hi) { unsigned r; asm volatile("v_cvt_pk_bf16_f32 %0, %1, %2" : "=v"(r) : "v"(lo), "v"(hi)); return r; }
template <class Epi, class Sched, bool STAMP = false>
__device__ __forceinline__ void gemm_phase(PG8_LAS unsigned char* lds, const Gemm g, const Sched& S, const Epi& E, unsigned long long* stamps) {
    const int tid = lt_tid(), wid = __builtin_amdgcn_readfirstlane(tid >> 6), lane = tid & 63, wr = wid >> 2, wc = wid & 3, fr = lane & 15, fq = lane >> 4;
    const int K = g.K, nt = K / BK;
    int ts_lo = 0, ts_hi = 0, nts = 0; const unsigned long long rt_entry = STAMP ? (unsigned long long)wall_clock64() : 0ull;
#define PG8_STAMP() do { if (STAMP && wid == 0 && nts < 64) { const unsigned long long _c = (unsigned long long)clock64(); \
        ts_lo = (lane == nts) ? (int)(unsigned)_c : ts_lo; ts_hi = (lane == nts) ? (int)(unsigned)(_c >> 32) : ts_hi; ++nts; } } while (0)
    PG8_STAMP();
    unsigned voffA[2], voffB[2];
#pragma unroll
    for (int i = 0; i < 2; ++i) { int R, C; stage_rc(tid * 16 + i * 8192, R, C); const int Rb = Epi::PERM ? ((R & ~31) + perm32(R & 31)) : R;
        voffA[i] = (unsigned)(R * g.lda + C) * 2u; voffB[i] = (unsigned)(Rb * K + C) * 2u; }
    const size_t kstep = (size_t)(BK * 2);
    const size_t hstep = (size_t)HALF * K * 2;
    const size_t tstep = 2 * hstep; const size_t hstepA = (size_t)HALF * g.lda * 2; const size_t tstepA = 2 * hstepA;
    const unsigned ldsw = (unsigned)wid * 1024u;
    const int aoff = lds_byte(wr * 64 + fr, fq * 8), boff = lds_byte(wc * 32 + fr, fq * 8);
#define PG8_SA(b, h) (((b) * 2 + (h)) * HTB)
#define PG8_SB(b, h) ((4 + (b) * 2 + (h)) * HTB)
#define PG8_STAGE(bufoff, gbase, voff) do { _Pragma("unroll") for (int _i = 0; _i < 2; ++_i) \
        __builtin_amdgcn_global_load_lds((const unsigned*)((const char*)(gbase) + (voff)[_i]), (PG8_LAS unsigned*)(lds + (bufoff) + ldsw + _i * 8192), 16, 0, 0); } while (0)
#define PG8_LDA(dst, b, h) do { _Pragma("unroll") for (int m = 0; m < 4; ++m) _Pragma("unroll") for (int k = 0; k < 2; ++k) dst[m][k] = *(const PG8_LAS bf16x8*)(lds + PG8_SA(b, h) + aoff + m * 2048 + k * 1024); } while (0)
#define PG8_LDB(dst, b, h) do { _Pragma("unroll") for (int n = 0; n < 2; ++n) _Pragma("unroll") for (int k = 0; k < 2; ++k) dst[n][k] = *(const PG8_LAS bf16x8*)(lds + PG8_SB(b, h) + boff + n * 2048 + k * 1024); } while (0)
#define PG8_MMA(ai, bj, At, Bt) do { __builtin_amdgcn_s_setprio(1); _Pragma("unroll") for (int m = 0; m < 4; ++m) _Pragma("unroll") for (int n = 0; n < 2; ++n) _Pragma("unroll") for (int k = 0; k < 2; ++k) \
        acc[ai][bj][m][n] = __builtin_amdgcn_mfma_f32_16x16x32_bf16(Bt[n][k], At[m][k], acc[ai][bj][m][n], 0, 0, 0); __builtin_amdgcn_s_setprio(0); } while (0)
#define PG8_WAIT_V(n) asm volatile("s_waitcnt vmcnt(" #n ")" ::: "memory")
#define PG8_WAIT_L(n) asm volatile("s_waitcnt lgkmcnt(" #n ")" ::: "memory")
#define PG8_BAR __builtin_amdgcn_s_barrier()
#define PG8_SCHED __builtin_amdgcn_sched_barrier(0)
    Unit cur, nxt; int ui = 0;
    if (!S.next(0, cur)) return;
    f32x4 acc[2][2][4][2];
#pragma unroll
    for (int a = 0; a < 2; ++a)
#pragma unroll
        for (int b = 0; b < 2; ++b)
#pragma unroll
            for (int m = 0; m < 4; ++m)
#pragma unroll
                for (int n = 0; n < 2; ++n) acc[a][b][m][n] = (f32x4){0.f, 0.f, 0.f, 0.f};
    bf16x8 At[4][2], B0[2][2], B1[2][2];
    const char* cA = (const char*)g.A + (size_t)cur.pm * tstepA; const char* cB = (const char*)g.Bt + (size_t)cur.pn * tstep;
    S.a_ready(cur);
    PG8_STAGE(PG8_SB(0, 0), cB, voffB); PG8_STAGE(PG8_SA(0, 0), cA, voffA); PG8_STAGE(PG8_SB(0, 1), cB + hstep, voffB); PG8_STAGE(PG8_SA(0, 1), cA + hstepA, voffA);
    if (wr == 1) PG8_BAR;
    PG8_WAIT_V(4); PG8_BAR;
    PG8_STAGE(PG8_SB(1, 0), cB + kstep, voffB); PG8_STAGE(PG8_SA(1, 0), cA + kstep, voffA); PG8_STAGE(PG8_SB(1, 1), cB + hstep + kstep, voffB);
    PG8_WAIT_V(6); PG8_BAR;
    PG8_STAMP();
    for (;;) {
        const bool has_next = S.next(ui + 1, nxt);
        const char* nA = has_next ? (const char*)g.A + (size_t)nxt.pm * tstepA : cA; const char* nB = has_next ? (const char*)g.Bt + (size_t)nxt.pn * tstep : cB;
        for (int t = 0; t < nt; t += 2) {
            const bool last = (t == nt - 2);
            const char* a1 = cA + (size_t)(t + 1) * kstep;
            const char* a2 = last ? nA : cA + (size_t)(t + 2) * kstep; const char* b2 = last ? nB : cB + (size_t)(t + 2) * kstep;
            const char* a3 = a2 + kstep; const char* b3 = b2 + kstep;
            if (last && has_next) S.a_ready(nxt);
            PG8_LDB(B0, 0, 0); PG8_SCHED; PG8_LDA(At, 0, 0); PG8_STAGE(PG8_SA(1, 1), a1 + hstepA, voffA);
            PG8_WAIT_L(8); PG8_BAR; PG8_WAIT_L(0); PG8_MMA(0, 0, At, B0); PG8_BAR; PG8_SCHED;
            PG8_LDB(B1, 0, 1); PG8_STAGE(PG8_SB(0, 0), b2, voffB);
            PG8_BAR; PG8_WAIT_L(0); PG8_MMA(0, 1, At, B1); PG8_BAR;
            PG8_LDA(At, 0, 1); PG8_STAGE(PG8_SA(0, 0), a2, voffA);
            PG8_BAR; PG8_WAIT_L(0); PG8_MMA(1, 0, At, B0); PG8_BAR; PG8_SCHED;
            PG8_STAGE(PG8_SB(0, 1), b2 + hstep, voffB);
            PG8_WAIT_V(6); PG8_BAR; PG8_MMA(1, 1, At, B1); PG8_BAR;
            PG8_LDB(B0, 1, 0); PG8_SCHED; PG8_LDA(At, 1, 0); PG8_STAGE(PG8_SA(0, 1), a2 + hstepA, voffA);
            PG8_WAIT_L(8); PG8_BAR; PG8_WAIT_L(0); PG8_MMA(0, 0, At, B0); PG8_BAR; PG8_SCHED;
            PG8_LDB(B1, 1, 1); PG8_STAGE(PG8_SB(1, 0), b3, voffB);
            PG8_BAR; PG8_WAIT_L(0); PG8_MMA(0, 1, At, B1); PG8_BAR;
            PG8_LDA(At, 1, 1); PG8_STAGE(PG8_SA(1, 0), a3, voffA);
            PG8_BAR; PG8_WAIT_L(0); PG8_MMA(1, 0, At, B0); PG8_BAR; PG8_SCHED;
            PG8_STAGE(PG8_SB(1, 1), b3 + hstep, voffB);
            PG8_WAIT_V(6); PG8_BAR; PG8_MMA(1, 1, At, B1); PG8_BAR;
        }
        PG8_STAMP();
        if constexpr (!Epi::AFTER_DRAIN) { E(acc, cur, wr, wc, fr, fq); S.done(cur); }
        PG8_STAMP();
        if (!has_next) break;
#pragma unroll
        for (int a = 0; a < 2; ++a)
#pragma unroll
            for (int b = 0; b < 2; ++b)
#pragma unroll
                for (int m = 0; m < 4; ++m)
#pragma unroll
                    for (int n = 0; n < 2; ++n) acc[a][b][m][n] = (f32x4){0.f, 0.f, 0.f, 0.f};
        cur = nxt; cA = nA; cB = nB; ++ui;
    }
    PG8_WAIT_V(0);
    if (wr == 0) PG8_BAR;
    PG8_BAR;
    if constexpr (Epi::AFTER_DRAIN) { E.fused(acc, cur, wr, wc, fr, fq, lds, wid, lane); S.done(cur); }
    PG8_STAMP();
    if (STAMP && wid == 0) { stamps[lane] = lane < nts ? (((unsigned long long)(unsigned)ts_hi << 32) | (unsigned)ts_lo) : 0ull;
        if (lane == 62) stamps[62] = rt_entry; if (lane == 63) stamps[63] = (unsigned long long)wall_clock64(); }
#undef PG8_STAMP
#undef PG8_SA
#undef PG8_SB
#undef PG8_STAGE
#undef PG8_LDA
#undef PG8_LDB
#undef PG8_MMA
#undef PG8_WAIT_V
#undef PG8_WAIT_L
#undef PG8_BAR
#undef PG8_SCHED
}
}

using pg8::bf16_t; using pg8::bf16x8; using pg8::f32x4;
constexpr int NTOK = 32768, SEQL = 2048, DM = 1024, LDP = 5632, INC = 5648;
constexpr int C_Z = 0, C_G = 1024, C_SG = 1536, C_XBC = 2048, C_Q = 3584, C_F = 4096, C_I = 4608, C_U = 5120, C_O = 2048;
constexpr float EPSN = 1e-6f;

struct Params {
    const float *x, *pre_w, *post_w, *w_in, *w_out, *conv_w, *conv_b, *dt_bias, *a_log, *ssd_d, *ssd_nw, *hg_lb, *hg_nw,
        *lam_re, *lam_im, *log_step, *b_re, *b_im, *c_re, *c_im, *s5_d, *glu_w, *glu_b, *s5_nw;
    float* out;
    bf16_t *proj, *xb, *winT, *woutT, *wgluT, *ktab, *woff, *wst;
    float *wdt, *aT, *lb, *rstd, *dtraw, *ss_ssd, *ss_hg, *ss_s5;
};

#define CPAR const __attribute__((address_space(4))) Params&
#define GETP() ({ const __attribute__((address_space(4))) Params* _pp = (const __attribute__((address_space(4))) Params*)__builtin_amdgcn_kernarg_segment_ptr(); asm volatile("" : "+s"(_pp)); _pp; })
__device__ __forceinline__ unsigned f2bf(float f) { unsigned u = __float_as_uint(f); u += 0x7FFFu + ((u >> 16) & 1u); return u >> 16; }
__device__ __forceinline__ float bf2f(unsigned b) { return __uint_as_float(b << 16); }
__device__ __forceinline__ float bflo(unsigned w) { return __uint_as_float(w << 16); }
__device__ __forceinline__ float bfhi(unsigned w) { return __uint_as_float(w & 0xffff0000u); }
__device__ __forceinline__ unsigned pk2(float a, float b) { return f2bf(a) | (f2bf(b) << 16); }
__device__ __forceinline__ float sigmoidf_(float v) { return 1.f / (1.f + __expf(-v)); }
__device__ __forceinline__ float siluf_(float v) { return v / (1.f + __expf(-v)); }
__device__ __forceinline__ float wave_sum(float v) {
#pragma unroll
    for (int o = 32; o >= 1; o >>= 1) v += __shfl_xor(v, o);
    return v;
}
__device__ __forceinline__ f32x4 mma_lds(const bf16_t* A, int lda, const bf16_t* Bt, int ldb, int K, f32x4 acc, int lane) {
    const bf16_t* ap = A + (lane & 15) * lda + (lane >> 4) * 8;
    const bf16_t* bp = Bt + (lane & 15) * ldb + (lane >> 4) * 8;
#pragma unroll 4
    for (int k0 = 0; k0 < K; k0 += 32) {
        bf16x8 a = *(const bf16x8*)(ap + k0), b = *(const bf16x8*)(bp + k0);
        acc = __builtin_amdgcn_mfma_f32_16x16x32_bf16(a, b, acc, 0, 0, 0);
    }
    return acc;
}

struct EpiIn {
    static constexpr bool PERM = false, AFTER_DRAIN = false;
    bf16_t* O; const float* rstd;
    __device__ __forceinline__ void operator()(const f32x4 (&acc)[2][2][4][2], const pg8::Unit& u, int wr, int wc, int fr, int fq) const {
        const int row0 = u.pm * 256 + wr * 64 + fr, col0 = u.pn * 256 + wc * 32 + 4 * fq;
#pragma unroll
        for (int ai = 0; ai < 2; ++ai)
#pragma unroll
            for (int m = 0; m < 4; ++m) { const int row = row0 + ai * 128 + m * 16; const float rs = rstd[row]; bf16_t* rowp = O + (size_t)row * LDP + col0;
#pragma unroll
                for (int bj = 0; bj < 2; ++bj)
#pragma unroll
                    for (int n = 0; n < 2; ++n) { const f32x4 v = acc[ai][bj][m][n] * rs; uint2 w; w.x = pk2(v[0], v[1]); w.y = pk2(v[2], v[3]); *(uint2*)(rowp + bj * 128 + n * 16) = w; } }
    }
};
struct EpiOut {
    static constexpr bool PERM = false, AFTER_DRAIN = false;
    bf16_t* O;
    __device__ __forceinline__ void operator()(const f32x4 (&acc)[2][2][4][2], const pg8::Unit& u, int wr, int wc, int fr, int fq) const {
        const int row0 = u.pm * 256 + wr * 64 + fr, col0 = u.pn * 256 + wc * 32 + 4 * fq;
#pragma unroll
        for (int ai = 0; ai < 2; ++ai)
#pragma unroll
            for (int m = 0; m < 4; ++m) { const int row = row0 + ai * 128 + m * 16; bf16_t* rowp = O + (size_t)row * LDP + C_O + col0;
#pragma unroll
                for (int bj = 0; bj < 2; ++bj)
#pragma unroll
                    for (int n = 0; n < 2; ++n) { const f32x4 v = acc[ai][bj][m][n]; uint2 w; w.x = pk2(v[0], v[1]); w.y = pk2(v[2], v[3]); *(uint2*)(rowp + bj * 128 + n * 16) = w; } }
    }
};
struct EpiGlu {
    static constexpr bool PERM = false, AFTER_DRAIN = false;
    bf16_t* P; const float* bias; float* ss;
    __device__ __forceinline__ void operator()(const f32x4 (&acc)[2][2][4][2], const pg8::Unit& u, int wr, int wc, int fr, int fq) const {
        const int row0 = u.pm * 256 + wr * 64 + fr, c0 = u.pn * 128 + wc * 32 + 4 * fq;
        f32x4 bv[2], bg[2];
#pragma unroll
        for (int n = 0; n < 2; ++n) { bv[n] = *(const f32x4*)(bias + c0 + n * 16); bg[n] = *(const f32x4*)(bias + 512 + c0 + n * 16); }
#pragma unroll
        for (int ai = 0; ai < 2; ++ai)
#pragma unroll
            for (int m = 0; m < 4; ++m) { const int row = row0 + ai * 128 + m * 16; bf16_t* rowp = P + (size_t)row * LDP + C_SG + c0; float sq = 0.f;
#pragma unroll
                for (int n = 0; n < 2; ++n) { const f32x4 val = acc[ai][0][m][n] + bv[n], gt = acc[ai][1][m][n] + bg[n]; const uint2 gw = *(const uint2*)(rowp + n * 16);
                    float g[4] = {bflo(gw.x), bfhi(gw.x), bflo(gw.y), bfhi(gw.y)}; float y[4];
#pragma unroll
                    for (int j = 0; j < 4; ++j) { y[j] = val[j] * sigmoidf_(gt[j]) * siluf_(g[j]); sq += y[j] * y[j]; }
                    uint2 w; w.x = pk2(y[0], y[1]); w.y = pk2(y[2], y[3]); *(uint2*)(rowp + n * 16) = w; }
                sq += __shfl_xor(sq, 16); sq += __shfl_xor(sq, 32);
                if (fq == 0) ss[(size_t)row * 16 + u.pn * 4 + wc] = sq; }
    }
};

__device__ __forceinline__ int src_col(int n) {
    if (n < 1024) return n; if (n < 1536) return 4112 + (n - 1024); if (n < 2048) return 5136 + (n - 1536); if (n < 3584) return 1024 + (n - 2048);
    if (n < 4096) return 2576 + (n - 3584); if (n < 4608) return 3088 + (n - 4096); if (n < 5120) return 3600 + (n - 4608); return 4624 + (n - 5120);
}
__device__ void tr_tile(const float* src, int lds_, int col0, int k0, const float* sc, bf16_t* dst, int ldd, int row0, float* tile) {
    const int tid = lt_tid();
#pragma unroll
    for (int i = 0; i < 8; ++i) { const int idx = tid + i * 512, k = idx >> 6, n = idx & 63; float v = src[(size_t)(k0 + k) * lds_ + col0 + n]; if (sc) v *= sc[k0 + k]; tile[k * 65 + n] = v; }
    __syncthreads();
#pragma unroll
    for (int i = 0; i < 4; ++i) { const int idx = tid + i * 512, n = idx >> 5, k2 = idx & 31; const float a = tile[(2 * k2) * 65 + n], b = tile[(2 * k2 + 1) * 65 + n];
        *(unsigned*)(dst + (size_t)(row0 + n) * ldd + k0 + 2 * k2) = pk2(a, b); }
    __syncthreads();
}

__device__ void s5_tables(CPAR p, int l, int g, unsigned char* shm) {
    float* apre = (float*)shm;
    float* apim = apre + 33 * 64;
    float* bbre = apim + 33 * 64;
    float* bbim = bbre + 1024;
    float* core = bbim + 1024;
    float* coim = core + 64;
    const int tid = lt_tid();
    if (tid < 64) {
        const int pp = tid; const int gi = (l * 32 + g) * 64 + pp;
        const double lr = fmin((double)p.lam_re[gi], -1e-4), li = (double)p.lam_im[gi], st = exp((double)p.log_step[l * 32 + g]);
        for (int j = 0; j <= 32; ++j) {
            const double mag = exp(lr * st * j); double ang = li * st * j; ang -= 6.283185307179586476925 * rint(ang / 6.283185307179586476925);
            const float af = (float)ang; apre[j * 64 + pp] = (float)mag * cosf(af); apim[j * 64 + pp] = (float)mag * sinf(af);
        }
        const double are = (double)apre[64 + pp], aim = (double)apim[64 + pp];
        const double den = lr * lr + li * li, nre = are - 1.0, nim = aim;
        core[pp] = (float)((nre * lr + nim * li) / den); coim[pp] = (float)((nim * lr - nre * li) / den);
        p.aT[(g * 64 + pp) * 2 + 0] = apre[32 * 64 + pp]; p.aT[(g * 64 + pp) * 2 + 1] = apim[32 * 64 + pp];
    }
    __syncthreads();
    for (int i = tid; i < 1024; i += 512) { const int pp = i >> 4; const size_t gi = ((size_t)(l * 32 + g) * 64) * 16 + i;
        const float br = p.b_re[gi], bi = p.b_im[gi]; bbre[i] = core[pp] * br - coim[pp] * bi; bbim[i] = core[pp] * bi + coim[pp] * br; }
    __syncthreads();
    const float* cre = p.c_re + (size_t)(l * 32 + g) * 1024;
    const float* cim = p.c_im + (size_t)(l * 32 + g) * 1024;
    bf16_t* kt = p.ktab + (size_t)g * 8192;
    for (int e = tid; e < 8192; e += 512) { const int lag = e >> 8, h = (e >> 4) & 15, h2 = e & 15; float s = 0.f;
        for (int pp = 0; pp < 64; ++pp) { const float cr = cre[h * 64 + pp], ci = cim[h * 64 + pp], ar = apre[lag * 64 + pp], ai = apim[lag * 64 + pp];
            const float car = cr * ar - ci * ai, cai = cr * ai + ci * ar; s += car * bbre[pp * 16 + h2] - cai * bbim[pp * 16 + h2]; }
        kt[e] = (bf16_t)f2bf(s); }
    bf16_t* wo = p.woff + (size_t)g * 65536;
    for (int e = tid; e < 65536; e += 512) { const int row = e >> 7, k = e & 127, t = row >> 4, h = row & 15, pp = k & 63;
        const float cr = cre[h * 64 + pp], ci = cim[h * 64 + pp], ar = apre[(t + 1) * 64 + pp], ai = apim[(t + 1) * 64 + pp];
        const float v = (k < 64) ? (cr * ar - ci * ai) : -(cr * ai + ci * ar); wo[e] = (bf16_t)f2bf(v); }
    bf16_t* ws = p.wst + (size_t)g * 65536;
    for (int e = tid; e < 65536; e += 512) { const int m = e >> 9, k = e & 511, s = k >> 4, h2 = k & 15, pp = m & 63;
        const float ar = apre[(31 - s) * 64 + pp], ai = apim[(31 - s) * 64 + pp], br = bbre[pp * 16 + h2], bi = bbim[pp * 16 + h2];
        const float v = (m < 64) ? (ar * br - ai * bi) : (ar * bi + ai * br); ws[e] = (bf16_t)f2bf(v); }
    __syncthreads();
}

__device__ void phase_prep(CPAR p, int l, unsigned char* shm) {
    const int tid = lt_tid(), lane = tid & 63, wv = tid >> 6;
    const int G = gridDim.x, bid = lt_bid();
    if (l < 4) {
        float* tile = (float*)shm;
        for (int t = bid; t < 2048; t += G) {
            if (t < 1408) { const int nt = t >> 4, kt = t & 15; tr_tile(p.w_in + (size_t)l * DM * INC, INC, src_col(nt * 64), kt * 64, p.pre_w + l * DM, p.winT, DM, nt * 64, tile); }
            else if (t < 1920) { const int u = t - 1408, nt = u >> 5, kt = u & 31, k0 = kt * 64;
                const float* sc = (k0 < 1024) ? (p.ssd_nw + l * 1024) : (k0 < 1536) ? (p.hg_nw + l * 512 - 1024) : (p.s5_nw + l * 512 - 1536);
                tr_tile(p.w_out + (size_t)l * 2048 * DM, DM, nt * 64, k0, sc, p.woutT, 2048, nt * 64, tile); }
            else { const int u = t - 1920, nt = u >> 3, kt = u & 7, row0 = nt * 64, pn = row0 >> 8, half = (row0 >> 7) & 1, j0 = row0 & 127;
                tr_tile(p.glu_w + (size_t)l * 512 * 1024, 1024, half * 512 + pn * 128 + j0, kt * 64, nullptr, p.wgluT, 512, row0, tile); }
        }
        for (int g = bid; g < 32; g += G) s5_tables(p, l, g, shm);
        if (l == 0 && bid == G - 1) {
            const float a0 = p.hg_lb[tid], a1 = p.hg_lb[512 + tid], a2 = p.hg_lb[1024 + tid], a3 = p.hg_lb[1536 + tid];
            const float mx = fmaxf(fmaxf(a0, a1), fmaxf(a2, a3)); const float e0 = expf(a0 - mx), e1 = expf(a1 - mx), e2 = expf(a2 - mx), e3 = expf(a3 - mx), inv = 1.f / (e0 + e1 + e2 + e3);
            p.lb[tid] = 0.f; p.lb[512 + tid] = e1 * inv; p.lb[1024 + tid] = (e1 + e2) * inv; p.lb[1536 + tid] = (e1 + e2 + e3) * inv;
        }
    }
    __syncthreads();
    const float* xin = (l <= 1) ? p.x : p.out;
    for (int row = bid * 8 + wv; row < NTOK; row += G * 8) {
        float xv[16];
#pragma unroll
        for (int i = 0; i < 4; ++i) { const float4 v = *(const float4*)(xin + (size_t)row * DM + i * 256 + lane * 4); xv[4 * i] = v.x; xv[4 * i + 1] = v.y; xv[4 * i + 2] = v.z; xv[4 * i + 3] = v.w; }
        if (l > 0) {
            float ov[16]; float ss = 0.f;
#pragma unroll
            for (int i = 0; i < 4; ++i) { const uint2 w = *(const uint2*)(p.proj + (size_t)row * LDP + C_O + i * 256 + lane * 4);
                ov[4 * i] = bflo(w.x); ov[4 * i + 1] = bfhi(w.x); ov[4 * i + 2] = bflo(w.y); ov[4 * i + 3] = bfhi(w.y); }
#pragma unroll
            for (int i = 0; i < 16; ++i) ss += ov[i] * ov[i];
            ss = wave_sum(ss); const float rs = rsqrtf(ss * (1.f / 1024.f) + EPSN);
#pragma unroll
            for (int i = 0; i < 4; ++i) { const float4 w = *(const float4*)(p.post_w + (l - 1) * DM + i * 256 + lane * 4);
                xv[4 * i] += ov[4 * i] * rs * w.x; xv[4 * i + 1] += ov[4 * i + 1] * rs * w.y; xv[4 * i + 2] += ov[4 * i + 2] * rs * w.z; xv[4 * i + 3] += ov[4 * i + 3] * rs * w.w; }
#pragma unroll
            for (int i = 0; i < 4; ++i) *(float4*)(p.out + (size_t)row * DM + i * 256 + lane * 4) = make_float4(xv[4 * i], xv[4 * i + 1], xv[4 * i + 2], xv[4 * i + 3]);
        }
        if (l < 4) {
            float ss = 0.f;
#pragma unroll
            for (int i = 0; i < 16; ++i) ss += xv[i] * xv[i];
            ss = wave_sum(ss); const float rs = rsqrtf(ss * (1.f / 1024.f) + EPSN);
            if (lane == 0) p.rstd[row] = rs;
#pragma unroll
            for (int i = 0; i < 4; ++i) { uint2 w; w.x = pk2(xv[4 * i], xv[4 * i + 1]); w.y = pk2(xv[4 * i + 2], xv[4 * i + 3]); *(uint2*)(p.xb + (size_t)row * DM + i * 256 + lane * 4) = w; }
            float d[16];
#pragma unroll
            for (int j = 0; j < 16; ++j) d[j] = 0.f;
            const float* wbase = p.w_in + (size_t)l * DM * INC + 2560;
#pragma unroll
            for (int i = 0; i < 4; ++i) { const float4 pw = *(const float4*)(p.pre_w + l * DM + i * 256 + lane * 4); const float xw[4] = {xv[4 * i] * pw.x, xv[4 * i + 1] * pw.y, xv[4 * i + 2] * pw.z, xv[4 * i + 3] * pw.w};
#pragma unroll
                for (int e = 0; e < 4; ++e) { const float4* wp = (const float4*)(wbase + (size_t)(i * 256 + lane * 4 + e) * INC);
#pragma unroll
                    for (int q = 0; q < 4; ++q) { const float4 w = wp[q]; d[4 * q] += xw[e] * w.x; d[4 * q + 1] += xw[e] * w.y; d[4 * q + 2] += xw[e] * w.z; d[4 * q + 3] += xw[e] * w.w; } } }
            float mine = 0.f;
#pragma unroll
            for (int j = 0; j < 16; ++j) { const float t = wave_sum(d[j]); if (lane == j) mine = t; }
            if (lane < 16) p.dtraw[(size_t)row * 16 + lane] = mine * rs;
        }
    }
}

#ifndef PH
#define PH 63
#endif
#define MFMA16(a, b, c) __builtin_amdgcn_mfma_f32_16x16x32_bf16(a, b, c, 0, 0, 0)

__device__ void ssd_unit(CPAR p, int l, int b, int hd, unsigned char* shm) {
    const int tid = lt_tid(), lane = tid & 63, wv = tid >> 6, quad = lane >> 4, l15 = lane & 15;
    bf16_t* Cs = (bf16_t*)shm;
    bf16_t* Bs = Cs + 64 * 136;
    bf16_t* BscT = Bs + 64 * 136;
    bf16_t* XT = BscT + 128 * 72;
    bf16_t* Ls = XT + 64 * 72;
    bf16_t* Ss = Ls + 64 * 72;
    float* dtb = (float*)(Ss + 64 * 136);
    const int g = hd >> 3;
    const float a = -expf(p.a_log[l * 16 + hd]), dbias = p.dt_bias[l * 16 + hd], dsk = p.ssd_d[l * 16 + hd];
    for (int i = tid; i < 64 * 136 / 2; i += 512) ((unsigned*)Ss)[i] = 0u;
    f32x4 accS[4];
#pragma unroll
    for (int i = 0; i < 4; ++i) accS[i] = (f32x4){0.f, 0.f, 0.f, 0.f};
    const size_t row_base = (size_t)b * SEQL;
    for (int c = 0; c < 32; ++c) {
        const int t0 = c * 64;
        float* dtv = dtb + (c & 1) * 128; float* acum = dtv + 64;
        if (wv == 0) {
            const float v = p.dtraw[(row_base + t0 + lane) * 16 + hd] + dbias; const float dt = v > 20.f ? v : log1pf(expf(v)); float da = dt * a;
#pragma unroll
            for (int o = 1; o < 64; o <<= 1) { const float n = __shfl_up(da, o); if (lane >= o) da += n; }
            dtv[lane] = dt; acum[lane] = da;
        }
        __syncthreads();
        const float alast = acum[63];
        for (int idx = tid; idx < 1280; idx += 512) {
            const int cp = idx % 160, tg = idx / 160; int kind, ch;
            if (cp < 32) { kind = 0; ch = hd * 64 + cp * 2; } else if (cp < 96) { kind = 1; ch = 1024 + g * 128 + (cp - 32) * 2; } else { kind = 2; ch = 1280 + g * 128 + (cp - 96) * 2; }
            const int l0 = tg * 8;
            const bf16_t* src = p.proj + (row_base + t0 + l0) * LDP + C_XBC + ch;
            float r0[11], r1[11];
#pragma unroll
            for (int j = 0; j < 11; ++j) { const int t = t0 + l0 + j - 3; unsigned w = 0u; if (t >= 0) w = *(const unsigned*)(src + (ptrdiff_t)(j - 3) * LDP); r0[j] = bflo(w); r1[j] = bfhi(w); }
            const float* cw = p.conv_w + (size_t)l * 4 * 1536 + ch; const float* cb = p.conv_b + l * 1536 + ch;
            const float w00 = cw[0], w01 = cw[1536], w02 = cw[3072], w03 = cw[4608], w10 = cw[1], w11 = cw[1537], w12 = cw[3073], w13 = cw[4609], b0 = cb[0], b1 = cb[1];
            float o0[8], o1[8];
#pragma unroll
            for (int j = 0; j < 8; ++j) { o0[j] = siluf_(b0 + w00 * r0[j] + w01 * r0[j + 1] + w02 * r0[j + 2] + w03 * r0[j + 3]); o1[j] = siluf_(b1 + w10 * r1[j] + w11 * r1[j + 1] + w12 * r1[j + 2] + w13 * r1[j + 3]); }
            if (kind == 0) {
                uint4 q0, q1; q0.x = pk2(o0[0], o0[1]); q0.y = pk2(o0[2], o0[3]); q0.z = pk2(o0[4], o0[5]); q0.w = pk2(o0[6], o0[7]);
                q1.x = pk2(o1[0], o1[1]); q1.y = pk2(o1[2], o1[3]); q1.z = pk2(o1[4], o1[5]); q1.w = pk2(o1[6], o1[7]);
                *(uint4*)(XT + (cp * 2) * 72 + l0) = q0; *(uint4*)(XT + (cp * 2 + 1) * 72 + l0) = q1;
            } else if (kind == 1) {
                const int n0 = (cp - 32) * 2; float s0[8], s1[8];
#pragma unroll
                for (int j = 0; j < 8; ++j) { *(unsigned*)(Bs + (l0 + j) * 136 + n0) = pk2(o0[j], o1[j]); const float sc = dtv[l0 + j] * __expf(alast - acum[l0 + j]); s0[j] = o0[j] * sc; s1[j] = o1[j] * sc; }
                uint4 q0, q1; q0.x = pk2(s0[0], s0[1]); q0.y = pk2(s0[2], s0[3]); q0.z = pk2(s0[4], s0[5]); q0.w = pk2(s0[6], s0[7]);
                q1.x = pk2(s1[0], s1[1]); q1.y = pk2(s1[2], s1[3]); q1.z = pk2(s1[4], s1[5]); q1.w = pk2(s1[6], s1[7]);
                *(uint4*)(BscT + n0 * 72 + l0) = q0; *(uint4*)(BscT + (n0 + 1) * 72 + l0) = q1;
            } else {
                const int n0 = (cp - 96) * 2;
#pragma unroll
                for (int j = 0; j < 8; ++j) *(unsigned*)(Cs + (l0 + j) * 136 + n0) = pk2(o0[j], o1[j]);
            }
        }
        __syncthreads();
        const int mt = wv >> 1, ntb = (wv & 1) * 2;
        f32x4 accY[2];
#pragma unroll
        for (int i = 0; i < 2; ++i) {
            const int nt = ntb + i;
            const f32x4 s = mma_lds(Cs + mt * 16 * 136, 136, Bs + nt * 16 * 136, 136, 128, (f32x4){0.f, 0.f, 0.f, 0.f}, lane);
            const int scol = nt * 16 + l15; const float as = acum[scol], ds = dtv[scol];
#pragma unroll
            for (int j = 0; j < 4; ++j) { const int lrow = mt * 16 + quad * 4 + j; const float v = (scol <= lrow) ? s[j] * __expf(acum[lrow] - as) * ds : 0.f; Ls[lrow * 72 + scol] = (bf16_t)f2bf(v); }
            accY[i] = mma_lds(Cs + mt * 16 * 136, 136, Ss + nt * 16 * 136, 136, 128, (f32x4){0.f, 0.f, 0.f, 0.f}, lane);
#pragma unroll
            for (int j = 0; j < 4; ++j) accY[i][j] *= __expf(acum[mt * 16 + quad * 4 + j]);
        }
        __syncthreads();
        float sq[4] = {0.f, 0.f, 0.f, 0.f};
#pragma unroll
        for (int i = 0; i < 2; ++i) {
            const int nt = ntb + i, pcol = nt * 16 + l15;
            accY[i] = mma_lds(Ls + mt * 16 * 72, 72, XT + nt * 16 * 72, 72, 64, accY[i], lane);
#pragma unroll
            for (int j = 0; j < 4; ++j) { const int lrow = mt * 16 + quad * 4 + j; const float xval = bf2f(XT[pcol * 72 + lrow]); const float y = accY[i][j] + dsk * xval;
                bf16_t* zp = p.proj + (row_base + t0 + lrow) * LDP + C_Z + hd * 64 + pcol; const float yz = y * siluf_(bf2f(*zp)); sq[j] += yz * yz; *zp = (bf16_t)f2bf(yz); }
        }
#pragma unroll
        for (int j = 0; j < 4; ++j) { float v = sq[j]; v += __shfl_xor(v, 1); v += __shfl_xor(v, 2); v += __shfl_xor(v, 4); v += __shfl_xor(v, 8);
            if (l15 == 0) p.ss_ssd[(row_base + t0 + mt * 16 + quad * 4 + j) * 32 + hd * 2 + (wv & 1)] = v; }
        const int pmt = wv & 3, nb = (wv >> 2) * 4; const float cdec = __expf(alast);
#pragma unroll
        for (int i = 0; i < 4; ++i) {
            accS[i] *= cdec;
            accS[i] = mma_lds(XT + pmt * 16 * 72, 72, BscT + (nb + i) * 16 * 72, 72, 64, accS[i], lane);
#pragma unroll
            for (int j = 0; j < 4; ++j) Ss[(pmt * 16 + quad * 4 + j) * 136 + (nb + i) * 16 + l15] = (bf16_t)f2bf(accS[i][j]);
        }
    }
    __syncthreads();
}

__device__ void hgrn_unit(CPAR p, int l, int b, int head, int vq, unsigned char* shm) {
    const int tid = lt_tid(), lane = tid & 63, wv = tid >> 6, quad = lane >> 4, l15 = lane & 15;
    bf16_t* Qm = (bf16_t*)shm;
    bf16_t* Km = Qm + 64 * 136;
    bf16_t* Qs = Km + 64 * 136;
    bf16_t* KhT = Qs + 64 * 136;
    bf16_t* VT = KhT + 128 * 72;
    bf16_t* At = VT + 32 * 72;
    bf16_t* ST = At + 64 * 72;
    float* dec = (float*)(ST + 32 * 136);
    float* seg = dec + 128;
    for (int i = tid; i < 32 * 136 / 2; i += 512) ((unsigned*)ST)[i] = 0u;
    f32x4 accS[2] = {(f32x4){0.f, 0.f, 0.f, 0.f}, (f32x4){0.f, 0.f, 0.f, 0.f}};
    const int k = tid & 127, lq = tid >> 7;
    const float lb = p.lb[l * 512 + head * 128 + k], omlb = 1.f - lb;
    const size_t row_base = (size_t)b * SEQL;
    for (int c = 0; c < 32; ++c) {
        const int t0 = c * 64;
        float qv[16], lf[16], kk[16];
#pragma unroll
        for (int i = 0; i < 16; ++i) { const bf16_t* rp = p.proj + (row_base + t0 + lq * 16 + i) * LDP + head * 128 + k; const float q = bf2f(rp[C_Q]), f = bf2f(rp[C_F]);
            const float sg = sigmoidf_(f); lf[i] = (lb > 0.f) ? __logf(lb + omlb * sg) : (fminf(f, 0.f) - log1pf(__expf(-fabsf(f)))); kk[i] = omlb * sigmoidf_(-f); qv[i] = siluf_(q); }
#pragma unroll
        for (int i = 1; i < 16; ++i) lf[i] += lf[i - 1];
        seg[lq * 128 + k] = lf[15];
        float vv[16];
        if (tid < 128) { const int v = tid & 31, vl = tid >> 5;
#pragma unroll
            for (int i = 0; i < 16; ++i) vv[i] = bf2f(p.proj[(row_base + t0 + vl * 16 + i) * LDP + C_I + head * 128 + vq * 32 + v]); }
        __syncthreads();
        float off = 0.f, tot = 0.f;
#pragma unroll
        for (int j = 0; j < 4; ++j) { const float s = seg[j * 128 + k]; if (j < lq) off += s; tot += s; }
        const float mid = seg[k] + seg[128 + k];
        float kh[16];
#pragma unroll
        for (int i = 0; i < 16; ++i) { const float cum = off + lf[i]; const int lrow = lq * 16 + i;
            Qm[lrow * 136 + k] = (bf16_t)f2bf(qv[i] * __expf(fminf(fmaxf(cum - mid, -80.f), 80.f)));
            Km[lrow * 136 + k] = (bf16_t)f2bf(kk[i] * __expf(fminf(fmaxf(mid - cum, -80.f), 80.f)));
            Qs[lrow * 136 + k] = (bf16_t)f2bf(qv[i] * __expf(cum));
            kh[i] = kk[i] * __expf(tot - cum); }
        { uint4 q0, q1; q0.x = pk2(kh[0], kh[1]); q0.y = pk2(kh[2], kh[3]); q0.z = pk2(kh[4], kh[5]); q0.w = pk2(kh[6], kh[7]);
          q1.x = pk2(kh[8], kh[9]); q1.y = pk2(kh[10], kh[11]); q1.z = pk2(kh[12], kh[13]); q1.w = pk2(kh[14], kh[15]);
          *(uint4*)(KhT + k * 72 + lq * 16) = q0; *(uint4*)(KhT + k * 72 + lq * 16 + 8) = q1; }
        if (lq == 0) dec[k] = __expf(tot);
        if (tid < 128) { const int v = tid & 31, vl = tid >> 5; uint4 q0, q1; q0.x = pk2(vv[0], vv[1]); q0.y = pk2(vv[2], vv[3]); q0.z = pk2(vv[4], vv[5]); q0.w = pk2(vv[6], vv[7]);
            q1.x = pk2(vv[8], vv[9]); q1.y = pk2(vv[10], vv[11]); q1.z = pk2(vv[12], vv[13]); q1.w = pk2(vv[14], vv[15]);
            *(uint4*)(VT + v * 72 + vl * 16) = q0; *(uint4*)(VT + v * 72 + vl * 16 + 8) = q1; }
        __syncthreads();
        const int mt = wv >> 1, vt = wv & 1;
#pragma unroll
        for (int i = 0; i < 2; ++i) { const int nt = vt * 2 + i;
            const f32x4 s = mma_lds(Qm + mt * 16 * 136, 136, Km + nt * 16 * 136, 136, 128, (f32x4){0.f, 0.f, 0.f, 0.f}, lane);
            const int scol = nt * 16 + l15;
#pragma unroll
            for (int j = 0; j < 4; ++j) { const int lrow = mt * 16 + quad * 4 + j; At[lrow * 72 + scol] = (bf16_t)f2bf(scol <= lrow ? s[j] : 0.f); } }
        f32x4 accO = mma_lds(Qs + mt * 16 * 136, 136, ST + vt * 16 * 136, 136, 128, (f32x4){0.f, 0.f, 0.f, 0.f}, lane);
        __syncthreads();
        accO = mma_lds(At + mt * 16 * 72, 72, VT + vt * 16 * 72, 72, 64, accO, lane);
#pragma unroll
        for (int i = 0; i < 2; ++i) { const int ktile = (wv >> 1) * 2 + i; const float d = dec[ktile * 16 + l15];
            accS[i] *= d;
            accS[i] = mma_lds(VT + vt * 16 * 72, 72, KhT + ktile * 16 * 72, 72, 64, accS[i], lane);
#pragma unroll
            for (int j = 0; j < 4; ++j) ST[(vt * 16 + quad * 4 + j) * 136 + ktile * 16 + l15] = (bf16_t)f2bf(accS[i][j]); }
#pragma unroll
        for (int j = 0; j < 4; ++j) { const int lrow = mt * 16 + quad * 4 + j; const size_t row = row_base + t0 + lrow; const float o = accO[j];
            float v = o * o; v += __shfl_xor(v, 1); v += __shfl_xor(v, 2); v += __shfl_xor(v, 4); v += __shfl_xor(v, 8);
            if (l15 == 0) p.ss_hg[row * 32 + head * 8 + vq * 2 + vt] = v;
            bf16_t* gp = p.proj + row * LDP + C_G + head * 128 + vq * 32 + vt * 16 + l15; *gp = (bf16_t)f2bf(o * siluf_(bf2f(*gp))); }
    }
    __syncthreads();
}

__device__ void s5_unit(CPAR p, int l, int g, int b, unsigned char* shm) {
    const int tid = lt_tid(), lane = tid & 63, wv = tid >> 6, quad = lane >> 4, l15 = lane & 15;
    bf16_t* U = (bf16_t*)shm;
    float* St = (float*)(shm + 66560);
    bf16_t* Sin = (bf16_t*)(shm + 66560 + 33280);
    const size_t row_base = (size_t)b * SEQL;
    for (int i = tid; i < 4096; i += 512) { const int tok = i >> 1, hf = i & 1; const uint4 v = *(const uint4*)(p.proj + (row_base + tok) * LDP + C_U + g * 16 + hf * 8);
        *(uint4*)(U + (tok >> 5) * 520 + (tok & 31) * 16 + hf * 8) = v; }
    __syncthreads();
    {
        f32x4 acc[4];
#pragma unroll
        for (int n = 0; n < 4; ++n) acc[n] = (f32x4){0.f, 0.f, 0.f, 0.f};
        const bf16_t* ap = p.wst + (size_t)g * 65536 + (wv * 16 + l15) * 512 + quad * 8;
        for (int k0 = 0; k0 < 512; k0 += 32) { const bf16x8 a = *(const bf16x8*)(ap + k0);
#pragma unroll
            for (int n = 0; n < 4; ++n) { const bf16x8 bb = *(const bf16x8*)(U + (n * 16 + l15) * 520 + k0 + quad * 8); acc[n] = MFMA16(a, bb, acc[n]); } }
#pragma unroll
        for (int n = 0; n < 4; ++n)
#pragma unroll
            for (int j = 0; j < 4; ++j) St[(wv * 16 + quad * 4 + j) * 65 + n * 16 + l15] = acc[n][j];
    }
    __syncthreads();
    if (tid < 64) { const float ar = p.aT[(g * 64 + tid) * 2], ai = p.aT[(g * 64 + tid) * 2 + 1]; float sr = 0.f, si = 0.f;
#pragma unroll 8
        for (int c = 0; c < 64; ++c) { Sin[c * 136 + tid] = (bf16_t)f2bf(sr); Sin[c * 136 + 64 + tid] = (bf16_t)f2bf(si);
            const float lr = St[tid * 65 + c], li = St[(64 + tid) * 65 + c]; const float nr = ar * sr - ai * si + lr, ni = ar * si + ai * sr + li; sr = nr; si = ni; } }
    __syncthreads();
    const float4 dsk = *(const float4*)(p.s5_d + l * 512 + g * 16 + quad * 4);
    for (int it = 0; it < 4; ++it) {
        const int t = wv + 8 * it;
        f32x4 acc[4];
#pragma unroll
        for (int n = 0; n < 4; ++n) acc[n] = (f32x4){0.f, 0.f, 0.f, 0.f};
        const bf16_t* kt = p.ktab + (size_t)g * 8192 + l15 * 16 + (quad & 1) * 8;
        for (int j = 0; j <= (t >> 1); ++j) { const int lag = t - 2 * j - (quad >> 1); bf16x8 a = (bf16x8){0, 0, 0, 0, 0, 0, 0, 0}; if (lag >= 0) a = *(const bf16x8*)(kt + lag * 256);
#pragma unroll
            for (int n = 0; n < 4; ++n) { const bf16x8 bb = *(const bf16x8*)(U + (n * 16 + l15) * 520 + j * 32 + quad * 8); acc[n] = MFMA16(a, bb, acc[n]); } }
        const bf16_t* wp = p.woff + (size_t)g * 65536 + (t * 16 + l15) * 128 + quad * 8;
#pragma unroll
        for (int k0 = 0; k0 < 128; k0 += 32) { const bf16x8 a = *(const bf16x8*)(wp + k0);
#pragma unroll
            for (int n = 0; n < 4; ++n) { const bf16x8 bb = *(const bf16x8*)(Sin + (n * 16 + l15) * 136 + k0 + quad * 8); acc[n] = MFMA16(a, bb, acc[n]); } }
#pragma unroll
        for (int n = 0; n < 4; ++n) { const int c = n * 16 + l15; const uint2 uw = *(const uint2*)(U + c * 520 + t * 16 + quad * 4);
            float y[4] = {acc[n][0] + dsk.x * bflo(uw.x), acc[n][1] + dsk.y * bfhi(uw.x), acc[n][2] + dsk.z * bflo(uw.y), acc[n][3] + dsk.w * bfhi(uw.y)};
#pragma unroll
            for (int j = 0; j < 4; ++j) { const float z = 0.7978845608f * (y[j] + 0.044715f * y[j] * y[j] * y[j]); const float th = 1.f - 2.f / (__expf(2.f * z) + 1.f); y[j] = 0.5f * y[j] * (1.f + th); }
            uint2 w; w.x = pk2(y[0], y[1]); w.y = pk2(y[2], y[3]);
            *(uint2*)(p.proj + (row_base + c * 32 + t) * LDP + C_U + g * 16 + quad * 4) = w; }
    }
    __syncthreads();
}

__device__ void phase_mix(CPAR p, int l, unsigned char* shm) {
    const int G = gridDim.x, bid = lt_bid();
    for (int u = bid; u < 256; u += G) ssd_unit(p, l, u >> 4, u & 15, shm);
    for (int u = bid; u < 256; u += G) hgrn_unit(p, l, u >> 4, (u >> 2) & 3, u & 3, shm);
    for (int u = bid; u < 512; u += G) s5_unit(p, l, u >> 4, u & 15, shm);
}

__device__ void phase_fin(CPAR p) {
    const int tid = lt_tid(), lane = tid & 63, wv = tid >> 6;
    for (int row = lt_bid() * 8 + wv; row < NTOK; row += gridDim.x * 8) {
        float a0 = 0.f, a1 = 0.f, hh = 0.f, cc = 0.f;
        const float4* s1 = (const float4*)(p.ss_ssd + (size_t)row * 32);
#pragma unroll
        for (int i = 0; i < 4; ++i) { const float4 u = s1[i], v = s1[4 + i]; a0 += u.x + u.y + u.z + u.w; a1 += v.x + v.y + v.z + v.w; }
        const float4* s2 = (const float4*)(p.ss_hg + (size_t)row * 32 + (lane >> 4) * 8);
        { const float4 u = s2[0], v = s2[1]; hh = u.x + u.y + u.z + u.w + v.x + v.y + v.z + v.w; }
        const float4* s3 = (const float4*)(p.ss_s5 + (size_t)row * 16);
#pragma unroll
        for (int i = 0; i < 4; ++i) { const float4 u = s3[i]; cc += u.x + u.y + u.z + u.w; }
        const float sc[4] = {rsqrtf(a0 * (1.f / 512.f) + EPSN), rsqrtf(a1 * (1.f / 512.f) + EPSN), rsqrtf(hh * (1.f / 128.f) + EPSN), rsqrtf(cc * (1.f / 512.f) + EPSN)};
#pragma unroll
        for (int i = 0; i < 4; ++i) { uint4* ptr = (uint4*)(p.proj + (size_t)row * LDP + i * 512 + lane * 8); uint4 v = *ptr; const float s = sc[i];
            v.x = pk2(bflo(v.x) * s, bfhi(v.x) * s); v.y = pk2(bflo(v.y) * s, bfhi(v.y) * s); v.z = pk2(bflo(v.z) * s, bfhi(v.z) * s); v.w = pk2(bflo(v.w) * s, bfhi(v.w) * s); *ptr = v; }
    }
}

template <class Epi> __device__ __forceinline__ void run_gemm(unsigned char* shm, const pg8::Gemm& g, const Epi& E) {
    pg8::StaticOrder S; S.init(g.M, g.N, (int)gridDim.x, lt_bid());
    pg8::gemm_phase<Epi, pg8::StaticOrder, false>((PG8_LAS unsigned char*)shm, g, S, E, nullptr);
}

__global__ __launch_bounds__(512, 2) void mega(Params p_unused) {
    extern __shared__ __attribute__((aligned(16))) unsigned char shm[];
    cg::grid_group grid = cg::this_grid();
#pragma unroll 1
    for (int l = 0; l < 4; ++l) {
#if PH & 1
        { CPAR p = *GETP(); phase_prep(p, l, shm); }
#endif
        grid.sync();
#if PH & 2
        { CPAR p = *GETP(); pg8::Gemm g{p.xb, p.winT, NTOK, LDP, DM, DM}; EpiIn e{p.proj, p.rstd}; run_gemm(shm, g, e); }
#endif
        grid.sync();
#if PH & 4
        { CPAR p = *GETP(); phase_mix(p, l, shm); }
#endif
        grid.sync();
#if PH & 8
        { CPAR p = *GETP(); pg8::Gemm g{p.proj + C_U, p.wgluT, NTOK, 1024, 512, LDP}; EpiGlu e{p.proj, p.glu_b + l * 1024, p.ss_s5}; run_gemm(shm, g, e); }
#endif
        grid.sync();
#if PH & 16
        { CPAR p = *GETP(); phase_fin(p); }
#endif
        grid.sync();
#if PH & 32
        { CPAR p = *GETP(); pg8::Gemm g{p.proj, p.woutT, NTOK, 1024, 2048, LDP}; EpiOut e{p.proj}; run_gemm(shm, g, e); }
#endif
        grid.sync();
    }
#if PH & 1
    { CPAR p = *GETP(); phase_prep(p, 4, shm); }
#endif
}

extern "C" void kernel_launch(void* const* d_in, const int* in_sizes, int n_in, void* d_out, int out_size, void* d_ws, size_t ws_size, hipStream_t stream) {
    constexpr size_t kLds = 131072;
    static int grid_blocks = 0;
    if (!grid_blocks) {
        int dev = 0, cus = 0, per_cu = 0;
        hipGetDevice(&dev);
        hipDeviceGetAttribute(&cus, hipDeviceAttributeMultiprocessorCount, dev);
        hipFuncSetAttribute((const void*)mega, hipFuncAttributeMaxDynamicSharedMemorySize, (int)kLds);
        hipOccupancyMaxActiveBlocksPerMultiprocessor(&per_cu, mega, 512, kLds);
        if (per_cu < 1) per_cu = 1;
        grid_blocks = cus * per_cu;
        if (grid_blocks > 256) grid_blocks = 256;
    }
    Params p{};
    const float** f = (const float**)&p;
    for (int i = 0; i < 24; ++i) f[i] = (const float*)d_in[i];
    p.out = (float*)d_out;
    unsigned char* w = (unsigned char*)d_ws; size_t off = 0;
    auto take = [&](size_t bytes) { unsigned char* r = w + off; off += (bytes + 255) & ~(size_t)255; return r; };
    p.proj = (bf16_t*)take((size_t)NTOK * LDP * 2);
    p.xb = (bf16_t*)take((size_t)NTOK * DM * 2);
    p.winT = (bf16_t*)take((size_t)LDP * DM * 2);
    p.woutT = (bf16_t*)take((size_t)1024 * 2048 * 2);
    p.wgluT = (bf16_t*)take((size_t)1024 * 512 * 2);
    p.ktab = (bf16_t*)take((size_t)32 * 8192 * 2);
    p.woff = (bf16_t*)take((size_t)32 * 65536 * 2);
    p.wst = (bf16_t*)take((size_t)32 * 65536 * 2);
    p.wdt = (float*)take(256);
    p.aT = (float*)take((size_t)32 * 64 * 2 * 4);
    p.lb = (float*)take((size_t)4 * 512 * 4);
    p.rstd = (float*)take((size_t)NTOK * 4);
    p.dtraw = (float*)take((size_t)NTOK * 16 * 4);
    p.ss_ssd = (float*)take((size_t)NTOK * 32 * 4);
    p.ss_hg = (float*)take((size_t)NTOK * 32 * 4);
    p.ss_s5 = (float*)take((size_t)NTOK * 16 * 4);
    if (off > ws_size) { fprintf(stderr, "workspace too small: need %zu have %zu\n", off, ws_size); return; }
    void* args[] = {&p};
    hipError_t e = hipLaunchCooperativeKernel((const void*)mega, dim3(grid_blocks), dim3(512), args, kLds, stream);
    if (e != hipSuccess) fprintf(stderr, "cooperative launch failed: %s (grid %d)\n", hipGetErrorString(e), grid_blocks);
}
```

```cpp
#include <hip/hip_runtime.h>
#include <hip/hip_cooperative_groups.h>
#include <cstdio>
namespace cg = cooperative_groups;
__device__ __forceinline__ int lt_tid() { int t = threadIdx.x; asm volatile("" : "+v"(t)); return t; }
__device__ __forceinline__ int lt_bid() { int t = blockIdx.x; asm volatile("" : "+s"(t)); return t; }
namespace pg8 {
#define PG8_LAS __attribute__((address_space(3)))
typedef unsigned short bf16_t;
typedef short bf16x8 __attribute__((ext_vector_type(8)));
typedef float f32x4 __attribute__((ext_vector_type(4)));
typedef unsigned u32x4 __attribute__((ext_vector_type(4)));
constexpr int BM = 256, BK = 64, HALF = 128, HTB = HALF * BK * 2  , STAGE_BYTES = 8 * HTB, NXCD = 8, WGM = 8;

__host__ __device__ __forceinline__ int lds_byte(int r, int c) { const int st = (r >> 4) * 2 + (c >> 5), rr = r & 15, cc = c & 31, ob = rr * 64 + cc * 2; return st * 1024 + (ob ^ (((ob >> 9) & 1) << 5)); }
__host__ __device__ __forceinline__ void stage_rc(int b, int& R, int& C) { const int st = b / 1024, sb = b % 1024, swz = sb ^ (((sb >> 9) & 1) << 5); R = (st >> 1) * 16 + swz / 64; C = (st & 1) * 32 + (swz % 64) / 2; }
__host__ __device__ __forceinline__ int perm32(int rho) { const int n = rho >> 4, i = rho & 15; return 8 * (i >> 2) + 4 * n + (i & 3); }

struct Unit { int pm, pn; };
struct Gemm { const bf16_t* A; const bf16_t* Bt; int M, N, K, lda; };

struct StaticOrder {
    int nM, nN, nwg, G, c;
    __host__ __device__ void init(int M, int N, int G_, int c_) { nM = M / BM; nN = N / BM; nwg = nM * nN; G = G_; c = c_; }
    __host__ __device__ bool next(int i, Unit& u) const {
        const long L = (long)i * G + c; if (L >= nwg) return false;
        int wgid = (int)L; { const int q = nwg / NXCD, r = nwg % NXCD, xcd = wgid % NXCD, off = wgid / NXCD; wgid = (xcd < r ? xcd * (q + 1) : r * (q + 1) + (xcd - r) * q) + off; }
        const int nig = WGM * nN, gid = wgid / nig, fm = gid * WGM, gsz = (nM - fm) < WGM ? (nM - fm) : WGM;
        u.pm = fm + ((wgid % nig) % gsz); u.pn = (wgid % nig) / gsz; return true;
    }
    __device__ __forceinline__ void a_ready(const Unit&) const {}
    __device__ __forceinline__ void done(const Unit&) const {}
};

__device__ __forceinline__ unsigned cvt_pk_bf16(float lo, float hi) { unsigned r; asm volatile("v_cvt_pk_bf16_f32 %0, %1, %2" : "=v"(r) : "v"(lo), "v"(hi)); return r; }
template <class Epi, class Sched, bool STAMP = false>
__device__ __forceinline__ void gemm_phase(PG8_LAS unsigned char* lds, const Gemm g, const Sched& S, const Epi& E, unsigned long long* stamps) {
    const int tid = lt_tid(), wid = __builtin_amdgcn_readfirstlane(tid >> 6), lane = tid & 63, wr = wid >> 2, wc = wid & 3, fr = lane & 15, fq = lane >> 4;
    const int K = g.K, nt = K / BK;
    int ts_lo = 0, ts_hi = 0, nts = 0; const unsigned long long rt_entry = STAMP ? (unsigned long long)wall_clock64() : 0ull;
#define PG8_STAMP() do { if (STAMP && wid == 0 && nts < 64) { const unsigned long long _c = (unsigned long long)clock64(); \
        ts_lo = (lane == nts) ? (int)(unsigned)_c : ts_lo; ts_hi = (lane == nts) ? (int)(unsigned)(_c >> 32) : ts_hi; ++nts; } } while (0)
    PG8_STAMP();
    unsigned voffA[2], voffB[2];
#pragma unroll
    for (int i = 0; i < 2; ++i) { int R, C; stage_rc(tid * 16 + i * 8192, R, C); const int Rb = Epi::PERM ? ((R & ~31) + perm32(R & 31)) : R;
        voffA[i] = (unsigned)(R * g.lda + C) * 2u; voffB[i] = (unsigned)(Rb * K + C) * 2u; }
    const size_t kstep = (size_t)(BK * 2);
    const size_t hstep = (size_t)HALF * K * 2;
    const size_t tstep = 2 * hstep; const size_t hstepA = (size_t)HALF * g.lda * 2; const size_t tstepA = 2 * hstepA;
    const unsigned ldsw = (unsigned)wid * 1024u;
    const int aoff = lds_byte(wr * 64 + fr, fq * 8), boff = lds_byte(wc * 32 + fr, fq * 8);
#define PG8_SA(b, h) (((b) * 2 + (h)) * HTB)
#define PG8_SB(b, h) ((4 + (b) * 2 + (h)) * HTB)
#define PG8_STAGE(bufoff, gbase, voff) do { _Pragma("unroll") for (int _i = 0; _i < 2; ++_i) \
        __builtin_amdgcn_global_load_lds((const unsigned*)((const char*)(gbase) + (voff)[_i]), (PG8_LAS unsigned*)(lds + (bufoff) + ldsw + _i * 8192), 16, 0, 0); } while (0)
#define PG8_LDA(dst, b, h) do { _Pragma("unroll") for (int m = 0; m < 4; ++m) _Pragma("unroll") for (int k = 0; k < 2; ++k) dst[m][k] = *(const PG8_LAS bf16x8*)(lds + PG8_SA(b, h) + aoff + m * 2048 + k * 1024); } while (0)
#define PG8_LDB(dst, b, h) do { _Pragma("unroll") for (int n = 0; n < 2; ++n) _Pragma("unroll") for (int k = 0; k < 2; ++k) dst[n][k] = *(const PG8_LAS bf16x8*)(lds + PG8_SB(b, h) + boff + n * 2048 + k * 1024); } while (0)
#define PG8_MMA(ai, bj, At, Bt) do { __builtin_amdgcn_s_setprio(1); _Pragma("unroll") for (int m = 0; m < 4; ++m) _Pragma("unroll") for (int n = 0; n < 2; ++n) _Pragma("unroll") for (int k = 0; k < 2; ++k) \
        acc[ai][bj][m][n] = __builtin_amdgcn_mfma_f32_16x16x32_bf16(Bt[n][k], At[m][k], acc[ai][bj][m][n], 0, 0, 0); __builtin_amdgcn_s_setprio(0); } while (0)
#define PG8_WAIT_V(n) asm volatile("s_waitcnt vmcnt(" #n ")" ::: "memory")
#define PG8_WAIT_L(n) asm volatile("s_waitcnt lgkmcnt(" #n ")" ::: "memory")
#define PG8_BAR __builtin_amdgcn_s_barrier()
#define PG8_SCHED __builtin_amdgcn_sched_barrier(0)
    Unit cur, nxt; int ui = 0;
    if (!S.next(0, cur)) return;
    f32x4 acc[2][2][4][2];
#pragma unroll
    for (int a = 0; a < 2; ++a)
#pragma unroll
        for (int b = 0; b < 2; ++b)
#pragma unroll
            for (int m = 0; m < 4; ++m)
#pragma unroll
                for (int n = 0; n < 2; ++n) acc[a][b][m][n] = (f32x4){0.f, 0.f, 0.f, 0.f};
    bf16x8 At[4][2], B0[2][2], B1[2][2];
    const char* cA = (const char*)g.A + (size_t)cur.pm * tstepA; const char* cB = (const char*)g.Bt + (size_t)cur.pn * tstep;
    S.a_ready(cur);
    PG8_STAGE(PG8_SB(0, 0), cB, voffB); PG8_STAGE(PG8_SA(0, 0), cA, voffA); PG8_STAGE(PG8_SB(0, 1), cB + hstep, voffB); PG8_STAGE(PG8_SA(0, 1), cA + hstepA, voffA);
    if (wr == 1) PG8_BAR;
    PG8_WAIT_V(4); PG8_BAR;
    PG8_STAGE(PG8_SB(1, 0), cB + kstep, voffB); PG8_STAGE(PG8_SA(1, 0), cA + kstep, voffA); PG8_STAGE(PG8_SB(1, 1), cB + hstep + kstep, voffB);
    PG8_WAIT_V(6); PG8_BAR;
    PG8_STAMP();
    for (;;) {
        const bool has_next = S.next(ui + 1, nxt);
        const char* nA = has_next ? (const char*)g.A + (size_t)nxt.pm * tstepA : cA; const char* nB = has_next ? (const char*)g.Bt + (size_t)nxt.pn * tstep : cB;
        for (int t = 0; t < nt; t += 2) {
            if constexpr (Epi::SEG) { if (t >= 8 && E.boundary(t)) E.rescale(acc, t, ui, wr, fr, lds); }
            const bool last = (t == nt - 2);
            const char* a1 = cA + (size_t)(t + 1) * kstep;
            const char* a2 = last ? nA : cA + (size_t)(t + 2) * kstep; const char* b2 = last ? nB : cB + (size_t)(t + 2) * kstep;
            const char* a3 = a2 + kstep; const char* b3 = b2 + kstep;
            if (last && has_next) S.a_ready(nxt);
            PG8_LDB(B0, 0, 0); PG8_SCHED; PG8_LDA(At, 0, 0); PG8_STAGE(PG8_SA(1, 1), a1 + hstepA, voffA);
            PG8_WAIT_L(8); PG8_BAR; PG8_WAIT_L(0); PG8_MMA(0, 0, At, B0); PG8_BAR; PG8_SCHED;
            PG8_LDB(B1, 0, 1); PG8_STAGE(PG8_SB(0, 0), b2, voffB);
            PG8_BAR; PG8_WAIT_L(0); PG8_MMA(0, 1, At, B1); PG8_BAR;
            PG8_LDA(At, 0, 1); PG8_STAGE(PG8_SA(0, 0), a2, voffA);
            PG8_BAR; PG8_WAIT_L(0); PG8_MMA(1, 0, At, B0); PG8_BAR; PG8_SCHED;
            PG8_STAGE(PG8_SB(0, 1), b2 + hstep, voffB);
            PG8_WAIT_V(6); PG8_BAR; PG8_MMA(1, 1, At, B1); PG8_BAR;
            PG8_LDB(B0, 1, 0); PG8_SCHED; PG8_LDA(At, 1, 0); PG8_STAGE(PG8_SA(0, 1), a2 + hstepA, voffA);
            PG8_WAIT_L(8); PG8_BAR; PG8_WAIT_L(0); PG8_MMA(0, 0, At, B0); PG8_BAR; PG8_SCHED;
            PG8_LDB(B1, 1, 1); PG8_STAGE(PG8_SB(1, 0), b3, voffB);
            PG8_BAR; PG8_WAIT_L(0); PG8_MMA(0, 1, At, B1); PG8_BAR;
            PG8_LDA(At, 1, 1); PG8_STAGE(PG8_SA(1, 0), a3, voffA);
            PG8_BAR; PG8_WAIT_L(0); PG8_MMA(1, 0, At, B0); PG8_BAR; PG8_SCHED;
            PG8_STAGE(PG8_SB(1, 1), b3 + hstep, voffB);
            PG8_WAIT_V(6); PG8_BAR; PG8_MMA(1, 1, At, B1); PG8_BAR;
        }
        PG8_STAMP();
        if constexpr (Epi::SEG) { E.fin(acc, cur, wr, wc, fr, fq, ui, lds); } else if constexpr (!Epi::AFTER_DRAIN) { E(acc, cur, wr, wc, fr, fq); S.done(cur); }
        PG8_STAMP();
        if (!has_next) break;
#pragma unroll
        for (int a = 0; a < 2; ++a)
#pragma unroll
            for (int b = 0; b < 2; ++b)
#pragma unroll
                for (int m = 0; m < 4; ++m)
#pragma unroll
                    for (int n = 0; n < 2; ++n) acc[a][b][m][n] = (f32x4){0.f, 0.f, 0.f, 0.f};
        cur = nxt; cA = nA; cB = nB; ++ui;
    }
    PG8_WAIT_V(0);
    if (wr == 0) PG8_BAR;
    PG8_BAR;
    if constexpr (Epi::AFTER_DRAIN) { E.fused(acc, cur, wr, wc, fr, fq, lds, wid, lane); S.done(cur); }
    PG8_STAMP();
    if (STAMP && wid == 0) { stamps[lane] = lane < nts ? (((unsigned long long)(unsigned)ts_hi << 32) | (unsigned)ts_lo) : 0ull;
        if (lane == 62) stamps[62] = rt_entry; if (lane == 63) stamps[63] = (unsigned long long)wall_clock64(); }
#undef PG8_STAMP
#undef PG8_SA
#undef PG8_SB
#undef PG8_STAGE
#undef PG8_LDA
#undef PG8_LDB
#undef PG8_MMA
#undef PG8_WAIT_V
#undef PG8_WAIT_L
#undef PG8_BAR
#undef PG8_SCHED
}
}

using pg8::bf16_t; using pg8::bf16x8; using pg8::f32x4;
constexpr int NTOK = 32768, SEQL = 2048, DM = 1024, LDP = 5632, INC = 5648;
constexpr int C_Z = 0, C_G = 1024, C_SG = 1536, C_XBC = 2048, C_Q = 3584, C_F = 4096, C_I = 4608, C_U = 5120, C_O = 2048;
constexpr float EPSN = 1e-6f;

struct Params {
    const float *x, *pre_w, *post_w, *w_in, *w_out, *conv_w, *conv_b, *dt_bias, *a_log, *ssd_d, *ssd_nw, *hg_lb, *hg_nw,
        *lam_re, *lam_im, *log_step, *b_re, *b_im, *c_re, *c_im, *s5_d, *glu_w, *glu_b, *s5_nw;
    float* out;
    bf16_t *proj, *xb, *winT, *woutT, *wgluT, *ktab, *woff, *wst;
    float *wdt, *aT, *lb, *rstd, *dtraw, *ss_ssd, *ss_hg, *ss_s5;
    unsigned* bar;
    bf16_t* bcb;
};

#define CPAR const __attribute__((address_space(4))) Params&
#define GETP() ({ const __attribute__((address_space(4))) Params* _pp = (const __attribute__((address_space(4))) Params*)__builtin_amdgcn_kernarg_segment_ptr(); asm volatile("" : "+s"(_pp)); _pp; })
__device__ __forceinline__ unsigned f2bf(float f) { unsigned u = __float_as_uint(f); u += 0x7FFFu + ((u >> 16) & 1u); return u >> 16; }
__device__ __forceinline__ float bf2f(unsigned b) { return __uint_as_float(b << 16); }
__device__ __forceinline__ float bflo(unsigned w) { return __uint_as_float(w << 16); }
__device__ __forceinline__ float bfhi(unsigned w) { return __uint_as_float(w & 0xffff0000u); }
__device__ __forceinline__ unsigned pk2(float a, float b) { unsigned r; asm("v_cvt_pk_bf16_f32 %0, %1, %2" : "=v"(r) : "v"(a), "v"(b)); return r; }
__device__ __forceinline__ float sigmoidf_(float v) { return 1.f / (1.f + __expf(-v)); }
__device__ __forceinline__ float siluf_(float v) { return v / (1.f + __expf(-v)); }
__device__ __forceinline__ float wave_sum(float v) {
#pragma unroll
    for (int o = 32; o >= 1; o >>= 1) v += __shfl_xor(v, o);
    return v;
}
__device__ __forceinline__ f32x4 mma_lds(const bf16_t* A, int lda, const bf16_t* Bt, int ldb, int K, f32x4 acc, int lane) {
    const bf16_t* ap = A + (lane & 15) * lda + (lane >> 4) * 8;
    const bf16_t* bp = Bt + (lane & 15) * ldb + (lane >> 4) * 8;
#pragma unroll 4
    for (int k0 = 0; k0 < K; k0 += 32) {
        bf16x8 a = *(const bf16x8*)(ap + k0), b = *(const bf16x8*)(bp + k0);
        acc = __builtin_amdgcn_mfma_f32_16x16x32_bf16(a, b, acc, 0, 0, 0);
    }
    return acc;
}

template <int NT, int K>
__device__ __forceinline__ void mma_lds_n(const bf16_t* A, int lda, const bf16_t* Bt, int ldb, int bstride, f32x4 (&acc)[NT], int lane) {
    const bf16_t* ap = A + (lane & 15) * lda + (lane >> 4) * 8;
    const bf16_t* bp = Bt + (lane & 15) * ldb + (lane >> 4) * 8;
    constexpr int KS = K / 32;
    bf16x8 a[2], b[2][NT];
    a[0] = *(const bf16x8*)ap;
#pragma unroll
    for (int i = 0; i < NT; ++i) b[0][i] = *(const bf16x8*)(bp + i * bstride);
#pragma unroll
    for (int ks = 0; ks < KS; ++ks) { const int cur = ks & 1, nxt = cur ^ 1;
        if (ks + 1 < KS) { a[nxt] = *(const bf16x8*)(ap + (ks + 1) * 32);
#pragma unroll
            for (int i = 0; i < NT; ++i) b[nxt][i] = *(const bf16x8*)(bp + i * bstride + (ks + 1) * 32); }
        __builtin_amdgcn_sched_barrier(0);
#pragma unroll
        for (int i = 0; i < NT; ++i) acc[i] = __builtin_amdgcn_mfma_f32_16x16x32_bf16(a[cur], b[cur][i], acc[i], 0, 0, 0);
        __builtin_amdgcn_sched_barrier(0); }
}

template <int NT, int K>
__device__ __forceinline__ void mma_lds_s(const bf16_t* A, int lda, const bf16_t* Bt, int ldb, int bstride, f32x4 (&acc)[NT], int lane) {
    const bf16_t* ap = A + (lane & 15) * lda + (lane >> 4) * 8;
    const bf16_t* bp = Bt + (lane & 15) * ldb + (lane >> 4) * 8;
#pragma unroll
    for (int k0 = 0; k0 < K; k0 += 32) { const bf16x8 a = *(const bf16x8*)(ap + k0);
#pragma unroll
        for (int i = 0; i < NT; ++i) { const bf16x8 b = *(const bf16x8*)(bp + i * bstride + k0); acc[i] = __builtin_amdgcn_mfma_f32_16x16x32_bf16(a, b, acc[i], 0, 0, 0); } }
}

#define XB_TMO      128
#define XB_XCNT(j)  (256  + 64 * (j))
#define XB_XSUB(j)  (1280 + 64 * (j))
#define XB_XGEN(j)  (2304 + 64 * (j))
#define XB_TOP      3328
#define XB_TOPGEN   3392
#define XCD_BAR_WORDS 3456
#define XB_SPIN_CAP (1u << 18)
#define LAS __attribute__((address_space(3)))

__device__ __forceinline__ unsigned xb_ld(unsigned* p)              { return __hip_atomic_load(p, __ATOMIC_RELAXED, __HIP_MEMORY_SCOPE_AGENT); }
__device__ __forceinline__ unsigned xb_add(unsigned* p, unsigned v) { return __hip_atomic_fetch_add(p, v, __ATOMIC_RELAXED, __HIP_MEMORY_SCOPE_AGENT); }
__device__ __forceinline__ unsigned xb_xcc_id() { return (unsigned)__builtin_amdgcn_s_getreg((3 << 11) | 20) & 0xFu; }
#define XB_SPIN(cond, bar) do { unsigned _sp = 0; while (cond) { __builtin_amdgcn_s_sleep(1); \
    if ((++_sp & 255u) == 0u) { if (xb_ld(&(bar)[XB_TMO])) break; if (_sp > XB_SPIN_CAP) { atomicAdd(&(bar)[XB_TMO], 1u); break; } } } } while (0)

struct XcdBarrier {
    unsigned* bar;
    bf16_t* bcb; unsigned x;
    volatile LAS unsigned* st;
};

__device__ __forceinline__ XcdBarrier xcd_barrier_post(unsigned* bar, volatile LAS unsigned* st) {
    XcdBarrier b; b.bar = bar; b.x = xb_xcc_id(); b.st = st;
    if (threadIdx.x == 0) (void)xb_add(&bar[XB_XCNT(b.x)], 1u);
    return b;
}
__device__ __forceinline__ void xcd_barrier_complete(unsigned* bar, unsigned x, unsigned& nloc, unsigned& nx) {
    const unsigned G = gridDim.x * gridDim.y * gridDim.z;
    unsigned sum, cnt, mine, sp = 0u;
    for (;;) {
        sum = 0u; cnt = 0u; mine = 0u;
#pragma unroll
        for (unsigned j = 0; j < 16; ++j) { const unsigned c = xb_ld(&bar[XB_XCNT(j)]); sum += c; cnt += (c > 0u) ? 1u : 0u; mine = (j == x) ? c : mine; }
        if (sum == G) break;
        __builtin_amdgcn_s_sleep(1);
        if ((++sp & 255u) == 0u) { if (xb_ld(&bar[XB_TMO])) break; if (sp > XB_SPIN_CAP) { atomicAdd(&bar[XB_TMO], 1u); break; } }
    }
    nloc = mine > 0u ? mine : 1u; nx = cnt > 0u ? cnt : 1u;
}

__device__ __forceinline__ void xcd_barrier(const XcdBarrier& b) {
    asm volatile("s_waitcnt vmcnt(0)" ::: "memory");
    __syncthreads();
    if (threadIdx.x == 0) {
        unsigned* bar = b.bar;
        __builtin_amdgcn_s_waitcnt(0);
        unsigned nloc = b.st[0], nx = b.st[1];
        if (nloc == 0u) { xcd_barrier_complete(bar, b.x, nloc, nx); b.st[0] = nloc; b.st[1] = nx; }
        const unsigned old = xb_add(&bar[XB_XSUB(b.x)], 1u);
        const unsigned gen = old / nloc;
        if (old + 1u == (gen + 1u) * nloc) {
            __builtin_amdgcn_fence(__ATOMIC_RELEASE, "agent");
            asm volatile("s_waitcnt vmcnt(0)" ::: "memory");
            const unsigned og = xb_add(&bar[XB_TOP], 1u);
            const unsigned tg = og / nx;
            if (og + 1u == (tg + 1u) * nx) xb_add(&bar[XB_TOPGEN], 1u);
            else XB_SPIN(xb_ld(&bar[XB_TOPGEN]) == tg, bar);
            __builtin_amdgcn_fence(__ATOMIC_ACQUIRE, "agent");
            xb_add(&bar[XB_XGEN(b.x)], 1u);
            asm volatile("s_waitcnt vmcnt(0)" ::: "memory");
        } else {
            XB_SPIN(xb_ld(&bar[XB_XGEN(b.x)]) == gen, bar);
            __builtin_amdgcn_fence(__ATOMIC_ACQUIRE, "agent");
            asm volatile("s_waitcnt vmcnt(0)" ::: "memory");
        }
    }
    __syncthreads();
}


struct EpiIn {
    static constexpr bool PERM = false, AFTER_DRAIN = false, SEG = false;
    bf16_t* O; const float* rstd;
    __device__ __forceinline__ void operator()(const f32x4 (&acc)[2][2][4][2], const pg8::Unit& u, int wr, int wc, int fr, int fq) const {
        const int row0 = u.pm * 256 + wr * 64 + fr, col0 = u.pn * 256 + wc * 32 + 4 * fq;
#pragma unroll
        for (int ai = 0; ai < 2; ++ai)
#pragma unroll
            for (int m = 0; m < 4; ++m) { const int row = row0 + ai * 128 + m * 16; const float rs = rstd[row]; bf16_t* rowp = O + (size_t)row * LDP + col0;
#pragma unroll
                for (int bj = 0; bj < 2; ++bj)
#pragma unroll
                    for (int n = 0; n < 2; ++n) { const f32x4 v = acc[ai][bj][m][n] * rs; uint2 w; w.x = pk2(v[0], v[1]); w.y = pk2(v[2], v[3]); *(uint2*)(rowp + bj * 128 + n * 16) = w; } }
    }
};
struct EpiOut {
    static constexpr bool PERM = false, AFTER_DRAIN = false, SEG = false;
    bf16_t* O;
    __device__ __forceinline__ void operator()(const f32x4 (&acc)[2][2][4][2], const pg8::Unit& u, int wr, int wc, int fr, int fq) const {
        const int row0 = u.pm * 256 + wr * 64 + fr, col0 = u.pn * 256 + wc * 32 + 4 * fq;
#pragma unroll
        for (int ai = 0; ai < 2; ++ai)
#pragma unroll
            for (int m = 0; m < 4; ++m) { const int row = row0 + ai * 128 + m * 16; bf16_t* rowp = O + (size_t)row * LDP + C_O + col0;
#pragma unroll
                for (int bj = 0; bj < 2; ++bj)
#pragma unroll
                    for (int n = 0; n < 2; ++n) { const f32x4 v = acc[ai][bj][m][n]; uint2 w; w.x = pk2(v[0], v[1]); w.y = pk2(v[2], v[3]); *(uint2*)(rowp + bj * 128 + n * 16) = w; } }
    }
};
struct EpiOutSeg {
    static constexpr bool PERM = false, AFTER_DRAIN = false, SEG = true;
    bf16_t* O;
    __device__ __forceinline__ bool boundary(int t) const { return t == 8 || t == 16 || t == 18 || t == 20 || t == 22 || t == 24; }
    __device__ __forceinline__ void rescale(f32x4 (&acc)[2][2][4][2], int t, int ui, int wr, int fr, PG8_LAS unsigned char* lds) const {
        const int b = (t == 8) ? 0 : (t == 16) ? 1 : ((t - 14) >> 1);
        const PG8_LAS float* rt = (const PG8_LAS float*)(lds + 131072) + ((ui & 1) * 7 + b) * 256 + wr * 64 + fr;
#pragma unroll
        for (int ai = 0; ai < 2; ++ai)
#pragma unroll
            for (int m = 0; m < 4; ++m) { const float r = rt[ai * 128 + m * 16];
#pragma unroll
                for (int bj = 0; bj < 2; ++bj)
#pragma unroll
                    for (int n = 0; n < 2; ++n) acc[ai][bj][m][n] *= r; }
    }
    __device__ __forceinline__ void fin(const f32x4 (&acc)[2][2][4][2], const pg8::Unit& u, int wr, int wc, int fr, int fq, int ui, PG8_LAS unsigned char* lds) const {
        const PG8_LAS float* rt = (const PG8_LAS float*)(lds + 131072) + ((ui & 1) * 7 + 6) * 256 + wr * 64 + fr;
        const int row0 = u.pm * 256 + wr * 64 + fr, col0 = u.pn * 256 + wc * 32 + 4 * fq;
#pragma unroll
        for (int ai = 0; ai < 2; ++ai)
#pragma unroll
            for (int m = 0; m < 4; ++m) { const int row = row0 + ai * 128 + m * 16; const float r = rt[ai * 128 + m * 16]; bf16_t* rowp = O + (size_t)row * LDP + C_O + col0;
#pragma unroll
                for (int bj = 0; bj < 2; ++bj)
#pragma unroll
                    for (int n = 0; n < 2; ++n) { const f32x4 v = acc[ai][bj][m][n] * r; uint2 w; w.x = pk2(v[0], v[1]); w.y = pk2(v[2], v[3]); *(uint2*)(rowp + bj * 128 + n * 16) = w; } }
    }
    __device__ __forceinline__ void operator()(const f32x4 (&acc)[2][2][4][2], const pg8::Unit& u, int wr, int wc, int fr, int fq) const {}
};
struct EpiGlu {
    static constexpr bool PERM = false, AFTER_DRAIN = false, SEG = false;
    bf16_t* P; const float* bias; float* ss;
    __device__ __forceinline__ void operator()(const f32x4 (&acc)[2][2][4][2], const pg8::Unit& u, int wr, int wc, int fr, int fq) const {
        const int row0 = u.pm * 256 + wr * 64 + fr, c0 = u.pn * 128 + wc * 32 + 4 * fq;
        f32x4 bv[2], bg[2];
#pragma unroll
        for (int n = 0; n < 2; ++n) { bv[n] = *(const f32x4*)(bias + c0 + n * 16); bg[n] = *(const f32x4*)(bias + 512 + c0 + n * 16); }
#pragma unroll
        for (int ai = 0; ai < 2; ++ai)
#pragma unroll
            for (int m = 0; m < 4; ++m) { const int row = row0 + ai * 128 + m * 16; bf16_t* rowp = P + (size_t)row * LDP + C_SG + c0; float sq = 0.f;
#pragma unroll
                for (int n = 0; n < 2; ++n) { const f32x4 val = acc[ai][0][m][n] + bv[n], gt = acc[ai][1][m][n] + bg[n]; const uint2 gw = *(const uint2*)(rowp + n * 16);
                    float g[4] = {bflo(gw.x), bfhi(gw.x), bflo(gw.y), bfhi(gw.y)}; float y[4];
#pragma unroll
                    for (int j = 0; j < 4; ++j) { y[j] = val[j] * sigmoidf_(gt[j]) * siluf_(g[j]); sq += y[j] * y[j]; }
                    uint2 w; w.x = pk2(y[0], y[1]); w.y = pk2(y[2], y[3]); *(uint2*)(rowp + n * 16) = w; }
                sq += __shfl_xor(sq, 16); sq += __shfl_xor(sq, 32);
                if (fq == 0) ss[(size_t)row * 16 + u.pn * 4 + wc] = sq; }
    }
};

__device__ __forceinline__ int src_col(int n) {
    if (n < 1024) return n; if (n < 1536) return 4112 + (n - 1024); if (n < 2048) return 5136 + (n - 1536); if (n < 3584) return 1024 + (n - 2048);
    if (n < 4096) return 2576 + (n - 3584); if (n < 4608) return 3088 + (n - 4096); if (n < 5120) return 3600 + (n - 4608); return 4624 + (n - 5120);
}
template <int NSUB>
__device__ __forceinline__ void tr_tile(const float* src, int lds_, int col0, int k0, const float* sc, bf16_t* dst, int ldd, int row0, float* tile) {
    const int tid = lt_tid();
    constexpr int W = 64 * NSUB, STR = W + 1;
#pragma unroll
    for (int i = 0; i < 2 * NSUB; ++i) { const int idx = tid + i * 512, k = idx / (W / 4), n4 = idx % (W / 4);
        float4 v = *(const float4*)(src + (size_t)(k0 + k) * lds_ + col0 + n4 * 4); if (sc) { const float f = sc[k0 + k]; v.x *= f; v.y *= f; v.z *= f; v.w *= f; }
        float* tp = tile + k * STR + n4 * 4; tp[0] = v.x; tp[1] = v.y; tp[2] = v.z; tp[3] = v.w; }
    __syncthreads();
#pragma unroll
    for (int i = 0; i < NSUB; ++i) { const int idx = tid + i * 512, n = idx % W, kg = idx / W; const float* tp = tile + (kg * 8) * STR + n;
        uint4 w; w.x = pk2(tp[0], tp[STR]); w.y = pk2(tp[2 * STR], tp[3 * STR]); w.z = pk2(tp[4 * STR], tp[5 * STR]); w.w = pk2(tp[6 * STR], tp[7 * STR]);
        *(uint4*)(dst + (size_t)(row0 + n) * ldd + k0 + kg * 8) = w; }
    __syncthreads();
}

__device__ void s5_tables(CPAR p, int l, int g, int part, unsigned char* shm) {
    float* apre = (float*)shm;
    float* apim = apre + 33 * 64;
    float* bbre = apim + 33 * 64;
    float* bbim = bbre + 1024;
    float* core = bbim + 1024;
    float* coim = core + 64;
    float* cres = coim + 64;
    float* cims = cres + 1024;
    const int tid = lt_tid();
    if (tid < 64) {
        const int pp = tid; const int gi = (l * 32 + g) * 64 + pp;
        const double lr = fmin((double)p.lam_re[gi], -1e-4), li = (double)p.lam_im[gi], st = (double)expf(p.log_step[l * 32 + g]);
        const double xe = lr * st; double mag = 1.0, term = 1.0;
        for (int q = 1; q <= 12; ++q) { term *= xe / (double)q; mag += term; }
        double ang = li * st; ang -= 6.283185307179586476925 * rint(ang / 6.283185307179586476925);
        const double are = mag * (double)cosf((float)ang), aim = mag * (double)sinf((float)ang);
        double pr = 1.0, pi = 0.0;
        for (int j = 0; j <= 32; ++j) { apre[j * 64 + pp] = (float)pr; apim[j * 64 + pp] = (float)pi; const double nr = pr * are - pi * aim, ni = pr * aim + pi * are; pr = nr; pi = ni; }
        const double den = lr * lr + li * li, nre = are - 1.0, nim = aim;
        core[pp] = (float)((nre * lr + nim * li) / den); coim[pp] = (float)((nim * lr - nre * li) / den);
        if (part == 0) { float* aT = p.aT + (l & 1) * 32 * 64 * 2; aT[(g * 64 + pp) * 2 + 0] = apre[32 * 64 + pp]; aT[(g * 64 + pp) * 2 + 1] = apim[32 * 64 + pp]; }
    }
    __syncthreads();
    for (int i = tid; i < 1024; i += 512) { const int pp = i >> 4; const size_t gi = ((size_t)(l * 32 + g) * 64) * 16 + i;
        const float br = p.b_re[gi], bi = p.b_im[gi]; bbre[i] = core[pp] * br - coim[pp] * bi; bbim[i] = core[pp] * bi + coim[pp] * br; }
    __syncthreads();
    for (int i = tid; i < 1024; i += 512) { cres[i] = p.c_re[(size_t)(l * 32 + g) * 1024 + i]; cims[i] = p.c_im[(size_t)(l * 32 + g) * 1024 + i]; }
    __syncthreads();
    const float* cre = cres;
    const float* cim = cims;
    bf16_t* kt = p.ktab + (size_t)(l & 1) * 32 * 8192 + (size_t)g * 8192;
    for (int e = part * 1024 + tid; e < part * 1024 + 1024; e += 512) { const int lag = e >> 8, h = (e >> 4) & 15, h2 = e & 15; float s = 0.f;
        for (int pp = 0; pp < 64; ++pp) { const float cr = cre[h * 64 + pp], ci = cim[h * 64 + pp], ar = apre[lag * 64 + pp], ai = apim[lag * 64 + pp];
            const float car = cr * ar - ci * ai, cai = cr * ai + ci * ar; s += car * bbre[pp * 16 + h2] - cai * bbim[pp * 16 + h2]; }
        kt[e] = (bf16_t)f2bf(s); }
    bf16_t* wo = p.woff + (size_t)(l & 1) * 32 * 65536 + (size_t)g * 65536;
    for (int e = part * 8192 + tid; e < part * 8192 + 8192; e += 512) { const int row = e >> 7, k = e & 127, t = row >> 4, h = row & 15, pp = k & 63;
        const float cr = cre[h * 64 + pp], ci = cim[h * 64 + pp], ar = apre[(t + 1) * 64 + pp], ai = apim[(t + 1) * 64 + pp];
        const float v = (k < 64) ? (cr * ar - ci * ai) : -(cr * ai + ci * ar); wo[e] = (bf16_t)f2bf(v); }
    bf16_t* ws = p.wst + (size_t)(l & 1) * 32 * 65536 + (size_t)g * 65536;
    for (int e = part * 8192 + tid; e < part * 8192 + 8192; e += 512) { const int m = e >> 9, k = e & 511, s = k >> 4, h2 = k & 15, pp = m & 63;
        const float ar = apre[(31 - s) * 64 + pp], ai = apim[(31 - s) * 64 + pp], br = bbre[pp * 16 + h2], bi = bbim[pp * 16 + h2];
        const float v = (m < 64) ? (ar * br - ai * bi) : (ar * bi + ai * br); ws[e] = (bf16_t)f2bf(v); }
    __syncthreads();
}

__device__ __forceinline__ void convert_weights(CPAR p, int l, int part, int nparts, unsigned char* shm) {
    float* tile = (float*)shm; const int par = l & 1;
    bf16_t* winT = p.winT + (size_t)par * LDP * DM; bf16_t* woutT = p.woutT + (size_t)par * 1024 * 2048; bf16_t* wgluT = p.wgluT + (size_t)par * 1024 * 512;
    for (int t = part; t < 544; t += nparts) {
        if (t < 352) { const int nt = t >> 4, kt = t & 15; tr_tile<4>(p.w_in + (size_t)l * DM * INC, INC, src_col(nt * 256), kt * 64, p.pre_w + l * DM, winT, DM, nt * 256, tile); }
        else if (t < 480) { const int u = t - 352, nt = u >> 5, kt = u & 31, k0 = kt * 64;
            const float* sc = (k0 < 1024) ? (p.ssd_nw + l * 1024) : (k0 < 1536) ? (p.hg_nw + l * 512 - 1024) : (p.s5_nw + l * 512 - 1536);
            tr_tile<4>(p.w_out + (size_t)l * 2048 * DM, DM, nt * 256, k0, sc, woutT, 2048, nt * 256, tile); }
        else { const int u = t - 480, nt = u >> 3, kt = u & 7, row0 = nt * 128, pn = row0 >> 8, half = (row0 >> 7) & 1;
            tr_tile<2>(p.glu_w + (size_t)l * 512 * 1024, 1024, half * 512 + pn * 128, kt * 64, nullptr, wgluT, 512, row0, tile); }
    }
    for (int u = part; u < 256; u += nparts) s5_tables(p, l, u >> 3, u & 7, shm);
}

__device__ void phase_prep(CPAR p, int l, unsigned char* shm) {
    const int tid = lt_tid(), lane = tid & 63, wv = tid >> 6;
    const int G = gridDim.x, bid = lt_bid();
    if (l == 0) {
        convert_weights(p, 0, bid, G, shm);
        if (bid == G - 1) {
            const float a0 = p.hg_lb[tid], a1 = p.hg_lb[512 + tid], a2 = p.hg_lb[1024 + tid], a3 = p.hg_lb[1536 + tid];
            const float mx = fmaxf(fmaxf(a0, a1), fmaxf(a2, a3)); const float e0 = expf(a0 - mx), e1 = expf(a1 - mx), e2 = expf(a2 - mx), e3 = expf(a3 - mx), inv = 1.f / (e0 + e1 + e2 + e3);
            p.lb[tid] = 0.f; p.lb[512 + tid] = e1 * inv; p.lb[1024 + tid] = (e1 + e2) * inv; p.lb[1536 + tid] = (e1 + e2 + e3) * inv;
        }
    }
    __syncthreads();
    float* wdt_s = (float*)(shm + 32768);
    if (l < 4) { for (int e = tid; e < 16384; e += 512) { const int k = e >> 4, j = e & 15; wdt_s[j * 1024 + k] = p.w_in[(size_t)l * DM * INC + (size_t)k * INC + 2560 + j] * p.pre_w[l * DM + k]; } }
    __syncthreads();
    float pw[16];
#pragma unroll
    for (int i = 0; i < 4; ++i) { const float4 w = (l > 0) ? *(const float4*)(p.post_w + (l - 1) * DM + i * 256 + lane * 4) : make_float4(0.f, 0.f, 0.f, 0.f); pw[4 * i] = w.x; pw[4 * i + 1] = w.y; pw[4 * i + 2] = w.z; pw[4 * i + 3] = w.w; }
    const int rstep = G * 8; int row = bid * 8 + wv;
    float4 xn[4]; uint2 xq[4], on[4];
#pragma unroll
    for (int i = 0; i < 4; ++i) { xn[i] = make_float4(0.f, 0.f, 0.f, 0.f); xq[i] = make_uint2(0u, 0u); on[i] = make_uint2(0u, 0u); }
    if (row < NTOK) {
        if (l == 0) {
#pragma unroll
            for (int i = 0; i < 4; ++i) xn[i] = *(const float4*)(p.x + (size_t)row * DM + i * 256 + lane * 4);
        } else {
#pragma unroll
            for (int i = 0; i < 4; ++i) { xq[i] = *(const uint2*)(p.xb + (size_t)row * DM + i * 256 + lane * 4); on[i] = *(const uint2*)(p.proj + (size_t)row * LDP + C_O + i * 256 + lane * 4); }
        }
    }
    for (; row < NTOK; row += rstep) {
        float xv[16]; uint2 oc[4];
        if (l == 0) {
#pragma unroll
            for (int i = 0; i < 4; ++i) { xv[4 * i] = xn[i].x; xv[4 * i + 1] = xn[i].y; xv[4 * i + 2] = xn[i].z; xv[4 * i + 3] = xn[i].w; oc[i] = make_uint2(0u, 0u); }
        } else {
#pragma unroll
            for (int i = 0; i < 4; ++i) { xv[4 * i] = bflo(xq[i].x); xv[4 * i + 1] = bfhi(xq[i].x); xv[4 * i + 2] = bflo(xq[i].y); xv[4 * i + 3] = bfhi(xq[i].y); oc[i] = on[i]; }
        }
        if (row + rstep < NTOK) {
            if (l == 0) {
#pragma unroll
                for (int i = 0; i < 4; ++i) xn[i] = *(const float4*)(p.x + (size_t)(row + rstep) * DM + i * 256 + lane * 4);
            } else {
#pragma unroll
                for (int i = 0; i < 4; ++i) { xq[i] = *(const uint2*)(p.xb + (size_t)(row + rstep) * DM + i * 256 + lane * 4); on[i] = *(const uint2*)(p.proj + (size_t)(row + rstep) * LDP + C_O + i * 256 + lane * 4); }
            }
        }
        if (l > 0) {
            float ov[16]; float ss = 0.f;
#pragma unroll
            for (int i = 0; i < 4; ++i) { ov[4 * i] = bflo(oc[i].x); ov[4 * i + 1] = bfhi(oc[i].x); ov[4 * i + 2] = bflo(oc[i].y); ov[4 * i + 3] = bfhi(oc[i].y); }
#pragma unroll
            for (int i = 0; i < 16; ++i) ss += ov[i] * ov[i];
            ss = wave_sum(ss); const float rs = rsqrtf(ss * (1.f / 1024.f) + EPSN);
#pragma unroll
            for (int i = 0; i < 16; ++i) xv[i] += ov[i] * rs * pw[i];
            if (l == 4) {
#pragma unroll
                for (int i = 0; i < 4; ++i) *(float4*)(p.out + (size_t)row * DM + i * 256 + lane * 4) = make_float4(xv[4 * i], xv[4 * i + 1], xv[4 * i + 2], xv[4 * i + 3]);
            }
        }
        if (l < 4) {
            float ss = 0.f;
#pragma unroll
            for (int i = 0; i < 16; ++i) ss += xv[i] * xv[i];
            ss = wave_sum(ss); const float rs = rsqrtf(ss * (1.f / 1024.f) + EPSN);
            if (lane == 0) p.rstd[row] = rs;
#pragma unroll
            for (int i = 0; i < 4; ++i) { uint2 w; w.x = pk2(xv[4 * i], xv[4 * i + 1]); w.y = pk2(xv[4 * i + 2], xv[4 * i + 3]); *(uint2*)(p.xb + (size_t)row * DM + i * 256 + lane * 4) = w; }
            float d[16];
#pragma unroll
            for (int j = 0; j < 16; ++j) { float a = 0.f;
#pragma unroll
                for (int i = 0; i < 4; ++i) { const float4 w = *(const float4*)(wdt_s + j * 1024 + i * 256 + lane * 4); a += xv[4 * i] * w.x + xv[4 * i + 1] * w.y + xv[4 * i + 2] * w.z + xv[4 * i + 3] * w.w; }
                d[j] = a; }
            float e8[8], e4[4], e2[2];
#pragma unroll
            for (int j = 0; j < 8; ++j) { const bool hi = lane & 32; const float mine = hi ? d[j + 8] : d[j], send = hi ? d[j] : d[j + 8]; e8[j] = mine + __shfl_xor(send, 32); }
#pragma unroll
            for (int j = 0; j < 4; ++j) { const bool hi = lane & 16; const float mine = hi ? e8[j + 4] : e8[j], send = hi ? e8[j] : e8[j + 4]; e4[j] = mine + __shfl_xor(send, 16); }
#pragma unroll
            for (int j = 0; j < 2; ++j) { const bool hi = lane & 8; const float mine = hi ? e4[j + 2] : e4[j], send = hi ? e4[j] : e4[j + 2]; e2[j] = mine + __shfl_xor(send, 8); }
            float e1; { const bool hi = lane & 4; const float mine = hi ? e2[1] : e2[0], send = hi ? e2[0] : e2[1]; e1 = mine + __shfl_xor(send, 4); }
            e1 += __shfl_xor(e1, 2); e1 += __shfl_xor(e1, 1);
            if ((lane & 3) == 0) { const int j = ((lane >> 5) & 1) * 8 + ((lane >> 4) & 1) * 4 + ((lane >> 3) & 1) * 2 + ((lane >> 2) & 1); p.dtraw[(size_t)row * 16 + j] = e1 * rs; }
        }
    }
}

#ifndef PH
#define PH 63
#endif
#ifndef TPROBE
#define TPROBE -1
#endif
#if TPROBE >= 0
#ifndef TBLK
#define TBLK 0
#endif
#define TSTAMP(k) do { if (blockIdx.x == TBLK && threadIdx.x == 0) { CPAR _p = *GETP(); unsigned long long* _w = (unsigned long long*)_p.wdt; const unsigned long long _t = wall_clock64(); if ((k) == TPROBE) _w[1] += (_t - _w[0]); _w[0] = _t; } } while (0)
#else
#define TSTAMP(k) do { } while (0)
#endif
#define BAR_LDS() do { asm volatile("s_waitcnt lgkmcnt(0)" ::: "memory"); __builtin_amdgcn_s_barrier(); asm volatile("" ::: "memory"); } while (0)
#define MFMA16(a, b, c) __builtin_amdgcn_mfma_f32_16x16x32_bf16(a, b, c, 0, 0, 0)

__device__ void bcconv_unit(CPAR p, int l, int u) {
    const int tid = lt_tid();
    const int bg = u >> 3, tr = u & 7, b = bg >> 1, g = bg & 1;
    bf16_t* Bn = p.bcb; bf16_t* Cn = Bn + (size_t)32 * 2048 * 128; bf16_t* BT = Cn + (size_t)32 * 2048 * 128;
    const int cp = tid & 63, kind = (tid >> 6) & 1, tgl = tid >> 7;
    const int ch = (kind ? 1280 : 1024) + g * 128 + cp * 2;
    const float* cw = p.conv_w + (size_t)l * 4 * 1536 + ch; const float* cb = p.conv_b + l * 1536 + ch;
    const float w00 = cw[0], w01 = cw[1536], w02 = cw[3072], w03 = cw[4608], w10 = cw[1], w11 = cw[1537], w12 = cw[3073], w13 = cw[4609], b0 = cb[0], b1 = cb[1];
    for (int it = 0; it < 8; ++it) {
        const int t = tr * 256 + (it * 4 + tgl) * 8;
        const bf16_t* src = p.proj + ((size_t)b * SEQL + t) * LDP + C_XBC + ch;
        float r0[11], r1[11];
#pragma unroll
        for (int j = 0; j < 11; ++j) { unsigned w = 0u; if (t + j - 3 >= 0) w = *(const unsigned*)(src + (ptrdiff_t)(j - 3) * LDP); r0[j] = bflo(w); r1[j] = bfhi(w); }
        float o0[8], o1[8];
#pragma unroll
        for (int j = 0; j < 8; ++j) { o0[j] = siluf_(b0 + w00 * r0[j] + w01 * r0[j + 1] + w02 * r0[j + 2] + w03 * r0[j + 3]); o1[j] = siluf_(b1 + w10 * r1[j] + w11 * r1[j + 1] + w12 * r1[j + 2] + w13 * r1[j + 3]); }
        bf16_t* dstn = (kind ? Cn : Bn) + ((size_t)bg * 2048 + t) * 128 + cp * 2;
#pragma unroll
        for (int j = 0; j < 8; ++j) *(unsigned*)(dstn + j * 128) = pk2(o0[j], o1[j]);
        if (!kind) { uint4 q0, q1; q0.x = pk2(o0[0], o0[1]); q0.y = pk2(o0[2], o0[3]); q0.z = pk2(o0[4], o0[5]); q0.w = pk2(o0[6], o0[7]);
            q1.x = pk2(o1[0], o1[1]); q1.y = pk2(o1[2], o1[3]); q1.z = pk2(o1[4], o1[5]); q1.w = pk2(o1[6], o1[7]);
            *(uint4*)(BT + ((size_t)bg * 128 + cp * 2) * 2048 + t) = q0; *(uint4*)(BT + ((size_t)bg * 128 + cp * 2 + 1) * 2048 + t) = q1; }
    }
}

__device__ void ssd_unit(CPAR p, int l, int b, int hd, unsigned char* shm) {
    const int tid = lt_tid(), lane = tid & 63, wv = __builtin_amdgcn_readfirstlane(tid >> 6), quad = lane >> 4, l15 = lane & 15;
    constexpr int OSET = 64 * 136 * 2 + 128 * 72 + 64 * 72;
    bf16_t* OB = (bf16_t*)shm;
    bf16_t* Ls = OB + 2 * OSET;
    bf16_t* Ss = Ls + 64 * 72;
    bf16_t* Yw = Ss + 64 * 136;
    float* dtb = (float*)(Yw + 64 * 72);
    const int g = hd >> 3, bg = b * 2 + g;
    const float a = -expf(p.a_log[l * 16 + hd]), dbias = p.dt_bias[l * 16 + hd], dsk = p.ssd_d[l * 16 + hd];
    for (int i = tid; i < 64 * 136 / 2; i += 512) ((unsigned*)Ss)[i] = 0u;
    const size_t row_base = (size_t)b * SEQL;
    const bf16_t* Bn = p.bcb + (size_t)bg * 2048 * 128; const bf16_t* Cn = Bn + (size_t)32 * 2048 * 128; const bf16_t* BT = p.bcb + (size_t)2 * 32 * 2048 * 128 + (size_t)bg * 128 * 2048;
#define SSD_SCAN(DST) do { float* _d = (DST); const float v = dtr + dbias; const float dt = v > 20.f ? v : __logf(1.f + __expf(v)); float da = dt * a; \
        _Pragma("unroll") for (int o = 1; o < 64; o <<= 1) { const float n = __shfl_up(da, o); if (lane >= o) da += n; } \
        const float al = __shfl(da, 63); _d[lane] = dt; _d[64 + lane] = da; _d[128 + lane] = dt * __expf(al - da); _d[192 + lane] = __expf(da); } while (0)
    if (wv < 4) {
        const int st = tid;
        const int xcp = st & 31, xtg = st >> 5, xch = hd * 64 + xcp * 2;
        const float* cw = p.conv_w + (size_t)l * 4 * 1536 + xch; const float* cb = p.conv_b + l * 1536 + xch;
        const float w00 = cw[0], w01 = cw[1536], w02 = cw[3072], w03 = cw[4608], w10 = cw[1], w11 = cw[1537], w12 = cw[3073], w13 = cw[4609], b0 = cb[0], b1 = cb[1];
        const bf16_t* xsrc = p.proj + (row_base + xtg * 8) * LDP + C_XBC + xch;
        uint4 pb0, pb1, pb2, pb3, pc0, pc1, pc2, pc3, pt0, pt1, pt2, pt3; unsigned xr[11]; float dtr = 0.f;
#define SSD_LD1(I, PB, PC, T0) do { const int q = st + (I) * 256; PB = *(const uint4*)(Bn + (size_t)(T0) * 128 + q * 8); PC = *(const uint4*)(Cn + (size_t)(T0) * 128 + q * 8); } while (0)
#define SSD_LDT(I, PT, T0) do { const int q = st + (I) * 256; PT = *(const uint4*)(BT + (size_t)(q >> 3) * 2048 + (T0) + (q & 7) * 8); } while (0)
#define SSD_LOAD_T(T0) do { SSD_LDT(0, pt0, T0); SSD_LDT(1, pt1, T0); SSD_LDT(2, pt2, T0); SSD_LDT(3, pt3, T0); } while (0)
#define SSD_LOAD(T0) do { SSD_LD1(0, pb0, pc0, T0); SSD_LD1(1, pb1, pc1, T0); SSD_LD1(2, pb2, pc2, T0); SSD_LD1(3, pb3, pc3, T0); \
            xr[0] = ((T0) + xtg * 8 - 3 >= 0) ? *(const unsigned*)(xsrc + ((ptrdiff_t)(T0) - 3) * LDP) : 0u; \
            xr[1] = ((T0) + xtg * 8 - 2 >= 0) ? *(const unsigned*)(xsrc + ((ptrdiff_t)(T0) - 2) * LDP) : 0u; \
            xr[2] = ((T0) + xtg * 8 - 1 >= 0) ? *(const unsigned*)(xsrc + ((ptrdiff_t)(T0) - 1) * LDP) : 0u; \
            xr[3] = *(const unsigned*)(xsrc + ((ptrdiff_t)(T0) + 0) * LDP); xr[4] = *(const unsigned*)(xsrc + ((ptrdiff_t)(T0) + 1) * LDP); \
            xr[5] = *(const unsigned*)(xsrc + ((ptrdiff_t)(T0) + 2) * LDP); xr[6] = *(const unsigned*)(xsrc + ((ptrdiff_t)(T0) + 3) * LDP); \
            xr[7] = *(const unsigned*)(xsrc + ((ptrdiff_t)(T0) + 4) * LDP); xr[8] = *(const unsigned*)(xsrc + ((ptrdiff_t)(T0) + 5) * LDP); \
            xr[9] = *(const unsigned*)(xsrc + ((ptrdiff_t)(T0) + 6) * LDP); xr[10] = *(const unsigned*)(xsrc + ((ptrdiff_t)(T0) + 7) * LDP); \
            if (wv == 0) dtr = p.dtraw[(row_base + (T0) + lane) * 16 + hd]; } while (0)
#define SSD_CB1(I, PB, PC, SET) do { const int q = st + (I) * 256; const int row = q >> 4, c16 = q & 15; *(uint4*)((SET) + row * 136 + c16 * 8) = PC; *(uint4*)((SET) + 64 * 136 + row * 136 + c16 * 8) = PB; } while (0)
#define SSD_PART1(SET) do { bf16_t* _s = (SET); SSD_CB1(0, pb0, pc0, _s); SSD_CB1(1, pb1, pc1, _s); SSD_CB1(2, pb2, pc2, _s); SSD_CB1(3, pb3, pc3, _s); \
            float o0[8], o1[8]; \
            _Pragma("unroll") for (int j = 0; j < 8; ++j) { o0[j] = siluf_(b0 + w00 * bflo(xr[j]) + w01 * bflo(xr[j + 1]) + w02 * bflo(xr[j + 2]) + w03 * bflo(xr[j + 3])); o1[j] = siluf_(b1 + w10 * bfhi(xr[j]) + w11 * bfhi(xr[j + 1]) + w12 * bfhi(xr[j + 2]) + w13 * bfhi(xr[j + 3])); } \
            uint4 q0, q1; q0.x = pk2(o0[0], o0[1]); q0.y = pk2(o0[2], o0[3]); q0.z = pk2(o0[4], o0[5]); q0.w = pk2(o0[6], o0[7]); \
            q1.x = pk2(o1[0], o1[1]); q1.y = pk2(o1[2], o1[3]); q1.z = pk2(o1[4], o1[5]); q1.w = pk2(o1[6], o1[7]); \
            bf16_t* _xt = _s + 2 * 64 * 136 + 128 * 72; *(uint4*)(_xt + (xcp * 2) * 72 + xtg * 8) = q0; *(uint4*)(_xt + (xcp * 2 + 1) * 72 + xtg * 8) = q1; } while (0)
#define SSD_BT1(I, PT, SET, SCV) do { const int q = st + (I) * 256; const int n = q >> 3, tg = q & 7; const float* sv = (SCV) + tg * 8; uint4 r; \
            r.x = pk2(bflo(PT.x) * sv[0], bfhi(PT.x) * sv[1]); r.y = pk2(bflo(PT.y) * sv[2], bfhi(PT.y) * sv[3]); r.z = pk2(bflo(PT.z) * sv[4], bfhi(PT.z) * sv[5]); r.w = pk2(bflo(PT.w) * sv[6], bfhi(PT.w) * sv[7]); \
            *(uint4*)((SET) + 2 * 64 * 136 + n * 72 + tg * 8) = r; } while (0)
#define SSD_PART2(SET, SCV) do { bf16_t* _s = (SET); const float* _v = (SCV); SSD_BT1(0, pt0, _s, _v); SSD_BT1(1, pt1, _s, _v); SSD_BT1(2, pt2, _s, _v); SSD_BT1(3, pt3, _s, _v); } while (0)
        SSD_LOAD(0); SSD_LOAD_T(0);
        if (wv == 0) SSD_SCAN(dtb);
        SSD_PART1(OB);
        SSD_LOAD(64);
        BAR_LDS();
        SSD_PART2(OB, dtb + 128);
        SSD_LOAD_T(64);
        BAR_LDS();
        for (int c = 0; c < 32; ++c) {
            bf16_t* nset = OB + ((c + 1) & 1) * OSET; float* ndt = dtb + ((c + 1) & 1) * 256;
            if (c < 31) { if (wv == 0) SSD_SCAN(ndt); SSD_PART1(nset); if (c < 30) SSD_LOAD((c + 2) * 64); }
            BAR_LDS();
            if (c < 31) { SSD_PART2(nset, ndt + 128); if (c < 30) SSD_LOAD_T((c + 2) * 64); }
            BAR_LDS();
        }
#undef SSD_LD1
#undef SSD_LDT
#undef SSD_LOAD_T
#undef SSD_LOAD
#undef SSD_CB1
#undef SSD_PART1
#undef SSD_BT1
#undef SSD_PART2
    } else {
        const int mt = wv - 4;
        f32x4 accS[8];
#pragma unroll
        for (int i = 0; i < 8; ++i) accS[i] = (f32x4){0.f, 0.f, 0.f, 0.f};
        const int orow = mt * 16 + (lane >> 2), ocol = (lane & 3) * 16;
        bf16_t* zbase = p.proj + (row_base + orow) * LDP + C_Z + hd * 64 + ocol;
        uint4 zc0, zc1;
        BAR_LDS();
        zc0 = *(const uint4*)zbase; zc1 = *(const uint4*)(zbase + 8);
        BAR_LDS();
        for (int c = 0; c < 32; ++c) {
            const int t0 = c * 64;
            const bf16_t* Cs = OB + (c & 1) * OSET; const bf16_t* Bs = Cs + 64 * 136; const bf16_t* BscT = Bs + 64 * 136; const bf16_t* XT = BscT + 128 * 72;
            const float* dtv = dtb + (c & 1) * 256; const float* acum = dtv + 64; const float* eav = dtv + 192;
            f32x4 accY[4], accT[4];
#pragma unroll
            for (int i = 0; i < 4; ++i) { accY[i] = (f32x4){0.f, 0.f, 0.f, 0.f}; accT[i] = (f32x4){0.f, 0.f, 0.f, 0.f}; }
            { const bf16_t* ap = Cs + (mt * 16 + l15) * 136 + quad * 8; const bf16_t* bp = Bs + l15 * 136 + quad * 8; const bf16_t* sp = Ss + l15 * 136 + quad * 8;
              bf16x8 fa[2], fb[2][4], fs[2][4];
              fa[0] = *(const bf16x8*)ap;
#pragma unroll
              for (int nt = 0; nt < 4; ++nt) { fb[0][nt] = *(const bf16x8*)(bp + nt * 16 * 136); fs[0][nt] = *(const bf16x8*)(sp + nt * 16 * 136); }
#pragma unroll
              for (int ks = 0; ks < 4; ++ks) { const int cur = ks & 1, nxt = cur ^ 1;
                  if (ks < 3) { fa[nxt] = *(const bf16x8*)(ap + (ks + 1) * 32);
#pragma unroll
                      for (int nt = 0; nt < 4; ++nt) { fb[nxt][nt] = *(const bf16x8*)(bp + nt * 16 * 136 + (ks + 1) * 32); fs[nxt][nt] = *(const bf16x8*)(sp + nt * 16 * 136 + (ks + 1) * 32); } }
                  __builtin_amdgcn_sched_barrier(0);
#pragma unroll
                  for (int nt = 0; nt < 4; ++nt) { accT[nt] = MFMA16(fa[cur], fb[cur][nt], accT[nt]); accY[nt] = MFMA16(fa[cur], fs[cur][nt], accY[nt]); }
                  __builtin_amdgcn_sched_barrier(0); } }
#pragma unroll
            for (int nt = 0; nt < 4; ++nt) { const int scol = nt * 16 + l15; const float as = acum[scol], ds = dtv[scol];
#pragma unroll
                for (int j = 0; j < 4; ++j) { const int lrow = mt * 16 + quad * 4 + j; const float v = (scol <= lrow) ? accT[nt][j] * __expf(acum[lrow] - as) * ds : 0.f; Ls[lrow * 72 + scol] = (bf16_t)f2bf(v); accY[nt][j] *= eav[lrow]; } }
            BAR_LDS();
            mma_lds_n<4, 64>(Ls + mt * 16 * 72, 72, XT, 72, 16 * 72, accY, lane);
#pragma unroll
            for (int nt = 0; nt < 4; ++nt) { const int pcol = nt * 16 + l15;
#pragma unroll
                for (int j = 0; j < 4; ++j) { const int lrow = mt * 16 + quad * 4 + j; Yw[lrow * 72 + pcol] = (bf16_t)f2bf(accY[nt][j] + dsk * bf2f(XT[pcol * 72 + lrow])); } }
            { const float cdec = __expf(acum[63]);
#pragma unroll
              for (int i = 0; i < 8; ++i) accS[i] *= cdec;
              mma_lds_n<8, 64>(XT + mt * 16 * 72, 72, BscT, 72, 16 * 72, accS, lane);
#pragma unroll
              for (int i = 0; i < 8; ++i)
#pragma unroll
                  for (int j = 0; j < 4; ++j) Ss[(mt * 16 + quad * 4 + j) * 136 + i * 16 + l15] = (bf16_t)f2bf(accS[i][j]); }
            { const uint4 y0 = *(const uint4*)(Yw + orow * 72 + ocol), y1 = *(const uint4*)(Yw + orow * 72 + ocol + 8); float sq = 0.f; uint4 r0, r1;
#define SSD_OUT(DST, YW, ZW) do { const float z0 = bflo(ZW), z1 = bfhi(ZW); const float v0 = bflo(YW) * z0 * __builtin_amdgcn_rcpf(1.f + __expf(-z0)), v1 = bfhi(YW) * z1 * __builtin_amdgcn_rcpf(1.f + __expf(-z1)); sq += v0 * v0 + v1 * v1; DST = pk2(v0, v1); } while (0)
              SSD_OUT(r0.x, y0.x, zc0.x); SSD_OUT(r0.y, y0.y, zc0.y); SSD_OUT(r0.z, y0.z, zc0.z); SSD_OUT(r0.w, y0.w, zc0.w);
              SSD_OUT(r1.x, y1.x, zc1.x); SSD_OUT(r1.y, y1.y, zc1.y); SSD_OUT(r1.z, y1.z, zc1.z); SSD_OUT(r1.w, y1.w, zc1.w);
#undef SSD_OUT
              sq += __shfl_xor(sq, 1); sq += __shfl_xor(sq, 2);
              if ((lane & 3) == 0) *(float2*)(p.ss_ssd + (row_base + t0 + orow) * 32 + hd * 2) = make_float2(sq, 0.f);
              bf16_t* zp = zbase + (size_t)t0 * LDP; *(uint4*)zp = r0; *(uint4*)(zp + 8) = r1;
              if (c < 31) { zc0 = *(const uint4*)(zp + (size_t)64 * LDP); zc1 = *(const uint4*)(zp + (size_t)64 * LDP + 8); } }
            BAR_LDS();
        }
    }
#undef SSD_SCAN
    __syncthreads();
}

__device__ void hgrn_unit(CPAR p, int l, int b, int head, int vh, unsigned char* shm) {
    const int tid = lt_tid(), lane = tid & 63, wv = tid >> 6, quad = lane >> 4, l15 = lane & 15;
    bf16_t* Qm = (bf16_t*)shm;
    bf16_t* Km = Qm + 64 * 136;
    bf16_t* Qs = Km + 64 * 136;
    bf16_t* KhT = Qs + 64 * 136;
    bf16_t* VT = KhT + 128 * 72;
    bf16_t* At = VT + 64 * 72;
    bf16_t* Ob = At + 64 * 72;
    bf16_t* ST = Ob + 64 * 72;
    float* dec = (float*)(ST + 64 * 136);
    float* seg = dec + 128;
    for (int i = tid; i < 64 * 136 / 2; i += 512) ((unsigned*)ST)[i] = 0u;
    f32x4 accS[4];
#pragma unroll
    for (int i = 0; i < 4; ++i) accS[i] = (f32x4){0.f, 0.f, 0.f, 0.f};
    const int kp = tid & 63, lq = tid >> 6, k0 = 2 * kp, vp = tid & 31, vl = tid >> 5, orow = (wv >> 1) * 16 + (lane >> 2), oc8 = (wv & 1) * 4 + (lane & 3);
    const float lb0 = p.lb[l * 512 + head * 128 + k0], lb1 = p.lb[l * 512 + head * 128 + k0 + 1], om0 = 1.f - lb0, om1 = 1.f - lb1;
    const size_t row_base = (size_t)b * SEQL;
    const bf16_t* qbase = p.proj + (row_base + lq * 8) * LDP + C_Q + head * 128 + k0;
    const bf16_t* vbase = p.proj + (row_base + vl * 4) * LDP + C_I + head * 128 + vh * 64 + 2 * vp;
    bf16_t* gbase = p.proj + (row_base + orow) * LDP + C_G + head * 128 + vh * 64 + oc8 * 8;
    unsigned qr[8], fr[8], vr[4]; uint4 gr;
#pragma unroll
    for (int i = 0; i < 8; ++i) { qr[i] = *(const unsigned*)(qbase + (size_t)i * LDP); fr[i] = *(const unsigned*)(qbase + (size_t)i * LDP + (C_F - C_Q)); }
#pragma unroll
    for (int i = 0; i < 4; ++i) vr[i] = *(const unsigned*)(vbase + (size_t)i * LDP);
    gr = *(const uint4*)gbase;
    for (int c = 0; c < 32; ++c) {
        const int t0 = c * 64;
        float qv0[8], qv1[8], P0[8], P1[8], kk0[8], kk1[8];
#pragma unroll
        for (int i = 0; i < 8; ++i) { const float q0 = bflo(qr[i]), q1 = bfhi(qr[i]), f0 = fmaxf(bflo(fr[i]), -80.f), f1 = fmaxf(bfhi(fr[i]), -80.f);
            const float fv0 = lb0 + om0 * __builtin_amdgcn_rcpf(1.f + __expf(-f0)), fv1 = lb1 + om1 * __builtin_amdgcn_rcpf(1.f + __expf(-f1));
            P0[i] = fv0; P1[i] = fv1; kk0[i] = 1.f - fv0; kk1[i] = 1.f - fv1;
            qv0[i] = q0 * __builtin_amdgcn_rcpf(1.f + __expf(-q0)); qv1[i] = q1 * __builtin_amdgcn_rcpf(1.f + __expf(-q1)); }
        P0[0] = fmaxf(P0[0], 1e-37f); P1[0] = fmaxf(P1[0], 1e-37f);
#pragma unroll
        for (int i = 1; i < 8; ++i) { P0[i] = fmaxf(P0[i] * P0[i - 1], 1e-37f); P1[i] = fmaxf(P1[i] * P1[i - 1], 1e-37f); }
        const float lfl0 = __logf(P0[7]), lfl1 = __logf(P1[7]);
        *(float2*)(seg + lq * 128 + k0) = make_float2(lfl0, lfl1);
        const unsigned v0 = vr[0], v1 = vr[1], v2 = vr[2], v3 = vr[3]; const uint4 gcur = gr;
        if (c < 31) {
            const size_t adv = (size_t)(t0 + 64) * LDP;
#pragma unroll
            for (int i = 0; i < 8; ++i) { qr[i] = *(const unsigned*)(qbase + adv + (size_t)i * LDP); fr[i] = *(const unsigned*)(qbase + adv + (size_t)i * LDP + (C_F - C_Q)); }
#pragma unroll
            for (int i = 0; i < 4; ++i) vr[i] = *(const unsigned*)(vbase + adv + (size_t)i * LDP);
            gr = *(const uint4*)(gbase + adv);
        }
        BAR_LDS();
        float off0 = 0.f, off1 = 0.f, tot0 = 0.f, tot1 = 0.f, mid0 = 0.f, mid1 = 0.f;
#pragma unroll
        for (int j = 0; j < 8; ++j) { const float2 s = *(const float2*)(seg + j * 128 + k0); if (j < lq) { off0 += s.x; off1 += s.y; } if (j < 4) { mid0 += s.x; mid1 += s.y; } tot0 += s.x; tot1 += s.y; }
        const float emid0 = __expf(mid0), emid1 = __expf(mid1), etm0 = __expf(tot0 - mid0), etm1 = __expf(tot1 - mid1);
        float kh0[8], kh1[8];
        const float a0 = off0 - mid0, a1 = off1 - mid1;
        if (fabsf(a0) <= 80.f && fabsf(a0 + lfl0) <= 80.f && fabsf(a1) <= 80.f && fabsf(a1 + lfl1) <= 80.f) {
            const float E0 = __expf(a0), E1 = __expf(a1);
            float r0 = __builtin_amdgcn_rcpf(E0 * P0[7]), r1 = __builtin_amdgcn_rcpf(E1 * P1[7]);
#pragma unroll
            for (int i = 7; i >= 0; --i) { const int lrow = lq * 8 + i; const float e0 = E0 * P0[i], e1 = E1 * P1[i];
                const float qm0 = qv0[i] * e0, qm1 = qv1[i] * e1, km0 = kk0[i] * r0, km1 = kk1[i] * r1;
                kh0[i] = km0 * etm0; kh1[i] = km1 * etm1;
                *(unsigned*)(Qm + lrow * 136 + k0) = pk2(qm0, qm1); *(unsigned*)(Km + lrow * 136 + k0) = pk2(km0, km1); *(unsigned*)(Qs + lrow * 136 + k0) = pk2(qm0 * emid0, qm1 * emid1);
                r0 *= (1.f - kk0[i]); r1 *= (1.f - kk1[i]); }
        } else {
#pragma unroll
            for (int i = 0; i < 8; ++i) { const int lrow = lq * 8 + i; const float cum0 = off0 + __logf(P0[i]), cum1 = off1 + __logf(P1[i]), d0 = cum0 - mid0, d1 = cum1 - mid1;
                const float qm0 = qv0[i] * __expf(fminf(fmaxf(d0, -80.f), 80.f)), km0 = kk0[i] * __expf(fminf(fmaxf(-d0, -80.f), 80.f)), qs0 = qv0[i] * __expf(cum0);
                const float qm1 = qv1[i] * __expf(fminf(fmaxf(d1, -80.f), 80.f)), km1 = kk1[i] * __expf(fminf(fmaxf(-d1, -80.f), 80.f)), qs1 = qv1[i] * __expf(cum1);
                kh0[i] = kk0[i] * __expf(tot0 - cum0); kh1[i] = kk1[i] * __expf(tot1 - cum1);
                *(unsigned*)(Qm + lrow * 136 + k0) = pk2(qm0, qm1); *(unsigned*)(Km + lrow * 136 + k0) = pk2(km0, km1); *(unsigned*)(Qs + lrow * 136 + k0) = pk2(qs0, qs1); }
        }
        { uint4 q0, q1; q0.x = pk2(kh0[0], kh0[1]); q0.y = pk2(kh0[2], kh0[3]); q0.z = pk2(kh0[4], kh0[5]); q0.w = pk2(kh0[6], kh0[7]);
          q1.x = pk2(kh1[0], kh1[1]); q1.y = pk2(kh1[2], kh1[3]); q1.z = pk2(kh1[4], kh1[5]); q1.w = pk2(kh1[6], kh1[7]);
          *(uint4*)(KhT + k0 * 72 + lq * 8) = q0; *(uint4*)(KhT + (k0 + 1) * 72 + lq * 8) = q1; }
        if (lq == 0) *(float2*)(dec + k0) = make_float2(__expf(tot0), __expf(tot1));
        { uint2 a, bq; a.x = (v0 & 0xffffu) | (v1 << 16); a.y = (v2 & 0xffffu) | (v3 << 16); bq.x = (v0 >> 16) | (v1 & 0xffff0000u); bq.y = (v2 >> 16) | (v3 & 0xffff0000u);
          *(uint2*)(VT + (2 * vp) * 72 + vl * 4) = a; *(uint2*)(VT + (2 * vp + 1) * 72 + vl * 4) = bq; }
        BAR_LDS();
        const int mt = wv >> 1, vtb = (wv & 1) * 2;
        f32x4 accO[2], accA[2];
#pragma unroll
        for (int i = 0; i < 2; ++i) { accO[i] = (f32x4){0.f, 0.f, 0.f, 0.f}; accA[i] = (f32x4){0.f, 0.f, 0.f, 0.f}; }
        mma_lds_s<2, 128>(Qm + mt * 16 * 136, 136, Km + vtb * 16 * 136, 136, 16 * 136, accA, lane);
        mma_lds_s<2, 128>(Qs + mt * 16 * 136, 136, ST + vtb * 16 * 136, 136, 16 * 136, accO, lane);
#pragma unroll
        for (int i = 0; i < 2; ++i) { const int scol = (vtb + i) * 16 + l15;
#pragma unroll
            for (int j = 0; j < 4; ++j) { const int lrow = mt * 16 + quad * 4 + j; At[lrow * 72 + scol] = (bf16_t)f2bf(scol <= lrow ? accA[i][j] : 0.f); } }
        BAR_LDS();
        mma_lds_s<2, 64>(At + mt * 16 * 72, 72, VT + vtb * 16 * 72, 72, 16 * 72, accO, lane);
#pragma unroll
        for (int i = 0; i < 2; ++i) { const int nt = vtb + i;
#pragma unroll
            for (int j = 0; j < 4; ++j) Ob[(mt * 16 + quad * 4 + j) * 72 + nt * 16 + l15] = (bf16_t)f2bf(accO[i][j]); }
        const int vts = wv & 3;
#pragma unroll
        for (int i = 0; i < 4; ++i) accS[i] *= dec[((wv >> 2) * 4 + i) * 16 + l15];
        mma_lds_s<4, 64>(VT + vts * 16 * 72, 72, KhT + (wv >> 2) * 4 * 16 * 72, 72, 16 * 72, accS, lane);
#pragma unroll
        for (int i = 0; i < 4; ++i) { const int ktile = (wv >> 2) * 4 + i;
#pragma unroll
            for (int j = 0; j < 4; ++j) ST[(vts * 16 + quad * 4 + j) * 136 + ktile * 16 + l15] = (bf16_t)f2bf(accS[i][j]); }
        { const uint4 ow = *(const uint4*)(Ob + orow * 72 + oc8 * 8); const unsigned ou[4] = {ow.x, ow.y, ow.z, ow.w}, gu[4] = {gcur.x, gcur.y, gcur.z, gcur.w}; unsigned res[4]; float sq = 0.f;
#pragma unroll
          for (int i = 0; i < 4; ++i) { const float o0 = bflo(ou[i]), o1 = bfhi(ou[i]), g0 = bflo(gu[i]), g1 = bfhi(gu[i]); sq += o0 * o0 + o1 * o1;
              res[i] = pk2(o0 * g0 * __builtin_amdgcn_rcpf(1.f + __expf(-g0)), o1 * g1 * __builtin_amdgcn_rcpf(1.f + __expf(-g1))); }
          sq += __shfl_xor(sq, 1); sq += __shfl_xor(sq, 2);
          if ((lane & 3) == 0) p.ss_hg[(row_base + t0 + orow) * 16 + head * 4 + vh * 2 + (wv & 1)] = sq;
          *(uint4*)(gbase + (size_t)t0 * LDP) = make_uint4(res[0], res[1], res[2], res[3]); }
    }
    __syncthreads();
}

__device__ void s5_unit(CPAR p, int l, int g, int b, unsigned char* shm) {
    const int tid = lt_tid(), lane = tid & 63, wv = tid >> 6, quad = lane >> 4, l15 = lane & 15;
    bf16_t* U = (bf16_t*)shm;
    float* St = (float*)(shm + 66560);
    bf16_t* Sin = (bf16_t*)(shm + 66560 + 33280);
    const size_t row_base = (size_t)b * SEQL;
    for (int i = tid; i < 4096; i += 512) { const int tok = i >> 1, hf = i & 1; const uint4 v = *(const uint4*)(p.proj + (row_base + tok) * LDP + C_U + g * 16 + hf * 8);
        *(uint4*)(U + (tok >> 5) * 520 + (tok & 31) * 16 + hf * 8) = v; }
    __syncthreads();
    {
        f32x4 acc[4];
#pragma unroll
        for (int n = 0; n < 4; ++n) acc[n] = (f32x4){0.f, 0.f, 0.f, 0.f};
        const bf16_t* ap = p.wst + (size_t)(l & 1) * 32 * 65536 + (size_t)g * 65536 + (wv * 16 + l15) * 512 + quad * 8;
        bf16x8 af[16];
#pragma unroll
        for (int ks = 0; ks < 16; ++ks) af[ks] = *(const bf16x8*)(ap + ks * 32);
        const bf16_t* ub = U + l15 * 520 + quad * 8;
        bf16x8 fb[2][4];
#pragma unroll
        for (int n = 0; n < 4; ++n) fb[0][n] = *(const bf16x8*)(ub + n * 16 * 520);
#pragma unroll
        for (int ks = 0; ks < 16; ++ks) { const int cur = ks & 1, nxt = cur ^ 1;
            if (ks < 15) {
#pragma unroll
                for (int n = 0; n < 4; ++n) fb[nxt][n] = *(const bf16x8*)(ub + n * 16 * 520 + (ks + 1) * 32); }
            __builtin_amdgcn_sched_barrier(0);
#pragma unroll
            for (int n = 0; n < 4; ++n) acc[n] = MFMA16(af[ks], fb[cur][n], acc[n]);
            __builtin_amdgcn_sched_barrier(0); }
#pragma unroll
        for (int n = 0; n < 4; ++n)
#pragma unroll
            for (int j = 0; j < 4; ++j) St[(wv * 16 + quad * 4 + j) * 65 + n * 16 + l15] = acc[n][j];
    }
    __syncthreads();
    if (tid < 64) { const float* aT = p.aT + (l & 1) * 32 * 64 * 2; const float ar = aT[(g * 64 + tid) * 2], ai = aT[(g * 64 + tid) * 2 + 1]; float sr = 0.f, si = 0.f;
#pragma unroll 8
        for (int c = 0; c < 64; ++c) { Sin[c * 136 + tid] = (bf16_t)f2bf(sr); Sin[c * 136 + 64 + tid] = (bf16_t)f2bf(si);
            const float lr = St[tid * 65 + c], li = St[(64 + tid) * 65 + c]; const float nr = ar * sr - ai * si + lr, ni = ar * si + ai * sr + li; sr = nr; si = ni; } }
    __syncthreads();
    bf16_t* Kt = (bf16_t*)St;
    { const uint4* ksrc = (const uint4*)(p.ktab + (size_t)(l & 1) * 32 * 8192 + (size_t)g * 8192); uint4* kdst = (uint4*)Kt; kdst[tid] = ksrc[tid]; kdst[tid + 512] = ksrc[tid + 512]; }
    __syncthreads();
    const float4 dsk = *(const float4*)(p.s5_d + l * 512 + g * 16 + quad * 4);
    for (int it = 0; it < 4; ++it) {
        const int t = (it & 1) ? (8 * it + 7 - wv) : (8 * it + wv);
        f32x4 acc[4];
#pragma unroll
        for (int n = 0; n < 4; ++n) acc[n] = (f32x4){0.f, 0.f, 0.f, 0.f};
        const bf16_t* wp = p.woff + (size_t)(l & 1) * 32 * 65536 + (size_t)g * 65536 + (t * 16 + l15) * 128 + quad * 8;
        bf16x8 wf[4];
#pragma unroll
        for (int ks = 0; ks < 4; ++ks) wf[ks] = *(const bf16x8*)(wp + ks * 32);
        const bf16_t* kt = Kt + l15 * 16 + (quad & 1) * 8;
        {
            const bf16_t* ub = U + l15 * 520 + quad * 8; const int jmax = t >> 1; const bf16x8 zf = (bf16x8){0, 0, 0, 0, 0, 0, 0, 0};
            bf16x8 ac, an = zf, bc[4], bn[4];
            { const int lag = t - (quad >> 1); ac = zf; if (lag >= 0) ac = *(const bf16x8*)(kt + lag * 256); }
#pragma unroll
            for (int n = 0; n < 4; ++n) { bc[n] = *(const bf16x8*)(ub + n * 16 * 520); bn[n] = zf; }
            for (int j = 0; j <= jmax; ++j) {
                if (j < jmax) { const int lag = t - 2 * (j + 1) - (quad >> 1); an = zf; if (lag >= 0) an = *(const bf16x8*)(kt + lag * 256);
#pragma unroll
                    for (int n = 0; n < 4; ++n) bn[n] = *(const bf16x8*)(ub + n * 16 * 520 + (j + 1) * 32); }
                __builtin_amdgcn_sched_barrier(0);
#pragma unroll
                for (int n = 0; n < 4; ++n) acc[n] = MFMA16(ac, bc[n], acc[n]);
                __builtin_amdgcn_sched_barrier(0);
                ac = an;
#pragma unroll
                for (int n = 0; n < 4; ++n) bc[n] = bn[n]; }
        }
        {
            const bf16_t* sb = Sin + l15 * 136 + quad * 8;
            bf16x8 fb[2][4];
#pragma unroll
            for (int n = 0; n < 4; ++n) fb[0][n] = *(const bf16x8*)(sb + n * 16 * 136);
#pragma unroll
            for (int ks = 0; ks < 4; ++ks) { const int cur = ks & 1, nxt = cur ^ 1;
                if (ks < 3) {
#pragma unroll
                    for (int n = 0; n < 4; ++n) fb[nxt][n] = *(const bf16x8*)(sb + n * 16 * 136 + (ks + 1) * 32); }
                __builtin_amdgcn_sched_barrier(0);
#pragma unroll
                for (int n = 0; n < 4; ++n) acc[n] = MFMA16(wf[ks], fb[cur][n], acc[n]);
                __builtin_amdgcn_sched_barrier(0); }
        }
#pragma unroll
        for (int n = 0; n < 4; ++n) { const int c = n * 16 + l15; const uint2 uw = *(const uint2*)(U + c * 520 + t * 16 + quad * 4);
            float y[4] = {acc[n][0] + dsk.x * bflo(uw.x), acc[n][1] + dsk.y * bfhi(uw.x), acc[n][2] + dsk.z * bflo(uw.y), acc[n][3] + dsk.w * bfhi(uw.y)};
#pragma unroll
            for (int j = 0; j < 4; ++j) { const float z = 0.7978845608f * (y[j] + 0.044715f * y[j] * y[j] * y[j]); const float th = 1.f - 2.f / (__expf(2.f * z) + 1.f); y[j] = 0.5f * y[j] * (1.f + th); }
            uint2 w; w.x = pk2(y[0], y[1]); w.y = pk2(y[2], y[3]);
            *(uint2*)(p.proj + (row_base + c * 32 + t) * LDP + C_U + g * 16 + quad * 4) = w; }
    }
    __syncthreads();
}

__device__ void phase_mixA(CPAR p, int l, unsigned char* shm) {
    const int G = gridDim.x, bid = lt_bid();
    const bool split = (G == 256);
    for (int u = bid; u < 256; u += G) bcconv_unit(p, l, u);
    TSTAMP(6);
    for (int u = (split && bid >= 128) ? 128 : bid; u < 128; u += G) hgrn_unit(p, l, u >> 3, (u >> 1) & 3, u & 1, shm);
    TSTAMP(7);
    { int u0 = bid, u1 = 512, st = G; if (split) { u0 = bid >= 128 ? (bid - 128) * 4 : 512; u1 = bid >= 128 ? u0 + 4 : 512; st = 1; }
      for (int u = u0; u < u1; u += st) s5_unit(p, l, u >> 4, u & 15, shm); }
    TSTAMP(8);
    if (l < 3 && (!split || bid >= 128)) convert_weights(p, l + 1, split ? bid - 128 : bid, split ? 128 : G, shm);
    TSTAMP(10);
}
__device__ void phase_mixB(CPAR p, int l, unsigned char* shm) {
    const int G = gridDim.x, bid = lt_bid();
    for (int u = bid; u < 256; u += G) ssd_unit(p, l, u >> 4, u & 15, shm);
    TSTAMP(9);
}

__device__ __forceinline__ void fin_scales(CPAR p, int row, int lane, float (&sc)[4]) {
    float a0 = 0.f, a1 = 0.f, hh = 0.f, cc = 0.f;
    const float4* s1 = (const float4*)(p.ss_ssd + (size_t)row * 32);
#pragma unroll
    for (int i = 0; i < 4; ++i) { const float4 u = s1[i], v = s1[4 + i]; a0 += u.x + u.y + u.z + u.w; a1 += v.x + v.y + v.z + v.w; }
    { const float4 u = *(const float4*)(p.ss_hg + (size_t)row * 16 + (lane >> 4) * 4); hh = u.x + u.y + u.z + u.w; }
    const float4* s3 = (const float4*)(p.ss_s5 + (size_t)row * 16);
#pragma unroll
    for (int i = 0; i < 4; ++i) { const float4 u = s3[i]; cc += u.x + u.y + u.z + u.w; }
    sc[0] = rsqrtf(a0 * (1.f / 512.f) + EPSN); sc[1] = rsqrtf(a1 * (1.f / 512.f) + EPSN); sc[2] = rsqrtf(hh * (1.f / 128.f) + EPSN); sc[3] = rsqrtf(cc * (1.f / 512.f) + EPSN);
}
__device__ __forceinline__ uint4 scale8(uint4 v, float s) {
    v.x = pk2(bflo(v.x) * s, bfhi(v.x) * s); v.y = pk2(bflo(v.y) * s, bfhi(v.y) * s); v.z = pk2(bflo(v.z) * s, bfhi(v.z) * s); v.w = pk2(bflo(v.w) * s, bfhi(v.w) * s); return v;
}
__device__ void phase_fin(CPAR p) {
    const int tid = lt_tid(), lane = tid & 63, wv = tid >> 6;
    const int rstep = gridDim.x * 8;
    for (int row = lt_bid() * 8 + wv; row < NTOK; row += 2 * rstep) {
        const int row2 = row + rstep; const bool two = row2 < NTOK;
        uint4 va[4], vb[4]; float sa[4], sb[4];
#pragma unroll
        for (int i = 0; i < 4; ++i) { va[i] = *(const uint4*)(p.proj + (size_t)row * LDP + i * 512 + lane * 8); if (two) vb[i] = *(const uint4*)(p.proj + (size_t)row2 * LDP + i * 512 + lane * 8); }
        fin_scales(p, row, lane, sa); if (two) fin_scales(p, row2, lane, sb);
#pragma unroll
        for (int i = 0; i < 4; ++i) { *(uint4*)(p.proj + (size_t)row * LDP + i * 512 + lane * 8) = scale8(va[i], sa[i]); if (two) *(uint4*)(p.proj + (size_t)row2 * LDP + i * 512 + lane * 8) = scale8(vb[i], sb[i]); }
    }
}

__device__ void fill_seg_table(CPAR p, unsigned char* shm) {
    const int tid = lt_tid(), slot = tid >> 8, r = tid & 255;
    pg8::StaticOrder S; S.init(NTOK, 1024, (int)gridDim.x, lt_bid());
    pg8::Unit un; float* rt = (float*)(shm + 131072);
    if (S.next(slot, un)) {
        const size_t row = (size_t)un.pm * 256 + r; float ms[7];
        const float4* s1 = (const float4*)(p.ss_ssd + row * 32); float a0 = 0.f, a1 = 0.f;
#pragma unroll
        for (int i = 0; i < 4; ++i) { const float4 u = s1[i], v = s1[4 + i]; a0 += u.x + u.y + u.z + u.w; a1 += v.x + v.y + v.z + v.w; }
        ms[0] = a0 * (1.f / 512.f); ms[1] = a1 * (1.f / 512.f);
        const float4* s2 = (const float4*)(p.ss_hg + row * 16);
#pragma unroll
        for (int h = 0; h < 4; ++h) { const float4 u = s2[h]; ms[2 + h] = (u.x + u.y + u.z + u.w) * (1.f / 128.f); }
        const float4* s3 = (const float4*)(p.ss_s5 + row * 16); float cc = 0.f;
#pragma unroll
        for (int i = 0; i < 4; ++i) { const float4 u = s3[i]; cc += u.x + u.y + u.z + u.w; }
        ms[6] = cc * (1.f / 512.f);
        float sc[7];
#pragma unroll
        for (int i = 0; i < 7; ++i) sc[i] = rsqrtf(ms[i] + EPSN);
#pragma unroll
        for (int i = 0; i < 6; ++i) rt[(slot * 7 + i) * 256 + r] = sc[i] / sc[i + 1];
        rt[(slot * 7 + 6) * 256 + r] = sc[6];
    }
    __syncthreads();
}

template <class Epi> __device__ __forceinline__ void run_gemm(unsigned char* shm, const pg8::Gemm& g, const Epi& E) {
    pg8::StaticOrder S; S.init(g.M, g.N, (int)gridDim.x, lt_bid());
    pg8::gemm_phase<Epi, pg8::StaticOrder, false>((PG8_LAS unsigned char*)shm, g, S, E, nullptr);
}

__global__ __launch_bounds__(512, 2) void mega(Params p_unused) {
    extern __shared__ __attribute__((aligned(16))) unsigned char shm[];
    __shared__ uint4 xb_words;
    cg::grid_group grid = cg::this_grid();
    if (threadIdx.x == 0) xb_words = make_uint4(0u, 0u, 0u, 0u);
    __syncthreads();
    { CPAR p = *GETP(); (void)xcd_barrier_post(p.bar, (volatile LAS unsigned*)&xb_words); }
#define GSYNC() do { CPAR _q = *GETP(); XcdBarrier _b; _b.bar = _q.bar; _b.x = xb_xcc_id(); _b.st = (volatile LAS unsigned*)&xb_words; xcd_barrier(_b); } while (0)
#if TPROBE >= 0
    if (blockIdx.x == TBLK && threadIdx.x == 0) { CPAR _p = *GETP(); unsigned long long* _w = (unsigned long long*)_p.wdt; _w[0] = wall_clock64(); _w[1] = 0; }
#endif
#pragma unroll 1
    for (int l = 0; l < 4; ++l) {
#if PH & 1
        { CPAR p = *GETP(); phase_prep(p, l, shm); }
#endif
        if (l == 0) grid.sync(); else GSYNC();
        TSTAMP(0);
#if PH & 2
        { CPAR p = *GETP(); pg8::Gemm g{p.xb, p.winT + (size_t)(l & 1) * LDP * DM, NTOK, LDP, DM, DM}; EpiIn e{p.proj, p.rstd}; run_gemm(shm, g, e); }
#endif
        GSYNC(); TSTAMP(1);
#if PH & 4
        { CPAR p = *GETP(); phase_mixA(p, l, shm); }
#endif
        GSYNC(); TSTAMP(2);
#if PH & 4
        { CPAR p = *GETP(); phase_mixB(p, l, shm); }
#endif
#if PH & 8
        { CPAR p = *GETP(); pg8::Gemm g{p.proj + C_U, p.wgluT + (size_t)(l & 1) * 1024 * 512, NTOK, 1024, 512, LDP}; EpiGlu e{p.proj, p.glu_b + l * 1024, p.ss_s5}; run_gemm(shm, g, e); }
#endif
        GSYNC(); TSTAMP(3);
        { CPAR p = *GETP(); fill_seg_table(p, shm); }
        { CPAR p = *GETP(); pg8::Gemm g{p.proj, p.woutT + (size_t)(l & 1) * 1024 * 2048, NTOK, 1024, 2048, LDP}; EpiOutSeg e{p.proj}; run_gemm(shm, g, e); }
        GSYNC(); TSTAMP(5);
    }
#if PH & 1
    { CPAR p = *GETP(); phase_prep(p, 4, shm); }
#endif
#if TPROBE >= 0
    __syncthreads(); TSTAMP(0);
    grid.sync();
    if (blockIdx.x == TBLK && threadIdx.x == 0) { CPAR p = *GETP(); p.out[0] = (float)(((unsigned long long*)p.wdt)[1]) * 0.001f; }
#endif
}

extern "C" void kernel_launch(void* const* d_in, const int* in_sizes, int n_in, void* d_out, int out_size, void* d_ws, size_t ws_size, hipStream_t stream) {
    constexpr size_t kLds = 162816;
    static int grid_blocks = 0;
    if (!grid_blocks) {
        int dev = 0, cus = 0, per_cu = 0;
        hipGetDevice(&dev);
        hipDeviceGetAttribute(&cus, hipDeviceAttributeMultiprocessorCount, dev);
        hipFuncSetAttribute((const void*)mega, hipFuncAttributeMaxDynamicSharedMemorySize, (int)kLds);
        hipOccupancyMaxActiveBlocksPerMultiprocessor(&per_cu, mega, 512, kLds);
        if (per_cu < 1) per_cu = 1;
        grid_blocks = cus * per_cu;
        if (grid_blocks > 256) grid_blocks = 256;
        if (grid_blocks != 256) fprintf(stderr, "this build assumes a 256-workgroup grid (got %d)\n", grid_blocks);
    }
    Params p{};
    const float** f = (const float**)&p;
    for (int i = 0; i < 24; ++i) f[i] = (const float*)d_in[i];
    p.out = (float*)d_out;
    p.bcb = (bf16_t*)d_out;
    unsigned char* w = (unsigned char*)d_ws; size_t off = 0;
    auto take = [&](size_t bytes) { unsigned char* r = w + off; off += (bytes + 255) & ~(size_t)255; return r; };
    p.proj = (bf16_t*)take((size_t)NTOK * LDP * 2);
    p.xb = (bf16_t*)take((size_t)NTOK * DM * 2);
    p.winT = (bf16_t*)take((size_t)2 * LDP * DM * 2);
    p.woutT = (bf16_t*)take((size_t)2 * 1024 * 2048 * 2);
    p.wgluT = (bf16_t*)take((size_t)2 * 1024 * 512 * 2);
    p.ktab = (bf16_t*)take((size_t)2 * 32 * 8192 * 2);
    p.woff = (bf16_t*)take((size_t)2 * 32 * 65536 * 2);
    p.wst = (bf16_t*)take((size_t)2 * 32 * 65536 * 2);
    p.wdt = (float*)take(256);
    p.aT = (float*)take((size_t)2 * 32 * 64 * 2 * 4);
    p.lb = (float*)take((size_t)4 * 512 * 4);
    p.rstd = (float*)take((size_t)NTOK * 4);
    p.dtraw = (float*)take((size_t)NTOK * 16 * 4);
    p.ss_ssd = (float*)take((size_t)NTOK * 32 * 4);
    p.ss_hg = (float*)take((size_t)NTOK * 32 * 4);
    p.ss_s5 = (float*)take((size_t)NTOK * 16 * 4);
    p.bar = (unsigned*)take((size_t)XCD_BAR_WORDS * 4);
    if (off > ws_size) { fprintf(stderr, "workspace too small: need %zu have %zu\n", off, ws_size); return; }
    hipMemsetAsync(p.bar, 0, (size_t)XCD_BAR_WORDS * 4, stream);
    void* args[] = {&p};
    hipError_t e = hipLaunchCooperativeKernel((const void*)mega, dim3(grid_blocks), dim3(512), args, kLds, stream);
    if (e != hipSuccess) fprintf(stderr, "cooperative launch failed: %s (grid %d)\n", hipGetErrorString(e), grid_blocks);
}
```

```cpp
#include <hip/hip_runtime.h>
#include <hip/hip_cooperative_groups.h>
#include <cstdio>
namespace cg = cooperative_groups;
__device__ __forceinline__ int lt_tid() { int t = threadIdx.x; asm volatile("" : "+v"(t)); return t; }
__device__ __forceinline__ int lt_bid() { int t = blockIdx.x; asm volatile("" : "+s"(t)); return t; }
namespace pg8 {
#define PG8_LAS __attribute__((address_space(3)))
typedef unsigned short bf16_t;
typedef short bf16x8 __attribute__((ext_vector_type(8)));
typedef float f32x4 __attribute__((ext_vector_type(4)));
typedef unsigned u32x4 __attribute__((ext_vector_type(4)));
constexpr int BM = 256, BK = 64, HALF = 128, HTB = HALF * BK * 2  , STAGE_BYTES = 8 * HTB, NXCD = 8, WGM = 8;

__host__ __device__ __forceinline__ int lds_byte(int r, int c) { const int st = (r >> 4) * 2 + (c >> 5), rr = r & 15, cc = c & 31, ob = rr * 64 + cc * 2; return st * 1024 + (ob ^ (((ob >> 9) & 1) << 5)); }
__host__ __device__ __forceinline__ void stage_rc(int b, int& R, int& C) { const int st = b / 1024, sb = b % 1024, swz = sb ^ (((sb >> 9) & 1) << 5); R = (st >> 1) * 16 + swz / 64; C = (st & 1) * 32 + (swz % 64) / 2; }
__host__ __device__ __forceinline__ int perm32(int rho) { const int n = rho >> 4, i = rho & 15; return 8 * (i >> 2) + 4 * n + (i & 3); }

struct Unit { int pm, pn; };
struct Gemm { const bf16_t* A; const bf16_t* Bt; int M, N, K, lda; };

struct StaticOrder {
    int nM, nN, nwg, G, c;
    __host__ __device__ void init(int M, int N, int G_, int c_) { nM = M / BM; nN = N / BM; nwg = nM * nN; G = G_; c = c_; }
    __host__ __device__ bool next(int i, Unit& u) const {
        const long L = (long)i * G + c; if (L >= nwg) return false;
        int wgid = (int)L; { const int q = nwg / NXCD, r = nwg % NXCD, xcd = wgid % NXCD, off = wgid / NXCD; wgid = (xcd < r ? xcd * (q + 1) : r * (q + 1) + (xcd - r) * q) + off; }
        const int nig = WGM * nN, gid = wgid / nig, fm = gid * WGM, gsz = (nM - fm) < WGM ? (nM - fm) : WGM;
        u.pm = fm + ((wgid % nig) % gsz); u.pn = (wgid % nig) / gsz; return true;
    }
    __device__ __forceinline__ void a_ready(const Unit&) const {}
    __device__ __forceinline__ void done(const Unit&) const {}
};

__device__ __forceinline__ unsigned cvt_pk_bf16(float lo, float hi) { unsigned r; asm volatile("v_cvt_pk_bf16_f32 %0, %1, %2" : "=v"(r) : "v"(lo), "v"(hi)); return r; }
template <class Epi, class Sched, bool STAMP = false>
__device__ __forceinline__ void gemm_phase(PG8_LAS unsigned char* lds, const Gemm g, const Sched& S, const Epi& E, unsigned long long* stamps) {
    const int tid = lt_tid(), wid = __builtin_amdgcn_readfirstlane(tid >> 6), lane = tid & 63, wr = wid >> 2, wc = wid & 3, fr = lane & 15, fq = lane >> 4;
    const int K = g.K, nt = K / BK;
    int ts_lo = 0, ts_hi = 0, nts = 0; const unsigned long long rt_entry = STAMP ? (unsigned long long)wall_clock64() : 0ull;
#define PG8_STAMP() do { if (STAMP && wid == 0 && nts < 64) { const unsigned long long _c = (unsigned long long)clock64(); \
        ts_lo = (lane == nts) ? (int)(unsigned)_c : ts_lo; ts_hi = (lane == nts) ? (int)(unsigned)(_c >> 32) : ts_hi; ++nts; } } while (0)
    PG8_STAMP();
    unsigned voffA[2], voffB[2];
#pragma unroll
    for (int i = 0; i < 2; ++i) { int R, C; stage_rc(tid * 16 + i * 8192, R, C); const int Rb = Epi::PERM ? ((R & ~31) + perm32(R & 31)) : R;
        voffA[i] = (unsigned)(R * g.lda + C) * 2u; voffB[i] = (unsigned)(Rb * K + C) * 2u; }
    const size_t kstep = (size_t)(BK * 2);
    const size_t hstep = (size_t)HALF * K * 2;
    const size_t tstep = 2 * hstep; const size_t hstepA = (size_t)HALF * g.lda * 2; const size_t tstepA = 2 * hstepA;
    const unsigned ldsw = (unsigned)wid * 1024u;
    const int aoff = lds_byte(wr * 64 + fr, fq * 8), boff = lds_byte(wc * 32 + fr, fq * 8);
#define PG8_SA(b, h) (((b) * 2 + (h)) * HTB)
#define PG8_SB(b, h) ((4 + (b) * 2 + (h)) * HTB)
#define PG8_STAGE(bufoff, gbase, voff) do { _Pragma("unroll") for (int _i = 0; _i < 2; ++_i) \
        __builtin_amdgcn_global_load_lds((const unsigned*)((const char*)(gbase) + (voff)[_i]), (PG8_LAS unsigned*)(lds + (bufoff) + ldsw + _i * 8192), 16, 0, 0); } while (0)
#define PG8_LDA(dst, b, h) do { _Pragma("unroll") for (int m = 0; m < 4; ++m) _Pragma("unroll") for (int k = 0; k < 2; ++k) dst[m][k] = *(const PG8_LAS bf16x8*)(lds + PG8_SA(b, h) + aoff + m * 2048 + k * 1024); } while (0)
#define PG8_LDB(dst, b, h) do { _Pragma("unroll") for (int n = 0; n < 2; ++n) _Pragma("unroll") for (int k = 0; k < 2; ++k) dst[n][k] = *(const PG8_LAS bf16x8*)(lds + PG8_SB(b, h) + boff + n * 2048 + k * 1024); } while (0)
#define PG8_MMA(ai, bj, At, Bt) do { __builtin_amdgcn_s_setprio(1); _Pragma("unroll") for (int m = 0; m < 4; ++m) _Pragma("unroll") for (int n = 0; n < 2; ++n) _Pragma("unroll") for (int k = 0; k < 2; ++k) \
        acc[ai][bj][m][n] = __builtin_amdgcn_mfma_f32_16x16x32_bf16(Bt[n][k], At[m][k], acc[ai][bj][m][n], 0, 0, 0); __builtin_amdgcn_s_setprio(0); } while (0)
#define PG8_WAIT_V(n) asm volatile("s_waitcnt vmcnt(" #n ")" ::: "memory")
#define PG8_WAIT_L(n) asm volatile("s_waitcnt lgkmcnt(" #n ")" ::: "memory")
#define PG8_BAR __builtin_amdgcn_s_barrier()
#define PG8_SCHED __builtin_amdgcn_sched_barrier(0)
    Unit cur, nxt; int ui = 0;
    if (!S.next(0, cur)) return;
    f32x4 acc[2][2][4][2];
#pragma unroll
    for (int a = 0; a < 2; ++a)
#pragma unroll
        for (int b = 0; b < 2; ++b)
#pragma unroll
            for (int m = 0; m < 4; ++m)
#pragma unroll
                for (int n = 0; n < 2; ++n) acc[a][b][m][n] = (f32x4){0.f, 0.f, 0.f, 0.f};
    bf16x8 At[4][2], B0[2][2], B1[2][2];
    const char* cA = (const char*)g.A + (size_t)cur.pm * tstepA; const char* cB = (const char*)g.Bt + (size_t)cur.pn * tstep;
    S.a_ready(cur);
    PG8_STAGE(PG8_SB(0, 0), cB, voffB); PG8_STAGE(PG8_SA(0, 0), cA, voffA); PG8_STAGE(PG8_SB(0, 1), cB + hstep, voffB); PG8_STAGE(PG8_SA(0, 1), cA + hstepA, voffA);
    if (wr == 1) PG8_BAR;
    PG8_WAIT_V(4); PG8_BAR;
    PG8_STAGE(PG8_SB(1, 0), cB + kstep, voffB); PG8_STAGE(PG8_SA(1, 0), cA + kstep, voffA); PG8_STAGE(PG8_SB(1, 1), cB + hstep + kstep, voffB);
    PG8_WAIT_V(6); PG8_BAR;
    PG8_STAMP();
    for (;;) {
        const bool has_next = S.next(ui + 1, nxt);
        const char* nA = has_next ? (const char*)g.A + (size_t)nxt.pm * tstepA : cA; const char* nB = has_next ? (const char*)g.Bt + (size_t)nxt.pn * tstep : cB;
        for (int t = 0; t < nt; t += 2) {
            if constexpr (Epi::SEG) { if (t >= 8 && E.boundary(t)) E.rescale(acc, t, ui, wr, fr, lds); }
            const bool last = (t == nt - 2);
            const char* a1 = cA + (size_t)(t + 1) * kstep;
            const char* a2 = last ? nA : cA + (size_t)(t + 2) * kstep; const char* b2 = last ? nB : cB + (size_t)(t + 2) * kstep;
            const char* a3 = a2 + kstep; const char* b3 = b2 + kstep;
            if (last && has_next) S.a_ready(nxt);
            PG8_LDB(B0, 0, 0); PG8_SCHED; PG8_LDA(At, 0, 0); PG8_STAGE(PG8_SA(1, 1), a1 + hstepA, voffA);
            PG8_WAIT_L(8); PG8_BAR; PG8_WAIT_L(0); PG8_MMA(0, 0, At, B0); PG8_BAR; PG8_SCHED;
            PG8_LDB(B1, 0, 1); PG8_STAGE(PG8_SB(0, 0), b2, voffB);
            PG8_BAR; PG8_WAIT_L(0); PG8_MMA(0, 1, At, B1); PG8_BAR;
            PG8_LDA(At, 0, 1); PG8_STAGE(PG8_SA(0, 0), a2, voffA);
            PG8_BAR; PG8_WAIT_L(0); PG8_MMA(1, 0, At, B0); PG8_BAR; PG8_SCHED;
            PG8_STAGE(PG8_SB(0, 1), b2 + hstep, voffB);
            PG8_WAIT_V(6); PG8_BAR; PG8_MMA(1, 1, At, B1); PG8_BAR;
            PG8_LDB(B0, 1, 0); PG8_SCHED; PG8_LDA(At, 1, 0); PG8_STAGE(PG8_SA(0, 1), a2 + hstepA, voffA);
            PG8_WAIT_L(8); PG8_BAR; PG8_WAIT_L(0); PG8_MMA(0, 0, At, B0); PG8_BAR; PG8_SCHED;
            PG8_LDB(B1, 1, 1); PG8_STAGE(PG8_SB(1, 0), b3, voffB);
            PG8_BAR; PG8_WAIT_L(0); PG8_MMA(0, 1, At, B1); PG8_BAR;
            PG8_LDA(At, 1, 1); PG8_STAGE(PG8_SA(1, 0), a3, voffA);
            PG8_BAR; PG8_WAIT_L(0); PG8_MMA(1, 0, At, B0); PG8_BAR; PG8_SCHED;
            PG8_STAGE(PG8_SB(1, 1), b3 + hstep, voffB);
            PG8_WAIT_V(6); PG8_BAR; PG8_MMA(1, 1, At, B1); PG8_BAR;
        }
        PG8_STAMP();
        if constexpr (Epi::SEG) { E.fin(acc, cur, wr, wc, fr, fq, ui, lds); } else if constexpr (!Epi::AFTER_DRAIN) { E(acc, cur, wr, wc, fr, fq); S.done(cur); }
        PG8_STAMP();
        if (!has_next) break;
#pragma unroll
        for (int a = 0; a < 2; ++a)
#pragma unroll
            for (int b = 0; b < 2; ++b)
#pragma unroll
                for (int m = 0; m < 4; ++m)
#pragma unroll
                    for (int n = 0; n < 2; ++n) acc[a][b][m][n] = (f32x4){0.f, 0.f, 0.f, 0.f};
        cur = nxt; cA = nA; cB = nB; ++ui;
    }
    PG8_WAIT_V(0);
    if (wr == 0) PG8_BAR;
    PG8_BAR;
    if constexpr (Epi::AFTER_DRAIN) { E.fused(acc, cur, wr, wc, fr, fq, lds, wid, lane); S.done(cur); }
    PG8_STAMP();
    if (STAMP && wid == 0) { stamps[lane] = lane < nts ? (((unsigned long long)(unsigned)ts_hi << 32) | (unsigned)ts_lo) : 0ull;
        if (lane == 62) stamps[62] = rt_entry; if (lane == 63) stamps[63] = (unsigned long long)wall_clock64(); }
#undef PG8_STAMP
#undef PG8_SA
#undef PG8_SB
#undef PG8_STAGE
#undef PG8_LDA
#undef PG8_LDB
#undef PG8_MMA
#undef PG8_WAIT_V
#undef PG8_WAIT_L
#undef PG8_BAR
#undef PG8_SCHED
}
}

using pg8::bf16_t; using pg8::bf16x8; using pg8::f32x4;
constexpr int NTOK = 32768, SEQL = 2048, DM = 1024, LDP = 5632, INC = 5648;
constexpr int C_Z = 0, C_G = 1024, C_SG = 1536, C_XBC = 2048, C_Q = 3584, C_F = 4096, C_I = 4608, C_U = 5120, C_O = 2048;
constexpr float EPSN = 1e-6f;

struct Params {
    const float *x, *pre_w, *post_w, *w_in, *w_out, *conv_w, *conv_b, *dt_bias, *a_log, *ssd_d, *ssd_nw, *hg_lb, *hg_nw,
        *lam_re, *lam_im, *log_step, *b_re, *b_im, *c_re, *c_im, *s5_d, *glu_w, *glu_b, *s5_nw;
    float* out;
    bf16_t *proj, *xb, *winT, *woutT, *wgluT, *ktab, *woff, *wst;
    float *wdt, *aT, *lb, *rstd, *dtraw, *ss_ssd, *ss_hg, *ss_s5;
    unsigned* bar;
    bf16_t* bcb;
};

#define CPAR const __attribute__((address_space(4))) Params&
#define GETP() ({ const __attribute__((address_space(4))) Params* _pp = (const __attribute__((address_space(4))) Params*)__builtin_amdgcn_kernarg_segment_ptr(); asm volatile("" : "+s"(_pp)); _pp; })
__device__ __forceinline__ unsigned f2bf(float f) { unsigned u = __float_as_uint(f); u += 0x7FFFu + ((u >> 16) & 1u); return u >> 16; }
__device__ __forceinline__ float bf2f(unsigned b) { return __uint_as_float(b << 16); }
__device__ __forceinline__ float bflo(unsigned w) { return __uint_as_float(w << 16); }
__device__ __forceinline__ float bfhi(unsigned w) { return __uint_as_float(w & 0xffff0000u); }
__device__ __forceinline__ unsigned pk2(float a, float b) { unsigned r; asm("v_cvt_pk_bf16_f32 %0, %1, %2" : "=v"(r) : "v"(a), "v"(b)); return r; }
__device__ __forceinline__ float sigmoidf_(float v) { return 1.f / (1.f + __expf(-v)); }
__device__ __forceinline__ float siluf_(float v) { return v / (1.f + __expf(-v)); }
__device__ __forceinline__ float wave_sum(float v) {
#pragma unroll
    for (int o = 32; o >= 1; o >>= 1) v += __shfl_xor(v, o);
    return v;
}
__device__ __forceinline__ f32x4 mma_lds(const bf16_t* A, int lda, const bf16_t* Bt, int ldb, int K, f32x4 acc, int lane) {
    const bf16_t* ap = A + (lane & 15) * lda + (lane >> 4) * 8;
    const bf16_t* bp = Bt + (lane & 15) * ldb + (lane >> 4) * 8;
#pragma unroll 4
    for (int k0 = 0; k0 < K; k0 += 32) {
        bf16x8 a = *(const bf16x8*)(ap + k0), b = *(const bf16x8*)(bp + k0);
        acc = __builtin_amdgcn_mfma_f32_16x16x32_bf16(a, b, acc, 0, 0, 0);
    }
    return acc;
}

template <int NT, int K>
__device__ __forceinline__ void mma_lds_n(const bf16_t* A, int lda, const bf16_t* Bt, int ldb, int bstride, f32x4 (&acc)[NT], int lane) {
    const bf16_t* ap = A + (lane & 15) * lda + (lane >> 4) * 8;
    const bf16_t* bp = Bt + (lane & 15) * ldb + (lane >> 4) * 8;
    constexpr int KS = K / 32;
    bf16x8 a[2], b[2][NT];
    a[0] = *(const bf16x8*)ap;
#pragma unroll
    for (int i = 0; i < NT; ++i) b[0][i] = *(const bf16x8*)(bp + i * bstride);
#pragma unroll
    for (int ks = 0; ks < KS; ++ks) { const int cur = ks & 1, nxt = cur ^ 1;
        if (ks + 1 < KS) { a[nxt] = *(const bf16x8*)(ap + (ks + 1) * 32);
#pragma unroll
            for (int i = 0; i < NT; ++i) b[nxt][i] = *(const bf16x8*)(bp + i * bstride + (ks + 1) * 32); }
        __builtin_amdgcn_sched_barrier(0);
#pragma unroll
        for (int i = 0; i < NT; ++i) acc[i] = __builtin_amdgcn_mfma_f32_16x16x32_bf16(a[cur], b[cur][i], acc[i], 0, 0, 0);
        __builtin_amdgcn_sched_barrier(0); }
}

template <int NT, int K>
__device__ __forceinline__ void mma_lds_s(const bf16_t* A, int lda, const bf16_t* Bt, int ldb, int bstride, f32x4 (&acc)[NT], int lane) {
    const bf16_t* ap = A + (lane & 15) * lda + (lane >> 4) * 8;
    const bf16_t* bp = Bt + (lane & 15) * ldb + (lane >> 4) * 8;
#pragma unroll
    for (int k0 = 0; k0 < K; k0 += 32) { const bf16x8 a = *(const bf16x8*)(ap + k0);
#pragma unroll
        for (int i = 0; i < NT; ++i) { const bf16x8 b = *(const bf16x8*)(bp + i * bstride + k0); acc[i] = __builtin_amdgcn_mfma_f32_16x16x32_bf16(a, b, acc[i], 0, 0, 0); } }
}

#define XB_TMO      128
#define XB_XCNT(j)  (256  + 64 * (j))
#define XB_XSUB(j)  (1280 + 64 * (j))
#define XB_XGEN(j)  (2304 + 64 * (j))
#define XB_TOP      3328
#define XB_TOPGEN   3392
#define XCD_BAR_WORDS 3456
#define XB_SPIN_CAP (1u << 18)
#define LAS __attribute__((address_space(3)))

__device__ __forceinline__ unsigned xb_ld(unsigned* p)              { return __hip_atomic_load(p, __ATOMIC_RELAXED, __HIP_MEMORY_SCOPE_AGENT); }
__device__ __forceinline__ unsigned xb_add(unsigned* p, unsigned v) { return __hip_atomic_fetch_add(p, v, __ATOMIC_RELAXED, __HIP_MEMORY_SCOPE_AGENT); }
__device__ __forceinline__ unsigned xb_xcc_id() { return (unsigned)__builtin_amdgcn_s_getreg((3 << 11) | 20) & 0xFu; }
#define XB_SPIN(cond, bar) do { unsigned _sp = 0; while (cond) { __builtin_amdgcn_s_sleep(1); \
    if ((++_sp & 255u) == 0u) { if (xb_ld(&(bar)[XB_TMO])) break; if (_sp > XB_SPIN_CAP) { atomicAdd(&(bar)[XB_TMO], 1u); break; } } } } while (0)

struct XcdBarrier {
    unsigned* bar;
    bf16_t* bcb; unsigned x;
    volatile LAS unsigned* st;
};

__device__ __forceinline__ XcdBarrier xcd_barrier_post(unsigned* bar, volatile LAS unsigned* st) {
    XcdBarrier b; b.bar = bar; b.x = xb_xcc_id(); b.st = st;
    if (threadIdx.x == 0) (void)xb_add(&bar[XB_XCNT(b.x)], 1u);
    return b;
}
__device__ __forceinline__ void xcd_barrier_complete(unsigned* bar, unsigned x, unsigned& nloc, unsigned& nx) {
    const unsigned G = gridDim.x * gridDim.y * gridDim.z;
    unsigned sum, cnt, mine, sp = 0u;
    for (;;) {
        sum = 0u; cnt = 0u; mine = 0u;
#pragma unroll
        for (unsigned j = 0; j < 16; ++j) { const unsigned c = xb_ld(&bar[XB_XCNT(j)]); sum += c; cnt += (c > 0u) ? 1u : 0u; mine = (j == x) ? c : mine; }
        if (sum == G) break;
        __builtin_amdgcn_s_sleep(1);
        if ((++sp & 255u) == 0u) { if (xb_ld(&bar[XB_TMO])) break; if (sp > XB_SPIN_CAP) { atomicAdd(&bar[XB_TMO], 1u); break; } }
    }
    nloc = mine > 0u ? mine : 1u; nx = cnt > 0u ? cnt : 1u;
}

__device__ __forceinline__ void xcd_barrier(const XcdBarrier& b) {
    asm volatile("s_waitcnt vmcnt(0)" ::: "memory");
    __syncthreads();
    if (threadIdx.x == 0) {
        unsigned* bar = b.bar;
        __builtin_amdgcn_s_waitcnt(0);
        unsigned nloc = b.st[0], nx = b.st[1];
        if (nloc == 0u) { xcd_barrier_complete(bar, b.x, nloc, nx); b.st[0] = nloc; b.st[1] = nx; }
        const unsigned old = xb_add(&bar[XB_XSUB(b.x)], 1u);
        const unsigned gen = old / nloc;
        if (old + 1u == (gen + 1u) * nloc) {
            __builtin_amdgcn_fence(__ATOMIC_RELEASE, "agent");
            asm volatile("s_waitcnt vmcnt(0)" ::: "memory");
            const unsigned og = xb_add(&bar[XB_TOP], 1u);
            const unsigned tg = og / nx;
            if (og + 1u == (tg + 1u) * nx) xb_add(&bar[XB_TOPGEN], 1u);
            else XB_SPIN(xb_ld(&bar[XB_TOPGEN]) == tg, bar);
            __builtin_amdgcn_fence(__ATOMIC_ACQUIRE, "agent");
            xb_add(&bar[XB_XGEN(b.x)], 1u);
            asm volatile("s_waitcnt vmcnt(0)" ::: "memory");
        } else {
            XB_SPIN(xb_ld(&bar[XB_XGEN(b.x)]) == gen, bar);
            __builtin_amdgcn_fence(__ATOMIC_ACQUIRE, "agent");
            asm volatile("s_waitcnt vmcnt(0)" ::: "memory");
        }
    }
    __syncthreads();
}


struct EpiIn {
    static constexpr bool PERM = false, AFTER_DRAIN = false, SEG = false;
    bf16_t* O; const float* rstd;
    __device__ __forceinline__ void operator()(const f32x4 (&acc)[2][2][4][2], const pg8::Unit& u, int wr, int wc, int fr, int fq) const {
        const int row0 = u.pm * 256 + wr * 64 + fr, col0 = u.pn * 256 + wc * 32 + 4 * fq;
#pragma unroll
        for (int ai = 0; ai < 2; ++ai)
#pragma unroll
            for (int m = 0; m < 4; ++m) { const int row = row0 + ai * 128 + m * 16; const float rs = rstd[row]; bf16_t* rowp = O + (size_t)row * LDP + col0;
#pragma unroll
                for (int bj = 0; bj < 2; ++bj)
#pragma unroll
                    for (int n = 0; n < 2; ++n) { const f32x4 v = acc[ai][bj][m][n] * rs; uint2 w; w.x = pk2(v[0], v[1]); w.y = pk2(v[2], v[3]); *(uint2*)(rowp + bj * 128 + n * 16) = w; } }
    }
};
struct EpiOut {
    static constexpr bool PERM = false, AFTER_DRAIN = false, SEG = false;
    bf16_t* O;
    __device__ __forceinline__ void operator()(const f32x4 (&acc)[2][2][4][2], const pg8::Unit& u, int wr, int wc, int fr, int fq) const {
        const int row0 = u.pm * 256 + wr * 64 + fr, col0 = u.pn * 256 + wc * 32 + 4 * fq;
#pragma unroll
        for (int ai = 0; ai < 2; ++ai)
#pragma unroll
            for (int m = 0; m < 4; ++m) { const int row = row0 + ai * 128 + m * 16; bf16_t* rowp = O + (size_t)row * LDP + C_O + col0;
#pragma unroll
                for (int bj = 0; bj < 2; ++bj)
#pragma unroll
                    for (int n = 0; n < 2; ++n) { const f32x4 v = acc[ai][bj][m][n]; uint2 w; w.x = pk2(v[0], v[1]); w.y = pk2(v[2], v[3]); *(uint2*)(rowp + bj * 128 + n * 16) = w; } }
    }
};
struct EpiOutSeg {
    static constexpr bool PERM = false, AFTER_DRAIN = false, SEG = true;
    bf16_t* O;
    __device__ __forceinline__ bool boundary(int t) const { return t == 8 || t == 16 || t == 18 || t == 20 || t == 22 || t == 24; }
    __device__ __forceinline__ void rescale(f32x4 (&acc)[2][2][4][2], int t, int ui, int wr, int fr, PG8_LAS unsigned char* lds) const {
        const int b = (t == 8) ? 0 : (t == 16) ? 1 : ((t - 14) >> 1);
        const PG8_LAS float* rt = (const PG8_LAS float*)(lds + 131072) + ((ui & 1) * 7 + b) * 256 + wr * 64 + fr;
#pragma unroll
        for (int ai = 0; ai < 2; ++ai)
#pragma unroll
            for (int m = 0; m < 4; ++m) { const float r = rt[ai * 128 + m * 16];
#pragma unroll
                for (int bj = 0; bj < 2; ++bj)
#pragma unroll
                    for (int n = 0; n < 2; ++n) acc[ai][bj][m][n] *= r; }
    }
    __device__ __forceinline__ void fin(const f32x4 (&acc)[2][2][4][2], const pg8::Unit& u, int wr, int wc, int fr, int fq, int ui, PG8_LAS unsigned char* lds) const {
        const PG8_LAS float* rt = (const PG8_LAS float*)(lds + 131072) + ((ui & 1) * 7 + 6) * 256 + wr * 64 + fr;
        const int row0 = u.pm * 256 + wr * 64 + fr, col0 = u.pn * 256 + wc * 32 + 4 * fq;
#pragma unroll
        for (int ai = 0; ai < 2; ++ai)
#pragma unroll
            for (int m = 0; m < 4; ++m) { const int row = row0 + ai * 128 + m * 16; const float r = rt[ai * 128 + m * 16]; bf16_t* rowp = O + (size_t)row * LDP + C_O + col0;
#pragma unroll
                for (int bj = 0; bj < 2; ++bj)
#pragma unroll
                    for (int n = 0; n < 2; ++n) { const f32x4 v = acc[ai][bj][m][n] * r; uint2 w; w.x = pk2(v[0], v[1]); w.y = pk2(v[2], v[3]); *(uint2*)(rowp + bj * 128 + n * 16) = w; } }
    }
    __device__ __forceinline__ void operator()(const f32x4 (&acc)[2][2][4][2], const pg8::Unit& u, int wr, int wc, int fr, int fq) const {}
};
struct EpiGlu {
    static constexpr bool PERM = false, AFTER_DRAIN = false, SEG = false;
    bf16_t* P; const float* bias; float* ss;
    __device__ __forceinline__ void operator()(const f32x4 (&acc)[2][2][4][2], const pg8::Unit& u, int wr, int wc, int fr, int fq) const {
        const int row0 = u.pm * 256 + wr * 64 + fr, c0 = u.pn * 128 + wc * 32 + 4 * fq;
        f32x4 bv[2], bg[2];
#pragma unroll
        for (int n = 0; n < 2; ++n) { bv[n] = *(const f32x4*)(bias + c0 + n * 16); bg[n] = *(const f32x4*)(bias + 512 + c0 + n * 16); }
#pragma unroll
        for (int ai = 0; ai < 2; ++ai)
#pragma unroll
            for (int m = 0; m < 4; ++m) { const int row = row0 + ai * 128 + m * 16; bf16_t* rowp = P + (size_t)row * LDP + C_SG + c0; float sq = 0.f;
#pragma unroll
                for (int n = 0; n < 2; ++n) { const f32x4 val = acc[ai][0][m][n] + bv[n], gt = acc[ai][1][m][n] + bg[n]; const uint2 gw = *(const uint2*)(rowp + n * 16);
                    float g[4] = {bflo(gw.x), bfhi(gw.x), bflo(gw.y), bfhi(gw.y)}; float y[4];
#pragma unroll
                    for (int j = 0; j < 4; ++j) { y[j] = val[j] * sigmoidf_(gt[j]) * siluf_(g[j]); sq += y[j] * y[j]; }
                    uint2 w; w.x = pk2(y[0], y[1]); w.y = pk2(y[2], y[3]); *(uint2*)(rowp + n * 16) = w; }
                sq += __shfl_xor(sq, 16); sq += __shfl_xor(sq, 32);
                if (fq == 0) ss[(size_t)row * 16 + u.pn * 4 + wc] = sq; }
    }
};

__device__ __forceinline__ int src_col(int n) {
    if (n < 1024) return n; if (n < 1536) return 4112 + (n - 1024); if (n < 2048) return 5136 + (n - 1536); if (n < 3584) return 1024 + (n - 2048);
    if (n < 4096) return 2576 + (n - 3584); if (n < 4608) return 3088 + (n - 4096); if (n < 5120) return 3600 + (n - 4608); return 4624 + (n - 5120);
}
template <int NSUB>
__device__ __forceinline__ void tr_tile(const float* src, int lds_, int col0, int k0, const float* sc, bf16_t* dst, int ldd, int row0, float* tile) {
    const int tid = lt_tid();
    constexpr int W = 64 * NSUB, STR = W + 1;
#pragma unroll
    for (int i = 0; i < 2 * NSUB; ++i) { const int idx = tid + i * 512, k = idx / (W / 4), n4 = idx % (W / 4);
        float4 v = *(const float4*)(src + (size_t)(k0 + k) * lds_ + col0 + n4 * 4); if (sc) { const float f = sc[k0 + k]; v.x *= f; v.y *= f; v.z *= f; v.w *= f; }
        float* tp = tile + k * STR + n4 * 4; tp[0] = v.x; tp[1] = v.y; tp[2] = v.z; tp[3] = v.w; }
    __syncthreads();
#pragma unroll
    for (int i = 0; i < NSUB; ++i) { const int idx = tid + i * 512, n = idx % W, kg = idx / W; const float* tp = tile + (kg * 8) * STR + n;
        uint4 w; w.x = pk2(tp[0], tp[STR]); w.y = pk2(tp[2 * STR], tp[3 * STR]); w.z = pk2(tp[4 * STR], tp[5 * STR]); w.w = pk2(tp[6 * STR], tp[7 * STR]);
        *(uint4*)(dst + (size_t)(row0 + n) * ldd + k0 + kg * 8) = w; }
    __syncthreads();
}

__device__ void s5_tables(CPAR p, int l, int g, int part, unsigned char* shm) {
    float* apre = (float*)shm;
    float* apim = apre + 33 * 64;
    float* bbre = apim + 33 * 64;
    float* bbim = bbre + 1024;
    float* core = bbim + 1024;
    float* coim = core + 64;
    float* cres = coim + 64;
    float* cims = cres + 1024;
    const int tid = lt_tid();
    if (tid < 64) {
        const int pp = tid; const int gi = (l * 32 + g) * 64 + pp;
        const double lr = fmin((double)p.lam_re[gi], -1e-4), li = (double)p.lam_im[gi], st = (double)expf(p.log_step[l * 32 + g]);
        const double xe = lr * st; double mag = 1.0, term = 1.0;
        for (int q = 1; q <= 12; ++q) { term *= xe / (double)q; mag += term; }
        double ang = li * st; ang -= 6.283185307179586476925 * rint(ang / 6.283185307179586476925);
        const double are = mag * (double)cosf((float)ang), aim = mag * (double)sinf((float)ang);
        double pr = 1.0, pi = 0.0;
        for (int j = 0; j <= 32; ++j) { apre[j * 64 + pp] = (float)pr; apim[j * 64 + pp] = (float)pi; const double nr = pr * are - pi * aim, ni = pr * aim + pi * are; pr = nr; pi = ni; }
        const double den = lr * lr + li * li, nre = are - 1.0, nim = aim;
        core[pp] = (float)((nre * lr + nim * li) / den); coim[pp] = (float)((nim * lr - nre * li) / den);
        if (part == 0) { float* aT = p.aT + (l & 1) * 32 * 64 * 2; aT[(g * 64 + pp) * 2 + 0] = apre[32 * 64 + pp]; aT[(g * 64 + pp) * 2 + 1] = apim[32 * 64 + pp]; }
    }
    __syncthreads();
    for (int i = tid; i < 1024; i += 512) { const int pp = i >> 4; const size_t gi = ((size_t)(l * 32 + g) * 64) * 16 + i;
        const float br = p.b_re[gi], bi = p.b_im[gi]; bbre[i] = core[pp] * br - coim[pp] * bi; bbim[i] = core[pp] * bi + coim[pp] * br; }
    __syncthreads();
    for (int i = tid; i < 1024; i += 512) { cres[i] = p.c_re[(size_t)(l * 32 + g) * 1024 + i]; cims[i] = p.c_im[(size_t)(l * 32 + g) * 1024 + i]; }
    __syncthreads();
    const float* cre = cres;
    const float* cim = cims;
    bf16_t* kt = p.ktab + (size_t)(l & 1) * 32 * 8192 + (size_t)g * 8192;
    for (int e = part * 1024 + tid; e < part * 1024 + 1024; e += 512) { const int lag = e >> 8, h = (e >> 4) & 15, h2 = e & 15; float s = 0.f;
        for (int pp = 0; pp < 64; ++pp) { const float cr = cre[h * 64 + pp], ci = cim[h * 64 + pp], ar = apre[lag * 64 + pp], ai = apim[lag * 64 + pp];
            const float car = cr * ar - ci * ai, cai = cr * ai + ci * ar; s += car * bbre[pp * 16 + h2] - cai * bbim[pp * 16 + h2]; }
        kt[e] = (bf16_t)f2bf(s); }
    bf16_t* wo = p.woff + (size_t)(l & 1) * 32 * 65536 + (size_t)g * 65536;
    for (int e = part * 8192 + tid; e < part * 8192 + 8192; e += 512) { const int row = e >> 7, k = e & 127, t = row >> 4, h = row & 15, pp = k & 63;
        const float cr = cre[h * 64 + pp], ci = cim[h * 64 + pp], ar = apre[(t + 1) * 64 + pp], ai = apim[(t + 1) * 64 + pp];
        const float v = (k < 64) ? (cr * ar - ci * ai) : -(cr * ai + ci * ar); wo[e] = (bf16_t)f2bf(v); }
    bf16_t* ws = p.wst + (size_t)(l & 1) * 32 * 65536 + (size_t)g * 65536;
    for (int e = part * 8192 + tid; e < part * 8192 + 8192; e += 512) { const int m = e >> 9, k = e & 511, s = k >> 4, h2 = k & 15, pp = m & 63;
        const float ar = apre[(31 - s) * 64 + pp], ai = apim[(31 - s) * 64 + pp], br = bbre[pp * 16 + h2], bi = bbim[pp * 16 + h2];
        const float v = (m < 64) ? (ar * br - ai * bi) : (ar * bi + ai * br); ws[e] = (bf16_t)f2bf(v); }
    __syncthreads();
}

__device__ __forceinline__ void convert_weights(CPAR p, int l, int part, int nparts, unsigned char* shm) {
    float* tile = (float*)shm; const int par = l & 1;
    bf16_t* winT = p.winT + (size_t)par * LDP * DM; bf16_t* woutT = p.woutT + (size_t)par * 1024 * 2048; bf16_t* wgluT = p.wgluT + (size_t)par * 1024 * 512;
    for (int t = part; t < 544; t += nparts) {
        if (t < 352) { const int nt = t >> 4, kt = t & 15; tr_tile<4>(p.w_in + (size_t)l * DM * INC, INC, src_col(nt * 256), kt * 64, p.pre_w + l * DM, winT, DM, nt * 256, tile); }
        else if (t < 480) { const int u = t - 352, nt = u >> 5, kt = u & 31, k0 = kt * 64;
            const float* sc = (k0 < 1024) ? (p.ssd_nw + l * 1024) : (k0 < 1536) ? (p.hg_nw + l * 512 - 1024) : (p.s5_nw + l * 512 - 1536);
            tr_tile<4>(p.w_out + (size_t)l * 2048 * DM, DM, nt * 256, k0, sc, woutT, 2048, nt * 256, tile); }
        else { const int u = t - 480, nt = u >> 3, kt = u & 7, row0 = nt * 128, pn = row0 >> 8, half = (row0 >> 7) & 1;
            tr_tile<2>(p.glu_w + (size_t)l * 512 * 1024, 1024, half * 512 + pn * 128, kt * 64, nullptr, wgluT, 512, row0, tile); }
    }
    for (int u = part; u < 256; u += nparts) s5_tables(p, l, u >> 3, u & 7, shm);
}

__device__ void phase_prep(CPAR p, int l, unsigned char* shm) {
    const int tid = lt_tid(), lane = tid & 63, wv = tid >> 6;
    const int G = gridDim.x, bid = lt_bid();
    if (l == 0) {
        convert_weights(p, 0, bid, G, shm);
        if (bid == G - 1) {
            const float a0 = p.hg_lb[tid], a1 = p.hg_lb[512 + tid], a2 = p.hg_lb[1024 + tid], a3 = p.hg_lb[1536 + tid];
            const float mx = fmaxf(fmaxf(a0, a1), fmaxf(a2, a3)); const float e0 = expf(a0 - mx), e1 = expf(a1 - mx), e2 = expf(a2 - mx), e3 = expf(a3 - mx), inv = 1.f / (e0 + e1 + e2 + e3);
            p.lb[tid] = 0.f; p.lb[512 + tid] = e1 * inv; p.lb[1024 + tid] = (e1 + e2) * inv; p.lb[1536 + tid] = (e1 + e2 + e3) * inv;
        }
    }
    __syncthreads();
    float* wdt_s = (float*)(shm + 32768);
    if (l < 4) { for (int e = tid; e < 16384; e += 512) { const int k = e >> 4, j = e & 15; wdt_s[j * 1024 + k] = p.w_in[(size_t)l * DM * INC + (size_t)k * INC + 2560 + j] * p.pre_w[l * DM + k]; } }
    __syncthreads();
    float pw[16];
#pragma unroll
    for (int i = 0; i < 4; ++i) { const float4 w = (l > 0) ? *(const float4*)(p.post_w + (l - 1) * DM + i * 256 + lane * 4) : make_float4(0.f, 0.f, 0.f, 0.f); pw[4 * i] = w.x; pw[4 * i + 1] = w.y; pw[4 * i + 2] = w.z; pw[4 * i + 3] = w.w; }
    const int rstep = G * 8; int row = bid * 8 + wv;
    float4 xn[4]; uint2 xq[4], on[4];
#pragma unroll
    for (int i = 0; i < 4; ++i) { xn[i] = make_float4(0.f, 0.f, 0.f, 0.f); xq[i] = make_uint2(0u, 0u); on[i] = make_uint2(0u, 0u); }
    if (row < NTOK) {
        if (l == 0) {
#pragma unroll
            for (int i = 0; i < 4; ++i) xn[i] = *(const float4*)(p.x + (size_t)row * DM + i * 256 + lane * 4);
        } else {
#pragma unroll
            for (int i = 0; i < 4; ++i) { xq[i] = *(const uint2*)(p.xb + (size_t)row * DM + i * 256 + lane * 4); on[i] = *(const uint2*)(p.proj + (size_t)row * LDP + C_O + i * 256 + lane * 4); }
        }
    }
    for (; row < NTOK; row += rstep) {
        float xv[16]; uint2 oc[4];
        if (l == 0) {
#pragma unroll
            for (int i = 0; i < 4; ++i) { xv[4 * i] = xn[i].x; xv[4 * i + 1] = xn[i].y; xv[4 * i + 2] = xn[i].z; xv[4 * i + 3] = xn[i].w; oc[i] = make_uint2(0u, 0u); }
        } else {
#pragma unroll
            for (int i = 0; i < 4; ++i) { xv[4 * i] = bflo(xq[i].x); xv[4 * i + 1] = bfhi(xq[i].x); xv[4 * i + 2] = bflo(xq[i].y); xv[4 * i + 3] = bfhi(xq[i].y); oc[i] = on[i]; }
        }
        if (row + rstep < NTOK) {
            if (l == 0) {
#pragma unroll
                for (int i = 0; i < 4; ++i) xn[i] = *(const float4*)(p.x + (size_t)(row + rstep) * DM + i * 256 + lane * 4);
            } else {
#pragma unroll
                for (int i = 0; i < 4; ++i) { xq[i] = *(const uint2*)(p.xb + (size_t)(row + rstep) * DM + i * 256 + lane * 4); on[i] = *(const uint2*)(p.proj + (size_t)(row + rstep) * LDP + C_O + i * 256 + lane * 4); }
            }
        }
        if (l > 0) {
            float ov[16]; float ss = 0.f;
#pragma unroll
            for (int i = 0; i < 4; ++i) { ov[4 * i] = bflo(oc[i].x); ov[4 * i + 1] = bfhi(oc[i].x); ov[4 * i + 2] = bflo(oc[i].y); ov[4 * i + 3] = bfhi(oc[i].y); }
#pragma unroll
            for (int i = 0; i < 16; ++i) ss += ov[i] * ov[i];
            ss = wave_sum(ss); const float rs = rsqrtf(ss * (1.f / 1024.f) + EPSN);
#pragma unroll
            for (int i = 0; i < 16; ++i) xv[i] += ov[i] * rs * pw[i];
            if (l == 4) {
#pragma unroll
                for (int i = 0; i < 4; ++i) *(float4*)(p.out + (size_t)row * DM + i * 256 + lane * 4) = make_float4(xv[4 * i], xv[4 * i + 1], xv[4 * i + 2], xv[4 * i + 3]);
            }
        }
        if (l < 4) {
            float ss = 0.f;
#pragma unroll
            for (int i = 0; i < 16; ++i) ss += xv[i] * xv[i];
            ss = wave_sum(ss); const float rs = rsqrtf(ss * (1.f / 1024.f) + EPSN);
            if (lane == 0) p.rstd[row] = rs;
#pragma unroll
            for (int i = 0; i < 4; ++i) { uint2 w; w.x = pk2(xv[4 * i], xv[4 * i + 1]); w.y = pk2(xv[4 * i + 2], xv[4 * i + 3]); *(uint2*)(p.xb + (size_t)row * DM + i * 256 + lane * 4) = w; }
            float d[16];
#pragma unroll
            for (int j = 0; j < 16; ++j) { float a = 0.f;
#pragma unroll
                for (int i = 0; i < 4; ++i) { const float4 w = *(const float4*)(wdt_s + j * 1024 + i * 256 + lane * 4); a += xv[4 * i] * w.x + xv[4 * i + 1] * w.y + xv[4 * i + 2] * w.z + xv[4 * i + 3] * w.w; }
                d[j] = a; }
            float e8[8], e4[4], e2[2];
#pragma unroll
            for (int j = 0; j < 8; ++j) { const bool hi = lane & 32; const float mine = hi ? d[j + 8] : d[j], send = hi ? d[j] : d[j + 8]; e8[j] = mine + __shfl_xor(send, 32); }
#pragma unroll
            for (int j = 0; j < 4; ++j) { const bool hi = lane & 16; const float mine = hi ? e8[j + 4] : e8[j], send = hi ? e8[j] : e8[j + 4]; e4[j] = mine + __shfl_xor(send, 16); }
#pragma unroll
            for (int j = 0; j < 2; ++j) { const bool hi = lane & 8; const float mine = hi ? e4[j + 2] : e4[j], send = hi ? e4[j] : e4[j + 2]; e2[j] = mine + __shfl_xor(send, 8); }
            float e1; { const bool hi = lane & 4; const float mine = hi ? e2[1] : e2[0], send = hi ? e2[0] : e2[1]; e1 = mine + __shfl_xor(send, 4); }
            e1 += __shfl_xor(e1, 2); e1 += __shfl_xor(e1, 1);
            if ((lane & 3) == 0) { const int j = ((lane >> 5) & 1) * 8 + ((lane >> 4) & 1) * 4 + ((lane >> 3) & 1) * 2 + ((lane >> 2) & 1); p.dtraw[(size_t)row * 16 + j] = e1 * rs; }
        }
    }
}

#ifndef PH
#define PH 63
#endif
#ifndef TPROBE
#define TPROBE -1
#endif
#if TPROBE >= 0
#ifndef TBLK
#define TBLK 0
#endif
#define TSTAMP(k) do { if (blockIdx.x == TBLK && threadIdx.x == 0) { CPAR _p = *GETP(); unsigned long long* _w = (unsigned long long*)_p.wdt; const unsigned long long _t = wall_clock64(); if ((k) == TPROBE) _w[1] += (_t - _w[0]); _w[0] = _t; } } while (0)
#else
#define TSTAMP(k) do { } while (0)
#endif
#define BAR_LDS() do { asm volatile("s_waitcnt lgkmcnt(0)" ::: "memory"); __builtin_amdgcn_s_barrier(); asm volatile("" ::: "memory"); } while (0)
#define MFMA16(a, b, c) __builtin_amdgcn_mfma_f32_16x16x32_bf16(a, b, c, 0, 0, 0)

__device__ void bcconv_unit(CPAR p, int l, int u) {
    const int tid = lt_tid();
    const int bg = u >> 3, tr = u & 7, b = bg >> 1, g = bg & 1;
    bf16_t* Bn = p.bcb; bf16_t* Cn = Bn + (size_t)32 * 2048 * 128; bf16_t* BT = Cn + (size_t)32 * 2048 * 128;
    const int cp = tid & 63, kind = (tid >> 6) & 1, tgl = tid >> 7;
    const int ch = (kind ? 1280 : 1024) + g * 128 + cp * 2;
    const float* cw = p.conv_w + (size_t)l * 4 * 1536 + ch; const float* cb = p.conv_b + l * 1536 + ch;
    const float w00 = cw[0], w01 = cw[1536], w02 = cw[3072], w03 = cw[4608], w10 = cw[1], w11 = cw[1537], w12 = cw[3073], w13 = cw[4609], b0 = cb[0], b1 = cb[1];
    for (int it = 0; it < 8; ++it) {
        const int t = tr * 256 + (it * 4 + tgl) * 8;
        const bf16_t* src = p.proj + ((size_t)b * SEQL + t) * LDP + C_XBC + ch;
        float r0[11], r1[11];
#pragma unroll
        for (int j = 0; j < 11; ++j) { unsigned w = 0u; if (t + j - 3 >= 0) w = *(const unsigned*)(src + (ptrdiff_t)(j - 3) * LDP); r0[j] = bflo(w); r1[j] = bfhi(w); }
        float o0[8], o1[8];
#pragma unroll
        for (int j = 0; j < 8; ++j) { o0[j] = siluf_(b0 + w00 * r0[j] + w01 * r0[j + 1] + w02 * r0[j + 2] + w03 * r0[j + 3]); o1[j] = siluf_(b1 + w10 * r1[j] + w11 * r1[j + 1] + w12 * r1[j + 2] + w13 * r1[j + 3]); }
        bf16_t* dstn = (kind ? Cn : Bn) + ((size_t)bg * 2048 + t) * 128 + cp * 2;
#pragma unroll
        for (int j = 0; j < 8; ++j) *(unsigned*)(dstn + j * 128) = pk2(o0[j], o1[j]);
        if (!kind) { uint4 q0, q1; q0.x = pk2(o0[0], o0[1]); q0.y = pk2(o0[2], o0[3]); q0.z = pk2(o0[4], o0[5]); q0.w = pk2(o0[6], o0[7]);
            q1.x = pk2(o1[0], o1[1]); q1.y = pk2(o1[2], o1[3]); q1.z = pk2(o1[4], o1[5]); q1.w = pk2(o1[6], o1[7]);
            *(uint4*)(BT + ((size_t)bg * 128 + cp * 2) * 2048 + t) = q0; *(uint4*)(BT + ((size_t)bg * 128 + cp * 2 + 1) * 2048 + t) = q1; }
    }
}

__device__ void ssd_unit(CPAR p, int l, int b, int hd, unsigned char* shm) {
    const int tid = lt_tid(), lane = tid & 63, wv = __builtin_amdgcn_readfirstlane(tid >> 6), quad = lane >> 4, l15 = lane & 15;
    constexpr int OSET = 64 * 136 * 2 + 128 * 72 + 64 * 72;
    bf16_t* OB = (bf16_t*)shm;
    bf16_t* Ls = OB + 2 * OSET;
    bf16_t* Ss = Ls + 64 * 72;
    bf16_t* Yw = Ss + 64 * 136;
    float* dtb = (float*)(Yw + 64 * 72);
    const int g = hd >> 3, bg = b * 2 + g;
    const float a = -expf(p.a_log[l * 16 + hd]), dbias = p.dt_bias[l * 16 + hd], dsk = p.ssd_d[l * 16 + hd];
    for (int i = tid; i < 64 * 136 / 2; i += 512) ((unsigned*)Ss)[i] = 0u;
    const size_t row_base = (size_t)b * SEQL;
    const bf16_t* Bn = p.bcb + (size_t)bg * 2048 * 128; const bf16_t* Cn = Bn + (size_t)32 * 2048 * 128; const bf16_t* BT = p.bcb + (size_t)2 * 32 * 2048 * 128 + (size_t)bg * 128 * 2048;
#define SSD_SCAN(DST) do { float* _d = (DST); const float v = dtr + dbias; const float dt = v > 20.f ? v : __logf(1.f + __expf(v)); float da = dt * a; \
        _Pragma("unroll") for (int o = 1; o < 64; o <<= 1) { const float n = __shfl_up(da, o); if (lane >= o) da += n; } \
        const float al = __shfl(da, 63); _d[lane] = dt; _d[64 + lane] = da; _d[128 + lane] = dt * __expf(al - da); _d[192 + lane] = __expf(da); } while (0)
    if (wv < 4) {
        const int st = tid;
        const int xcp = st & 31, xtg = st >> 5, xch = hd * 64 + xcp * 2;
        const float* cw = p.conv_w + (size_t)l * 4 * 1536 + xch; const float* cb = p.conv_b + l * 1536 + xch;
        const float w00 = cw[0], w01 = cw[1536], w02 = cw[3072], w03 = cw[4608], w10 = cw[1], w11 = cw[1537], w12 = cw[3073], w13 = cw[4609], b0 = cb[0], b1 = cb[1];
        const bf16_t* xsrc = p.proj + (row_base + xtg * 8) * LDP + C_XBC + xch;
        uint4 pb0, pb1, pb2, pb3, pc0, pc1, pc2, pc3, pt0, pt1, pt2, pt3; unsigned xr[11]; float dtr = 0.f;
#define SSD_LD1(I, PB, PC, T0) do { const int q = st + (I) * 256; PB = *(const uint4*)(Bn + (size_t)(T0) * 128 + q * 8); PC = *(const uint4*)(Cn + (size_t)(T0) * 128 + q * 8); } while (0)
#define SSD_LDT(I, PT, T0) do { const int q = st + (I) * 256; PT = *(const uint4*)(BT + (size_t)(q >> 3) * 2048 + (T0) + (q & 7) * 8); } while (0)
#define SSD_LOAD_T(T0) do { SSD_LDT(0, pt0, T0); SSD_LDT(1, pt1, T0); SSD_LDT(2, pt2, T0); SSD_LDT(3, pt3, T0); } while (0)
#define SSD_LOAD(T0) do { SSD_LD1(0, pb0, pc0, T0); SSD_LD1(1, pb1, pc1, T0); SSD_LD1(2, pb2, pc2, T0); SSD_LD1(3, pb3, pc3, T0); \
            xr[0] = ((T0) + xtg * 8 - 3 >= 0) ? *(const unsigned*)(xsrc + ((ptrdiff_t)(T0) - 3) * LDP) : 0u; \
            xr[1] = ((T0) + xtg * 8 - 2 >= 0) ? *(const unsigned*)(xsrc + ((ptrdiff_t)(T0) - 2) * LDP) : 0u; \
            xr[2] = ((T0) + xtg * 8 - 1 >= 0) ? *(const unsigned*)(xsrc + ((ptrdiff_t)(T0) - 1) * LDP) : 0u; \
            xr[3] = *(const unsigned*)(xsrc + ((ptrdiff_t)(T0) + 0) * LDP); xr[4] = *(const unsigned*)(xsrc + ((ptrdiff_t)(T0) + 1) * LDP); \
            xr[5] = *(const unsigned*)(xsrc + ((ptrdiff_t)(T0) + 2) * LDP); xr[6] = *(const unsigned*)(xsrc + ((ptrdiff_t)(T0) + 3) * LDP); \
            xr[7] = *(const unsigned*)(xsrc + ((ptrdiff_t)(T0) + 4) * LDP); xr[8] = *(const unsigned*)(xsrc + ((ptrdiff_t)(T0) + 5) * LDP); \
            xr[9] = *(const unsigned*)(xsrc + ((ptrdiff_t)(T0) + 6) * LDP); xr[10] = *(const unsigned*)(xsrc + ((ptrdiff_t)(T0) + 7) * LDP); \
            if (wv == 0) dtr = p.dtraw[(row_base + (T0) + lane) * 16 + hd]; } while (0)
#define SSD_CB1(I, PB, PC, SET) do { const int q = st + (I) * 256; const int row = q >> 4, c16 = q & 15; *(uint4*)((SET) + row * 136 + c16 * 8) = PC; *(uint4*)((SET) + 64 * 136 + row * 136 + c16 * 8) = PB; } while (0)
#define SSD_PART1(SET) do { bf16_t* _s = (SET); SSD_CB1(0, pb0, pc0, _s); SSD_CB1(1, pb1, pc1, _s); SSD_CB1(2, pb2, pc2, _s); SSD_CB1(3, pb3, pc3, _s); \
            float o0[8], o1[8]; \
            _Pragma("unroll") for (int j = 0; j < 8; ++j) { o0[j] = siluf_(b0 + w00 * bflo(xr[j]) + w01 * bflo(xr[j + 1]) + w02 * bflo(xr[j + 2]) + w03 * bflo(xr[j + 3])); o1[j] = siluf_(b1 + w10 * bfhi(xr[j]) + w11 * bfhi(xr[j + 1]) + w12 * bfhi(xr[j + 2]) + w13 * bfhi(xr[j + 3])); } \
            uint4 q0, q1; q0.x = pk2(o0[0], o0[1]); q0.y = pk2(o0[2], o0[3]); q0.z = pk2(o0[4], o0[5]); q0.w = pk2(o0[6], o0[7]); \
            q1.x = pk2(o1[0], o1[1]); q1.y = pk2(o1[2], o1[3]); q1.z = pk2(o1[4], o1[5]); q1.w = pk2(o1[6], o1[7]); \
            bf16_t* _xt = _s + 2 * 64 * 136 + 128 * 72; *(uint4*)(_xt + (xcp * 2) * 72 + xtg * 8) = q0; *(uint4*)(_xt + (xcp * 2 + 1) * 72 + xtg * 8) = q1; } while (0)
#define SSD_BT1(I, PT, SET, SCV) do { const int q = st + (I) * 256; const int n = q >> 3, tg = q & 7; const float* sv = (SCV) + tg * 8; uint4 r; \
            r.x = pk2(bflo(PT.x) * sv[0], bfhi(PT.x) * sv[1]); r.y = pk2(bflo(PT.y) * sv[2], bfhi(PT.y) * sv[3]); r.z = pk2(bflo(PT.z) * sv[4], bfhi(PT.z) * sv[5]); r.w = pk2(bflo(PT.w) * sv[6], bfhi(PT.w) * sv[7]); \
            *(uint4*)((SET) + 2 * 64 * 136 + n * 72 + tg * 8) = r; } while (0)
#define SSD_PART2(SET, SCV) do { bf16_t* _s = (SET); const float* _v = (SCV); SSD_BT1(0, pt0, _s, _v); SSD_BT1(1, pt1, _s, _v); SSD_BT1(2, pt2, _s, _v); SSD_BT1(3, pt3, _s, _v); } while (0)
        SSD_LOAD(0); SSD_LOAD_T(0);
        if (wv == 0) SSD_SCAN(dtb);
        SSD_PART1(OB);
        SSD_LOAD(64);
        BAR_LDS();
        SSD_PART2(OB, dtb + 128);
        SSD_LOAD_T(64);
        BAR_LDS();
        for (int c = 0; c < 32; ++c) {
            bf16_t* nset = OB + ((c + 1) & 1) * OSET; float* ndt = dtb + ((c + 1) & 1) * 256;
            if (c < 31) { if (wv == 0) SSD_SCAN(ndt); SSD_PART1(nset); if (c < 30) SSD_LOAD((c + 2) * 64); }
            BAR_LDS();
            if (c < 31) { SSD_PART2(nset, ndt + 128); if (c < 30) SSD_LOAD_T((c + 2) * 64); }
            BAR_LDS();
        }
#undef SSD_LD1
#undef SSD_LDT
#undef SSD_LOAD_T
#undef SSD_LOAD
#undef SSD_CB1
#undef SSD_PART1
#undef SSD_BT1
#undef SSD_PART2
    } else {
        const int mt = wv - 4;
        f32x4 accS[8];
#pragma unroll
        for (int i = 0; i < 8; ++i) accS[i] = (f32x4){0.f, 0.f, 0.f, 0.f};
        const int orow = mt * 16 + (lane >> 2), ocol = (lane & 3) * 16;
        bf16_t* zbase = p.proj + (row_base + orow) * LDP + C_Z + hd * 64 + ocol;
        uint4 zc0, zc1;
        BAR_LDS();
        zc0 = *(const uint4*)zbase; zc1 = *(const uint4*)(zbase + 8);
        BAR_LDS();
        for (int c = 0; c < 32; ++c) {
            const int t0 = c * 64;
            const bf16_t* Cs = OB + (c & 1) * OSET; const bf16_t* Bs = Cs + 64 * 136; const bf16_t* BscT = Bs + 64 * 136; const bf16_t* XT = BscT + 128 * 72;
            const float* dtv = dtb + (c & 1) * 256; const float* acum = dtv + 64; const float* eav = dtv + 192;
            f32x4 accY[4], accT[4];
#pragma unroll
            for (int i = 0; i < 4; ++i) { accY[i] = (f32x4){0.f, 0.f, 0.f, 0.f}; accT[i] = (f32x4){0.f, 0.f, 0.f, 0.f}; }
            { const bf16_t* ap = Cs + (mt * 16 + l15) * 136 + quad * 8; const bf16_t* bp = Bs + l15 * 136 + quad * 8; const bf16_t* sp = Ss + l15 * 136 + quad * 8;
              bf16x8 fa[2], fb[2][4], fs[2][4];
              fa[0] = *(const bf16x8*)ap;
#pragma unroll
              for (int nt = 0; nt < 4; ++nt) { fb[0][nt] = *(const bf16x8*)(bp + nt * 16 * 136); fs[0][nt] = *(const bf16x8*)(sp + nt * 16 * 136); }
#pragma unroll
              for (int ks = 0; ks < 4; ++ks) { const int cur = ks & 1, nxt = cur ^ 1;
                  if (ks < 3) { fa[nxt] = *(const bf16x8*)(ap + (ks + 1) * 32);
#pragma unroll
                      for (int nt = 0; nt < 4; ++nt) { fb[nxt][nt] = *(const bf16x8*)(bp + nt * 16 * 136 + (ks + 1) * 32); fs[nxt][nt] = *(const bf16x8*)(sp + nt * 16 * 136 + (ks + 1) * 32); } }
                  __builtin_amdgcn_sched_barrier(0);
#pragma unroll
                  for (int nt = 0; nt < 4; ++nt) { accT[nt] = MFMA16(fa[cur], fb[cur][nt], accT[nt]); accY[nt] = MFMA16(fa[cur], fs[cur][nt], accY[nt]); }
                  __builtin_amdgcn_sched_barrier(0); } }
#pragma unroll
            for (int nt = 0; nt < 4; ++nt) { const int scol = nt * 16 + l15; const float as = acum[scol], ds = dtv[scol];
#pragma unroll
                for (int j = 0; j < 4; ++j) { const int lrow = mt * 16 + quad * 4 + j; const float v = (scol <= lrow) ? accT[nt][j] * __expf(acum[lrow] - as) * ds : 0.f; Ls[lrow * 72 + scol] = (bf16_t)f2bf(v); accY[nt][j] *= eav[lrow]; } }
            BAR_LDS();
            mma_lds_n<4, 64>(Ls + mt * 16 * 72, 72, XT, 72, 16 * 72, accY, lane);
#pragma unroll
            for (int nt = 0; nt < 4; ++nt) { const int pcol = nt * 16 + l15;
#pragma unroll
                for (int j = 0; j < 4; ++j) { const int lrow = mt * 16 + quad * 4 + j; Yw[lrow * 72 + pcol] = (bf16_t)f2bf(accY[nt][j] + dsk * bf2f(XT[pcol * 72 + lrow])); } }
            { const float cdec = __expf(acum[63]);
#pragma unroll
              for (int i = 0; i < 8; ++i) accS[i] *= cdec;
              mma_lds_n<8, 64>(XT + mt * 16 * 72, 72, BscT, 72, 16 * 72, accS, lane);
#pragma unroll
              for (int i = 0; i < 8; ++i)
#pragma unroll
                  for (int j = 0; j < 4; ++j) Ss[(mt * 16 + quad * 4 + j) * 136 + i * 16 + l15] = (bf16_t)f2bf(accS[i][j]); }
            { const uint4 y0 = *(const uint4*)(Yw + orow * 72 + ocol), y1 = *(const uint4*)(Yw + orow * 72 + ocol + 8); float sq = 0.f; uint4 r0, r1;
#define SSD_OUT(DST, YW, ZW) do { const float z0 = bflo(ZW), z1 = bfhi(ZW); const float v0 = bflo(YW) * z0 * __builtin_amdgcn_rcpf(1.f + __expf(-z0)), v1 = bfhi(YW) * z1 * __builtin_amdgcn_rcpf(1.f + __expf(-z1)); sq += v0 * v0 + v1 * v1; DST = pk2(v0, v1); } while (0)
              SSD_OUT(r0.x, y0.x, zc0.x); SSD_OUT(r0.y, y0.y, zc0.y); SSD_OUT(r0.z, y0.z, zc0.z); SSD_OUT(r0.w, y0.w, zc0.w);
              SSD_OUT(r1.x, y1.x, zc1.x); SSD_OUT(r1.y, y1.y, zc1.y); SSD_OUT(r1.z, y1.z, zc1.z); SSD_OUT(r1.w, y1.w, zc1.w);
#undef SSD_OUT
              sq += __shfl_xor(sq, 1); sq += __shfl_xor(sq, 2);
              if ((lane & 3) == 0) *(float2*)(p.ss_ssd + (row_base + t0 + orow) * 32 + hd * 2) = make_float2(sq, 0.f);
              bf16_t* zp = zbase + (size_t)t0 * LDP; *(uint4*)zp = r0; *(uint4*)(zp + 8) = r1;
              if (c < 31) { zc0 = *(const uint4*)(zp + (size_t)64 * LDP); zc1 = *(const uint4*)(zp + (size_t)64 * LDP + 8); } }
            BAR_LDS();
        }
    }
#undef SSD_SCAN
    __syncthreads();
}

__device__ void hgrn_unit(CPAR p, int l, int b, int head, int vh, unsigned char* shm) {
    const int tid = lt_tid(), lane = tid & 63, wv = tid >> 6, quad = lane >> 4, l15 = lane & 15;
    bf16_t* Qm = (bf16_t*)shm;
    bf16_t* Km = Qm + 64 * 136;
    bf16_t* Qs = Km + 64 * 136;
    bf16_t* KhT = Qs + 64 * 136;
    bf16_t* VT = KhT + 128 * 72;
    bf16_t* At = VT + 64 * 72;
    bf16_t* Ob = At + 64 * 72;
    bf16_t* ST = Ob + 64 * 72;
    float* dec = (float*)(ST + 64 * 136);
    float* seg = dec + 128;
    for (int i = tid; i < 64 * 136 / 2; i += 512) ((unsigned*)ST)[i] = 0u;
    f32x4 accS[4];
#pragma unroll
    for (int i = 0; i < 4; ++i) accS[i] = (f32x4){0.f, 0.f, 0.f, 0.f};
    const int kp = tid & 63, lq = tid >> 6, k0 = 2 * kp, vp = tid & 31, vl = tid >> 5, orow = (wv >> 1) * 16 + (lane >> 2), oc8 = (wv & 1) * 4 + (lane & 3);
    const float lb0 = p.lb[l * 512 + head * 128 + k0], lb1 = p.lb[l * 512 + head * 128 + k0 + 1], om0 = 1.f - lb0, om1 = 1.f - lb1;
    const size_t row_base = (size_t)b * SEQL;
    const bf16_t* qbase = p.proj + (row_base + lq * 8) * LDP + C_Q + head * 128 + k0;
    const bf16_t* vbase = p.proj + (row_base + vl * 4) * LDP + C_I + head * 128 + vh * 64 + 2 * vp;
    bf16_t* gbase = p.proj + (row_base + orow) * LDP + C_G + head * 128 + vh * 64 + oc8 * 8;
    unsigned qr[8], fr[8], vr[4]; uint4 gr;
#pragma unroll
    for (int i = 0; i < 8; ++i) { qr[i] = *(const unsigned*)(qbase + (size_t)i * LDP); fr[i] = *(const unsigned*)(qbase + (size_t)i * LDP + (C_F - C_Q)); }
#pragma unroll
    for (int i = 0; i < 4; ++i) vr[i] = *(const unsigned*)(vbase + (size_t)i * LDP);
    gr = *(const uint4*)gbase;
    for (int c = 0; c < 32; ++c) {
        const int t0 = c * 64;
        float qv0[8], qv1[8], P0[8], P1[8], kk0[8], kk1[8];
#pragma unroll
        for (int i = 0; i < 8; ++i) { const float q0 = bflo(qr[i]), q1 = bfhi(qr[i]), f0 = fmaxf(bflo(fr[i]), -80.f), f1 = fmaxf(bfhi(fr[i]), -80.f);
            const float fv0 = lb0 + om0 * __builtin_amdgcn_rcpf(1.f + __expf(-f0)), fv1 = lb1 + om1 * __builtin_amdgcn_rcpf(1.f + __expf(-f1));
            P0[i] = fv0; P1[i] = fv1; kk0[i] = 1.f - fv0; kk1[i] = 1.f - fv1;
            qv0[i] = q0 * __builtin_amdgcn_rcpf(1.f + __expf(-q0)); qv1[i] = q1 * __builtin_amdgcn_rcpf(1.f + __expf(-q1)); }
        P0[0] = fmaxf(P0[0], 1e-37f); P1[0] = fmaxf(P1[0], 1e-37f);
#pragma unroll
        for (int i = 1; i < 8; ++i) { P0[i] = fmaxf(P0[i] * P0[i - 1], 1e-37f); P1[i] = fmaxf(P1[i] * P1[i - 1], 1e-37f); }
        const float lfl0 = __logf(P0[7]), lfl1 = __logf(P1[7]);
        *(float2*)(seg + lq * 128 + k0) = make_float2(lfl0, lfl1);
        const unsigned v0 = vr[0], v1 = vr[1], v2 = vr[2], v3 = vr[3]; const uint4 gcur = gr;
        if (c < 31) {
            const size_t adv = (size_t)(t0 + 64) * LDP;
#pragma unroll
            for (int i = 0; i < 8; ++i) { qr[i] = *(const unsigned*)(qbase + adv + (size_t)i * LDP); fr[i] = *(const unsigned*)(qbase + adv + (size_t)i * LDP + (C_F - C_Q)); }
#pragma unroll
            for (int i = 0; i < 4; ++i) vr[i] = *(const unsigned*)(vbase + adv + (size_t)i * LDP);
            gr = *(const uint4*)(gbase + adv);
        }
        BAR_LDS();
        float off0 = 0.f, off1 = 0.f, tot0 = 0.f, tot1 = 0.f, mid0 = 0.f, mid1 = 0.f;
#pragma unroll
        for (int j = 0; j < 8; ++j) { const float2 s = *(const float2*)(seg + j * 128 + k0); if (j < lq) { off0 += s.x; off1 += s.y; } if (j < 4) { mid0 += s.x; mid1 += s.y; } tot0 += s.x; tot1 += s.y; }
        const float emid0 = __expf(mid0), emid1 = __expf(mid1), etm0 = __expf(tot0 - mid0), etm1 = __expf(tot1 - mid1);
        float kh0[8], kh1[8];
        const float a0 = off0 - mid0, a1 = off1 - mid1;
        if (fabsf(a0) <= 80.f && fabsf(a0 + lfl0) <= 80.f && fabsf(a1) <= 80.f && fabsf(a1 + lfl1) <= 80.f) {
            const float E0 = __expf(a0), E1 = __expf(a1);
            float r0 = __builtin_amdgcn_rcpf(E0 * P0[7]), r1 = __builtin_amdgcn_rcpf(E1 * P1[7]);
#pragma unroll
            for (int i = 7; i >= 0; --i) { const int lrow = lq * 8 + i; const float e0 = E0 * P0[i], e1 = E1 * P1[i];
                const float qm0 = qv0[i] * e0, qm1 = qv1[i] * e1, km0 = kk0[i] * r0, km1 = kk1[i] * r1;
                kh0[i] = km0 * etm0; kh1[i] = km1 * etm1;
                *(unsigned*)(Qm + lrow * 136 + k0) = pk2(qm0, qm1); *(unsigned*)(Km + lrow * 136 + k0) = pk2(km0, km1); *(unsigned*)(Qs + lrow * 136 + k0) = pk2(qm0 * emid0, qm1 * emid1);
                r0 *= (1.f - kk0[i]); r1 *= (1.f - kk1[i]); }
        } else {
#pragma unroll
            for (int i = 0; i < 8; ++i) { const int lrow = lq * 8 + i; const float cum0 = off0 + __logf(P0[i]), cum1 = off1 + __logf(P1[i]), d0 = cum0 - mid0, d1 = cum1 - mid1;
                const float qm0 = qv0[i] * __expf(fminf(fmaxf(d0, -80.f), 80.f)), km0 = kk0[i] * __expf(fminf(fmaxf(-d0, -80.f), 80.f)), qs0 = qv0[i] * __expf(cum0);
                const float qm1 = qv1[i] * __expf(fminf(fmaxf(d1, -80.f), 80.f)), km1 = kk1[i] * __expf(fminf(fmaxf(-d1, -80.f), 80.f)), qs1 = qv1[i] * __expf(cum1);
                kh0[i] = kk0[i] * __expf(tot0 - cum0); kh1[i] = kk1[i] * __expf(tot1 - cum1);
                *(unsigned*)(Qm + lrow * 136 + k0) = pk2(qm0, qm1); *(unsigned*)(Km + lrow * 136 + k0) = pk2(km0, km1); *(unsigned*)(Qs + lrow * 136 + k0) = pk2(qs0, qs1); }
        }
        { uint4 q0, q1; q0.x = pk2(kh0[0], kh0[1]); q0.y = pk2(kh0[2], kh0[3]); q0.z = pk2(kh0[4], kh0[5]); q0.w = pk2(kh0[6], kh0[7]);
          q1.x = pk2(kh1[0], kh1[1]); q1.y = pk2(kh1[2], kh1[3]); q1.z = pk2(kh1[4], kh1[5]); q1.w = pk2(kh1[6], kh1[7]);
          *(uint4*)(KhT + k0 * 72 + lq * 8) = q0; *(uint4*)(KhT + (k0 + 1) * 72 + lq * 8) = q1; }
        if (lq == 0) *(float2*)(dec + k0) = make_float2(__expf(tot0), __expf(tot1));
        { uint2 a, bq; a.x = (v0 & 0xffffu) | (v1 << 16); a.y = (v2 & 0xffffu) | (v3 << 16); bq.x = (v0 >> 16) | (v1 & 0xffff0000u); bq.y = (v2 >> 16) | (v3 & 0xffff0000u);
          *(uint2*)(VT + (2 * vp) * 72 + vl * 4) = a; *(uint2*)(VT + (2 * vp + 1) * 72 + vl * 4) = bq; }
        BAR_LDS();
        const int mt = wv >> 1, vtb = (wv & 1) * 2;
        f32x4 accO[2], accA[2];
#pragma unroll
        for (int i = 0; i < 2; ++i) { accO[i] = (f32x4){0.f, 0.f, 0.f, 0.f}; accA[i] = (f32x4){0.f, 0.f, 0.f, 0.f}; }
        mma_lds_s<2, 128>(Qm + mt * 16 * 136, 136, Km + vtb * 16 * 136, 136, 16 * 136, accA, lane);
        mma_lds_s<2, 128>(Qs + mt * 16 * 136, 136, ST + vtb * 16 * 136, 136, 16 * 136, accO, lane);
#pragma unroll
        for (int i = 0; i < 2; ++i) { const int scol = (vtb + i) * 16 + l15;
#pragma unroll
            for (int j = 0; j < 4; ++j) { const int lrow = mt * 16 + quad * 4 + j; At[lrow * 72 + scol] = (bf16_t)f2bf(scol <= lrow ? accA[i][j] : 0.f); } }
        BAR_LDS();
        mma_lds_s<2, 64>(At + mt * 16 * 72, 72, VT + vtb * 16 * 72, 72, 16 * 72, accO, lane);
#pragma unroll
        for (int i = 0; i < 2; ++i) { const int nt = vtb + i;
#pragma unroll
            for (int j = 0; j < 4; ++j) Ob[(mt * 16 + quad * 4 + j) * 72 + nt * 16 + l15] = (bf16_t)f2bf(accO[i][j]); }
        const int vts = wv & 3;
#pragma unroll
        for (int i = 0; i < 4; ++i) accS[i] *= dec[((wv >> 2) * 4 + i) * 16 + l15];
        mma_lds_s<4, 64>(VT + vts * 16 * 72, 72, KhT + (wv >> 2) * 4 * 16 * 72, 72, 16 * 72, accS, lane);
#pragma unroll
        for (int i = 0; i < 4; ++i) { const int ktile = (wv >> 2) * 4 + i;
#pragma unroll
            for (int j = 0; j < 4; ++j) ST[(vts * 16 + quad * 4 + j) * 136 + ktile * 16 + l15] = (bf16_t)f2bf(accS[i][j]); }
        { const uint4 ow = *(const uint4*)(Ob + orow * 72 + oc8 * 8); const unsigned ou[4] = {ow.x, ow.y, ow.z, ow.w}, gu[4] = {gcur.x, gcur.y, gcur.z, gcur.w}; unsigned res[4]; float sq = 0.f;
#pragma unroll
          for (int i = 0; i < 4; ++i) { const float o0 = bflo(ou[i]), o1 = bfhi(ou[i]), g0 = bflo(gu[i]), g1 = bfhi(gu[i]); sq += o0 * o0 + o1 * o1;
              res[i] = pk2(o0 * g0 * __builtin_amdgcn_rcpf(1.f + __expf(-g0)), o1 * g1 * __builtin_amdgcn_rcpf(1.f + __expf(-g1))); }
          sq += __shfl_xor(sq, 1); sq += __shfl_xor(sq, 2);
          if ((lane & 3) == 0) p.ss_hg[(row_base + t0 + orow) * 16 + head * 4 + vh * 2 + (wv & 1)] = sq;
          *(uint4*)(gbase + (size_t)t0 * LDP) = make_uint4(res[0], res[1], res[2], res[3]); }
    }
    __syncthreads();
}

__device__ void s5_unit(CPAR p, int l, int g, int b, unsigned char* shm) {
    const int tid = lt_tid(), lane = tid & 63, wv = tid >> 6, quad = lane >> 4, l15 = lane & 15;
    bf16_t* U = (bf16_t*)shm;
    float* St = (float*)(shm + 66560);
    bf16_t* Sin = (bf16_t*)(shm + 66560 + 33280);
    const size_t row_base = (size_t)b * SEQL;
    for (int i = tid; i < 4096; i += 512) { const int tok = i >> 1, hf = i & 1; const uint4 v = *(const uint4*)(p.proj + (row_base + tok) * LDP + C_U + g * 16 + hf * 8);
        *(uint4*)(U + (tok >> 5) * 520 + (tok & 31) * 16 + hf * 8) = v; }
    __syncthreads();
    {
        f32x4 acc[4];
#pragma unroll
        for (int n = 0; n < 4; ++n) acc[n] = (f32x4){0.f, 0.f, 0.f, 0.f};
        const bf16_t* ap = p.wst + (size_t)(l & 1) * 32 * 65536 + (size_t)g * 65536 + (wv * 16 + l15) * 512 + quad * 8;
        bf16x8 af[16];
#pragma unroll
        for (int ks = 0; ks < 16; ++ks) af[ks] = *(const bf16x8*)(ap + ks * 32);
        const bf16_t* ub = U + l15 * 520 + quad * 8;
        bf16x8 fb[2][4];
#pragma unroll
        for (int n = 0; n < 4; ++n) fb[0][n] = *(const bf16x8*)(ub + n * 16 * 520);
#pragma unroll
        for (int ks = 0; ks < 16; ++ks) { const int cur = ks & 1, nxt = cur ^ 1;
            if (ks < 15) {
#pragma unroll
                for (int n = 0; n < 4; ++n) fb[nxt][n] = *(const bf16x8*)(ub + n * 16 * 520 + (ks + 1) * 32); }
            __builtin_amdgcn_sched_barrier(0);
#pragma unroll
            for (int n = 0; n < 4; ++n) acc[n] = MFMA16(af[ks], fb[cur][n], acc[n]);
            __builtin_amdgcn_sched_barrier(0); }
#pragma unroll
        for (int n = 0; n < 4; ++n)
#pragma unroll
            for (int j = 0; j < 4; ++j) St[(wv * 16 + quad * 4 + j) * 65 + n * 16 + l15] = acc[n][j];
    }
    __syncthreads();
    if (tid < 64) { const float* aT = p.aT + (l & 1) * 32 * 64 * 2; const float ar = aT[(g * 64 + tid) * 2], ai = aT[(g * 64 + tid) * 2 + 1]; float sr = 0.f, si = 0.f;
#pragma unroll 8
        for (int c = 0; c < 64; ++c) { Sin[c * 136 + tid] = (bf16_t)f2bf(sr); Sin[c * 136 + 64 + tid] = (bf16_t)f2bf(si);
            const float lr = St[tid * 65 + c], li = St[(64 + tid) * 65 + c]; const float nr = ar * sr - ai * si + lr, ni = ar * si + ai * sr + li; sr = nr; si = ni; } }
    __syncthreads();
    bf16_t* Kt = (bf16_t*)St;
    { const uint4* ksrc = (const uint4*)(p.ktab + (size_t)(l & 1) * 32 * 8192 + (size_t)g * 8192); uint4* kdst = (uint4*)Kt; kdst[tid] = ksrc[tid]; kdst[tid + 512] = ksrc[tid + 512]; }
    __syncthreads();
    const float4 dsk = *(const float4*)(p.s5_d + l * 512 + g * 16 + quad * 4);
    for (int it = 0; it < 4; ++it) {
        const int t = (it & 1) ? (8 * it + 7 - wv) : (8 * it + wv);
        f32x4 acc[4];
#pragma unroll
        for (int n = 0; n < 4; ++n) acc[n] = (f32x4){0.f, 0.f, 0.f, 0.f};
        const bf16_t* wp = p.woff + (size_t)(l & 1) * 32 * 65536 + (size_t)g * 65536 + (t * 16 + l15) * 128 + quad * 8;
        bf16x8 wf[4];
#pragma unroll
        for (int ks = 0; ks < 4; ++ks) wf[ks] = *(const bf16x8*)(wp + ks * 32);
        const bf16_t* kt = Kt + l15 * 16 + (quad & 1) * 8;
        {
            const bf16_t* ub = U + l15 * 520 + quad * 8; const int jmax = t >> 1; const bf16x8 zf = (bf16x8){0, 0, 0, 0, 0, 0, 0, 0};
            bf16x8 ac, an = zf, bc[4], bn[4];
            { const int lag = t - (quad >> 1); ac = zf; if (lag >= 0) ac = *(const bf16x8*)(kt + lag * 256); }
#pragma unroll
            for (int n = 0; n < 4; ++n) { bc[n] = *(const bf16x8*)(ub + n * 16 * 520); bn[n] = zf; }
            for (int j = 0; j <= jmax; ++j) {
                if (j < jmax) { const int lag = t - 2 * (j + 1) - (quad >> 1); an = zf; if (lag >= 0) an = *(const bf16x8*)(kt + lag * 256);
#pragma unroll
                    for (int n = 0; n < 4; ++n) bn[n] = *(const bf16x8*)(ub + n * 16 * 520 + (j + 1) * 32); }
                __builtin_amdgcn_sched_barrier(0);
#pragma unroll
                for (int n = 0; n < 4; ++n) acc[n] = MFMA16(ac, bc[n], acc[n]);
                __builtin_amdgcn_sched_barrier(0);
                ac = an;
#pragma unroll
                for (int n = 0; n < 4; ++n) bc[n] = bn[n]; }
        }
        {
            const bf16_t* sb = Sin + l15 * 136 + quad * 8;
            bf16x8 fb[2][4];
#pragma unroll
            for (int n = 0; n < 4; ++n) fb[0][n] = *(const bf16x8*)(sb + n * 16 * 136);
#pragma unroll
            for (int ks = 0; ks < 4; ++ks) { const int cur = ks & 1, nxt = cur ^ 1;
                if (ks < 3) {
#pragma unroll
                    for (int n = 0; n < 4; ++n) fb[nxt][n] = *(const bf16x8*)(sb + n * 16 * 136 + (ks + 1) * 32); }
                __builtin_amdgcn_sched_barrier(0);
#pragma unroll
                for (int n = 0; n < 4; ++n) acc[n] = MFMA16(wf[ks], fb[cur][n], acc[n]);
                __builtin_amdgcn_sched_barrier(0); }
        }
#pragma unroll
        for (int n = 0; n < 4; ++n) { const int c = n * 16 + l15; const uint2 uw = *(const uint2*)(U + c * 520 + t * 16 + quad * 4);
            float y[4] = {acc[n][0] + dsk.x * bflo(uw.x), acc[n][1] + dsk.y * bfhi(uw.x), acc[n][2] + dsk.z * bflo(uw.y), acc[n][3] + dsk.w * bfhi(uw.y)};
#pragma unroll
            for (int j = 0; j < 4; ++j) { const float z = 0.7978845608f * (y[j] + 0.044715f * y[j] * y[j] * y[j]); const float th = 1.f - 2.f / (__expf(2.f * z) + 1.f); y[j] = 0.5f * y[j] * (1.f + th); }
            uint2 w; w.x = pk2(y[0], y[1]); w.y = pk2(y[2], y[3]);
            *(uint2*)(p.proj + (row_base + c * 32 + t) * LDP + C_U + g * 16 + quad * 4) = w; }
    }
    __syncthreads();
}

__device__ void phase_mixA(CPAR p, int l, unsigned char* shm) {
    const int G = gridDim.x, bid = lt_bid();
    const bool split = (G == 256);
    for (int u = bid; u < 256; u += G) bcconv_unit(p, l, u);
    TSTAMP(6);
    for (int u = (split && bid >= 128) ? 128 : bid; u < 128; u += G) { const int pi = (u & 7) * 8 + (u >> 4), vh = (u >> 3) & 1;
        hgrn_unit(p, l, pi >> 2, pi & 3, vh, shm); }
    TSTAMP(7);
    { int u0 = bid, u1 = 512, st = G; if (split) { const int k = bid - 128, gq = ((k & 7) * 4 + (k >> 5)) * 4 + ((k >> 3) & 3);
        u0 = bid >= 128 ? gq * 4 : 512; u1 = bid >= 128 ? u0 + 4 : 512; st = 1; }
      for (int u = u0; u < u1; u += st) s5_unit(p, l, u >> 4, u & 15, shm); }
    TSTAMP(8);
    if (l < 3 && (!split || bid >= 128)) convert_weights(p, l + 1, split ? bid - 128 : bid, split ? 128 : G, shm);
    TSTAMP(10);
}
__device__ void phase_mixB(CPAR p, int l, unsigned char* shm) {
    const int G = gridDim.x, bid = lt_bid();
    for (int u = bid; u < 256; u += G) { const int bg = (u & 7) * 4 + (u >> 6), r = (u >> 3) & 7;
        ssd_unit(p, l, bg >> 1, (bg & 1) * 8 + r, shm); }
    TSTAMP(9);
}

__device__ __forceinline__ void fin_scales(CPAR p, int row, int lane, float (&sc)[4]) {
    float a0 = 0.f, a1 = 0.f, hh = 0.f, cc = 0.f;
    const float4* s1 = (const float4*)(p.ss_ssd + (size_t)row * 32);
#pragma unroll
    for (int i = 0; i < 4; ++i) { const float4 u = s1[i], v = s1[4 + i]; a0 += u.x + u.y + u.z + u.w; a1 += v.x + v.y + v.z + v.w; }
    { const float4 u = *(const float4*)(p.ss_hg + (size_t)row * 16 + (lane >> 4) * 4); hh = u.x + u.y + u.z + u.w; }
    const float4* s3 = (const float4*)(p.ss_s5 + (size_t)row * 16);
#pragma unroll
    for (int i = 0; i < 4; ++i) { const float4 u = s3[i]; cc += u.x + u.y + u.z + u.w; }
    sc[0] = rsqrtf(a0 * (1.f / 512.f) + EPSN); sc[1] = rsqrtf(a1 * (1.f / 512.f) + EPSN); sc[2] = rsqrtf(hh * (1.f / 128.f) + EPSN); sc[3] = rsqrtf(cc * (1.f / 512.f) + EPSN);
}
__device__ __forceinline__ uint4 scale8(uint4 v, float s) {
    v.x = pk2(bflo(v.x) * s, bfhi(v.x) * s); v.y = pk2(bflo(v.y) * s, bfhi(v.y) * s); v.z = pk2(bflo(v.z) * s, bfhi(v.z) * s); v.w = pk2(bflo(v.w) * s, bfhi(v.w) * s); return v;
}
__device__ void phase_fin(CPAR p) {
    const int tid = lt_tid(), lane = tid & 63, wv = tid >> 6;
    const int rstep = gridDim.x * 8;
    for (int row = lt_bid() * 8 + wv; row < NTOK; row += 2 * rstep) {
        const int row2 = row + rstep; const bool two = row2 < NTOK;
        uint4 va[4], vb[4]; float sa[4], sb[4];
#pragma unroll
        for (int i = 0; i < 4; ++i) { va[i] = *(const uint4*)(p.proj + (size_t)row * LDP + i * 512 + lane * 8); if (two) vb[i] = *(const uint4*)(p.proj + (size_t)row2 * LDP + i * 512 + lane * 8); }
        fin_scales(p, row, lane, sa); if (two) fin_scales(p, row2, lane, sb);
#pragma unroll
        for (int i = 0; i < 4; ++i) { *(uint4*)(p.proj + (size_t)row * LDP + i * 512 + lane * 8) = scale8(va[i], sa[i]); if (two) *(uint4*)(p.proj + (size_t)row2 * LDP + i * 512 + lane * 8) = scale8(vb[i], sb[i]); }
    }
}

__device__ void fill_seg_table(CPAR p, unsigned char* shm) {
    const int tid = lt_tid(), slot = tid >> 8, r = tid & 255;
    pg8::StaticOrder S; S.init(NTOK, 1024, (int)gridDim.x, lt_bid());
    pg8::Unit un; float* rt = (float*)(shm + 131072);
    if (S.next(slot, un)) {
        const size_t row = (size_t)un.pm * 256 + r; float ms[7];
        const float4* s1 = (const float4*)(p.ss_ssd + row * 32); float a0 = 0.f, a1 = 0.f;
#pragma unroll
        for (int i = 0; i < 4; ++i) { const float4 u = s1[i], v = s1[4 + i]; a0 += u.x + u.y + u.z + u.w; a1 += v.x + v.y + v.z + v.w; }
        ms[0] = a0 * (1.f / 512.f); ms[1] = a1 * (1.f / 512.f);
        const float4* s2 = (const float4*)(p.ss_hg + row * 16);
#pragma unroll
        for (int h = 0; h < 4; ++h) { const float4 u = s2[h]; ms[2 + h] = (u.x + u.y + u.z + u.w) * (1.f / 128.f); }
        const float4* s3 = (const float4*)(p.ss_s5 + row * 16); float cc = 0.f;
#pragma unroll
        for (int i = 0; i < 4; ++i) { const float4 u = s3[i]; cc += u.x + u.y + u.z + u.w; }
        ms[6] = cc * (1.f / 512.f);
        float sc[7];
#pragma unroll
        for (int i = 0; i < 7; ++i) sc[i] = rsqrtf(ms[i] + EPSN);
#pragma unroll
        for (int i = 0; i < 6; ++i) rt[(slot * 7 + i) * 256 + r] = sc[i] / sc[i + 1];
        rt[(slot * 7 + 6) * 256 + r] = sc[6];
    }
    __syncthreads();
}

template <class Epi> __device__ __forceinline__ void run_gemm(unsigned char* shm, const pg8::Gemm& g, const Epi& E) {
    pg8::StaticOrder S; S.init(g.M, g.N, (int)gridDim.x, lt_bid());
    pg8::gemm_phase<Epi, pg8::StaticOrder, false>((PG8_LAS unsigned char*)shm, g, S, E, nullptr);
}

__global__ __launch_bounds__(512, 2) void mega(Params p_unused) {
    extern __shared__ __attribute__((aligned(16))) unsigned char shm[];
    __shared__ uint4 xb_words;
    cg::grid_group grid = cg::this_grid();
    if (threadIdx.x == 0) xb_words = make_uint4(0u, 0u, 0u, 0u);
    __syncthreads();
    { CPAR p = *GETP(); (void)xcd_barrier_post(p.bar, (volatile LAS unsigned*)&xb_words); }
#define GSYNC() do { CPAR _q = *GETP(); XcdBarrier _b; _b.bar = _q.bar; _b.x = xb_xcc_id(); _b.st = (volatile LAS unsigned*)&xb_words; xcd_barrier(_b); } while (0)
#if TPROBE >= 0
    if (blockIdx.x == TBLK && threadIdx.x == 0) { CPAR _p = *GETP(); unsigned long long* _w = (unsigned long long*)_p.wdt; _w[0] = wall_clock64(); _w[1] = 0; }
#endif
#pragma unroll 1
    for (int l = 0; l < 4; ++l) {
#if PH & 1
        { CPAR p = *GETP(); phase_prep(p, l, shm); }
#endif
        if (l == 0) grid.sync(); else GSYNC();
        TSTAMP(0);
#if PH & 2
        { CPAR p = *GETP(); pg8::Gemm g{p.xb, p.winT + (size_t)(l & 1) * LDP * DM, NTOK, LDP, DM, DM}; EpiIn e{p.proj, p.rstd}; run_gemm(shm, g, e); }
#endif
        GSYNC(); TSTAMP(1);
#if PH & 4
        { CPAR p = *GETP(); phase_mixA(p, l, shm); }
#endif
        GSYNC(); TSTAMP(2);
#if PH & 4
        { CPAR p = *GETP(); phase_mixB(p, l, shm); }
#endif
#if PH & 8
        { CPAR p = *GETP(); pg8::Gemm g{p.proj + C_U, p.wgluT + (size_t)(l & 1) * 1024 * 512, NTOK, 1024, 512, LDP}; EpiGlu e{p.proj, p.glu_b + l * 1024, p.ss_s5}; run_gemm(shm, g, e); }
#endif
        GSYNC(); TSTAMP(3);
        { CPAR p = *GETP(); fill_seg_table(p, shm); }
        { CPAR p = *GETP(); pg8::Gemm g{p.proj, p.woutT + (size_t)(l & 1) * 1024 * 2048, NTOK, 1024, 2048, LDP}; EpiOutSeg e{p.proj}; run_gemm(shm, g, e); }
        GSYNC(); TSTAMP(5);
    }
#if PH & 1
    { CPAR p = *GETP(); phase_prep(p, 4, shm); }
#endif
#if TPROBE >= 0
    __syncthreads(); TSTAMP(0);
    grid.sync();
    if (blockIdx.x == TBLK && threadIdx.x == 0) { CPAR p = *GETP(); p.out[0] = (float)(((unsigned long long*)p.wdt)[1]) * 0.001f; }
#endif
}

extern "C" void kernel_launch(void* const* d_in, const int* in_sizes, int n_in, void* d_out, int out_size, void* d_ws, size_t ws_size, hipStream_t stream) {
    constexpr size_t kLds = 162816;
    static int grid_blocks = 0;
    if (!grid_blocks) {
        int dev = 0, cus = 0, per_cu = 0;
        hipGetDevice(&dev);
        hipDeviceGetAttribute(&cus, hipDeviceAttributeMultiprocessorCount, dev);
        hipFuncSetAttribute((const void*)mega, hipFuncAttributeMaxDynamicSharedMemorySize, (int)kLds);
        hipOccupancyMaxActiveBlocksPerMultiprocessor(&per_cu, mega, 512, kLds);
        if (per_cu < 1) per_cu = 1;
        grid_blocks = cus * per_cu;
        if (grid_blocks > 256) grid_blocks = 256;
        if (grid_blocks != 256) fprintf(stderr, "this build assumes a 256-workgroup grid (got %d)\n", grid_blocks);
    }
    Params p{};
    const float** f = (const float**)&p;
    for (int i = 0; i < 24; ++i) f[i] = (const float*)d_in[i];
    p.out = (float*)d_out;
    p.bcb = (bf16_t*)d_out;
    unsigned char* w = (unsigned char*)d_ws; size_t off = 0;
    auto take = [&](size_t bytes) { unsigned char* r = w + off; off += (bytes + 255) & ~(size_t)255; return r; };
    p.proj = (bf16_t*)take((size_t)NTOK * LDP * 2);
    p.xb = (bf16_t*)take((size_t)NTOK * DM * 2);
    p.winT = (bf16_t*)take((size_t)2 * LDP * DM * 2);
    p.woutT = (bf16_t*)take((size_t)2 * 1024 * 2048 * 2);
    p.wgluT = (bf16_t*)take((size_t)2 * 1024 * 512 * 2);
    p.ktab = (bf16_t*)take((size_t)2 * 32 * 8192 * 2);
    p.woff = (bf16_t*)take((size_t)2 * 32 * 65536 * 2);
    p.wst = (bf16_t*)take((size_t)2 * 32 * 65536 * 2);
    p.wdt = (float*)take(256);
    p.aT = (float*)take((size_t)2 * 32 * 64 * 2 * 4);
    p.lb = (float*)take((size_t)4 * 512 * 4);
    p.rstd = (float*)take((size_t)NTOK * 4);
    p.dtraw = (float*)take((size_t)NTOK * 16 * 4);
    p.ss_ssd = (float*)take((size_t)NTOK * 32 * 4);
    p.ss_hg = (float*)take((size_t)NTOK * 32 * 4);
    p.ss_s5 = (float*)take((size_t)NTOK * 16 * 4);
    p.bar = (unsigned*)take((size_t)XCD_BAR_WORDS * 4);
    if (off > ws_size) { fprintf(stderr, "workspace too small: need %zu have %zu\n", off, ws_size); return; }
    hipMemsetAsync(p.bar, 0, (size_t)XCD_BAR_WORDS * 4, stream);
    void* args[] = {&p};
    hipError_t e = hipLaunchCooperativeKernel((const void*)mega, dim3(grid_blocks), dim3(512), args, kLds, stream);
    if (e != hipSuccess) fprintf(stderr, "cooperative launch failed: %s (grid %d)\n", hipGetErrorString(e), grid_blocks);
}
```

```cpp
#include <hip/hip_runtime.h>
#include <hip/hip_cooperative_groups.h>
#include <cstdio>
namespace cg = cooperative_groups;
__device__ __forceinline__ int lt_tid() { int t = threadIdx.x; asm volatile("" : "+v"(t)); return t; }
__device__ __forceinline__ int lt_bid() { int t = blockIdx.x; asm volatile("" : "+s"(t)); return t; }
namespace pg8 {
#define PG8_LAS __attribute__((address_space(3)))
typedef unsigned short bf16_t;
typedef short bf16x8 __attribute__((ext_vector_type(8)));
typedef float f32x4 __attribute__((ext_vector_type(4)));
typedef unsigned u32x4 __attribute__((ext_vector_type(4)));
constexpr int BM = 256, BK = 64, HALF = 128, HTB = HALF * BK * 2  , STAGE_BYTES = 8 * HTB, NXCD = 8, WGM = 8;

__host__ __device__ __forceinline__ int lds_byte(int r, int c) { const int st = (r >> 4) * 2 + (c >> 5), rr = r & 15, cc = c & 31, ob = rr * 64 + cc * 2; return st * 1024 + (ob ^ (((ob >> 9) & 1) << 5)); }
__host__ __device__ __forceinline__ void stage_rc(int b, int& R, int& C) { const int st = b / 1024, sb = b % 1024, swz = sb ^ (((sb >> 9) & 1) << 5); R = (st >> 1) * 16 + swz / 64; C = (st & 1) * 32 + (swz % 64) / 2; }
__host__ __device__ __forceinline__ int perm32(int rho) { const int n = rho >> 4, i = rho & 15; return 8 * (i >> 2) + 4 * n + (i & 3); }

struct Unit { int pm, pn; };
struct Gemm { const bf16_t* A; const bf16_t* Bt; int M, N, K, lda; };

struct StaticOrder {
    int nM, nN, nwg, G, c;
    __host__ __device__ void init(int M, int N, int G_, int c_) { nM = M / BM; nN = N / BM; nwg = nM * nN; G = G_; c = c_; }
    __host__ __device__ bool next(int i, Unit& u) const {
        const long L = (long)i * G + c; if (L >= nwg) return false;
        int wgid = (int)L; { const int q = nwg / NXCD, r = nwg % NXCD, xcd = wgid % NXCD, off = wgid / NXCD; wgid = (xcd < r ? xcd * (q + 1) : r * (q + 1) + (xcd - r) * q) + off; }
        const int nig = WGM * nN, gid = wgid / nig, fm = gid * WGM, gsz = (nM - fm) < WGM ? (nM - fm) : WGM;
        u.pm = fm + ((wgid % nig) % gsz); u.pn = (wgid % nig) / gsz; return true;
    }
    __device__ __forceinline__ void a_ready(const Unit&) const {}
    __device__ __forceinline__ void done(const Unit&) const {}
};

__device__ __forceinline__ unsigned cvt_pk_bf16(float lo, float hi) { unsigned r; asm volatile("v_cvt_pk_bf16_f32 %0, %1, %2" : "=v"(r) : "v"(lo), "v"(hi)); return r; }
template <class Epi, class Sched, bool STAMP = false>
__device__ __forceinline__ void gemm_phase(PG8_LAS unsigned char* lds, const Gemm g, const Sched& S, const Epi& E, unsigned long long* stamps) {
    const int tid = lt_tid(), wid = __builtin_amdgcn_readfirstlane(tid >> 6), lane = tid & 63, wr = wid >> 2, wc = wid & 3, fr = lane & 15, fq = lane >> 4;
    const int K = g.K, nt = K / BK;
    int ts_lo = 0, ts_hi = 0, nts = 0; const unsigned long long rt_entry = STAMP ? (unsigned long long)wall_clock64() : 0ull;
#define PG8_STAMP() do { if (STAMP && wid == 0 && nts < 64) { const unsigned long long _c = (unsigned long long)clock64(); \
        ts_lo = (lane == nts) ? (int)(unsigned)_c : ts_lo; ts_hi = (lane == nts) ? (int)(unsigned)(_c >> 32) : ts_hi; ++nts; } } while (0)
    PG8_STAMP();
    unsigned voffA[2], voffB[2];
#pragma unroll
    for (int i = 0; i < 2; ++i) { int R, C; stage_rc(tid * 16 + i * 8192, R, C); const int Rb = Epi::PERM ? ((R & ~31) + perm32(R & 31)) : R;
        voffA[i] = (unsigned)(R * g.lda + C) * 2u; voffB[i] = (unsigned)(Rb * K + C) * 2u; }
    const size_t kstep = (size_t)(BK * 2);
    const size_t hstep = (size_t)HALF * K * 2;
    const size_t tstep = 2 * hstep; const size_t hstepA = (size_t)HALF * g.lda * 2; const size_t tstepA = 2 * hstepA;
    const unsigned ldsw = (unsigned)wid * 1024u;
    const int aoff = lds_byte(wr * 64 + fr, fq * 8), boff = lds_byte(wc * 32 + fr, fq * 8);
#define PG8_SA(b, h) (((b) * 2 + (h)) * HTB)
#define PG8_SB(b, h) ((4 + (b) * 2 + (h)) * HTB)
#define PG8_STAGE(bufoff, gbase, voff) do { _Pragma("unroll") for (int _i = 0; _i < 2; ++_i) \
        __builtin_amdgcn_global_load_lds((const unsigned*)((const char*)(gbase) + (voff)[_i]), (PG8_LAS unsigned*)(lds + (bufoff) + ldsw + _i * 8192), 16, 0, 0); } while (0)
#define PG8_LDA(dst, b, h) do { _Pragma("unroll") for (int m = 0; m < 4; ++m) _Pragma("unroll") for (int k = 0; k < 2; ++k) dst[m][k] = *(const PG8_LAS bf16x8*)(lds + PG8_SA(b, h) + aoff + m * 2048 + k * 1024); } while (0)
#define PG8_LDB(dst, b, h) do { _Pragma("unroll") for (int n = 0; n < 2; ++n) _Pragma("unroll") for (int k = 0; k < 2; ++k) dst[n][k] = *(const PG8_LAS bf16x8*)(lds + PG8_SB(b, h) + boff + n * 2048 + k * 1024); } while (0)
#define PG8_MMA(ai, bj, At, Bt) do { __builtin_amdgcn_s_setprio(1); _Pragma("unroll") for (int m = 0; m < 4; ++m) _Pragma("unroll") for (int n = 0; n < 2; ++n) _Pragma("unroll") for (int k = 0; k < 2; ++k) \
        acc[ai][bj][m][n] = __builtin_amdgcn_mfma_f32_16x16x32_bf16(Bt[n][k], At[m][k], acc[ai][bj][m][n], 0, 0, 0); __builtin_amdgcn_s_setprio(0); } while (0)
#define PG8_WAIT_V(n) asm volatile("s_waitcnt vmcnt(" #n ")" ::: "memory")
#define PG8_WAIT_L(n) asm volatile("s_waitcnt lgkmcnt(" #n ")" ::: "memory")
#define PG8_BAR __builtin_amdgcn_s_barrier()
#define PG8_SCHED __builtin_amdgcn_sched_barrier(0)
    Unit cur, nxt; int ui = 0;
    if (!S.next(0, cur)) return;
    f32x4 acc[2][2][4][2];
#pragma unroll
    for (int a = 0; a < 2; ++a)
#pragma unroll
        for (int b = 0; b < 2; ++b)
#pragma unroll
            for (int m = 0; m < 4; ++m)
#pragma unroll
                for (int n = 0; n < 2; ++n) acc[a][b][m][n] = (f32x4){0.f, 0.f, 0.f, 0.f};
    bf16x8 At[4][2], B0[2][2], B1[2][2];
    const char* cA = (const char*)g.A + (size_t)cur.pm * tstepA; const char* cB = (const char*)g.Bt + (size_t)cur.pn * tstep;
    S.a_ready(cur);
    PG8_STAGE(PG8_SB(0, 0), cB, voffB); PG8_STAGE(PG8_SA(0, 0), cA, voffA); PG8_STAGE(PG8_SB(0, 1), cB + hstep, voffB); PG8_STAGE(PG8_SA(0, 1), cA + hstepA, voffA);
    if (wr == 1) PG8_BAR;
    PG8_WAIT_V(4); PG8_BAR;
    PG8_STAGE(PG8_SB(1, 0), cB + kstep, voffB); PG8_STAGE(PG8_SA(1, 0), cA + kstep, voffA); PG8_STAGE(PG8_SB(1, 1), cB + hstep + kstep, voffB);
    PG8_WAIT_V(6); PG8_BAR;
    PG8_STAMP();
    for (;;) {
        const bool has_next = S.next(ui + 1, nxt);
        const char* nA = has_next ? (const char*)g.A + (size_t)nxt.pm * tstepA : cA; const char* nB = has_next ? (const char*)g.Bt + (size_t)nxt.pn * tstep : cB;
        for (int t = 0; t < nt; t += 2) {
            if constexpr (Epi::SEG) { if (t >= 8 && E.boundary(t)) E.rescale(acc, t, ui, wr, fr, lds); }
            const bool last = (t == nt - 2);
            const char* a1 = cA + (size_t)(t + 1) * kstep;
            const char* a2 = last ? nA : cA + (size_t)(t + 2) * kstep; const char* b2 = last ? nB : cB + (size_t)(t + 2) * kstep;
            const char* a3 = a2 + kstep; const char* b3 = b2 + kstep;
            if (last && has_next) S.a_ready(nxt);
            PG8_LDB(B0, 0, 0); PG8_SCHED; PG8_LDA(At, 0, 0); PG8_STAGE(PG8_SA(1, 1), a1 + hstepA, voffA);
            PG8_WAIT_L(8); PG8_BAR; PG8_WAIT_L(0); PG8_MMA(0, 0, At, B0); PG8_BAR; PG8_SCHED;
            PG8_LDB(B1, 0, 1); PG8_STAGE(PG8_SB(0, 0), b2, voffB);
            PG8_BAR; PG8_WAIT_L(0); PG8_MMA(0, 1, At, B1); PG8_BAR;
            PG8_LDA(At, 0, 1); PG8_STAGE(PG8_SA(0, 0), a2, voffA);
            PG8_BAR; PG8_WAIT_L(0); PG8_MMA(1, 0, At, B0); PG8_BAR; PG8_SCHED;
            PG8_STAGE(PG8_SB(0, 1), b2 + hstep, voffB);
            PG8_WAIT_V(6); PG8_BAR; PG8_MMA(1, 1, At, B1); PG8_BAR;
            PG8_LDB(B0, 1, 0); PG8_SCHED; PG8_LDA(At, 1, 0); PG8_STAGE(PG8_SA(0, 1), a2 + hstepA, voffA);
            PG8_WAIT_L(8); PG8_BAR; PG8_WAIT_L(0); PG8_MMA(0, 0, At, B0); PG8_BAR; PG8_SCHED;
            PG8_LDB(B1, 1, 1); PG8_STAGE(PG8_SB(1, 0), b3, voffB);
            PG8_BAR; PG8_WAIT_L(0); PG8_MMA(0, 1, At, B1); PG8_BAR;
            PG8_LDA(At, 1, 1); PG8_STAGE(PG8_SA(1, 0), a3, voffA);
            PG8_BAR; PG8_WAIT_L(0); PG8_MMA(1, 0, At, B0); PG8_BAR; PG8_SCHED;
            PG8_STAGE(PG8_SB(1, 1), b3 + hstep, voffB);
            PG8_WAIT_V(6); PG8_BAR; PG8_MMA(1, 1, At, B1); PG8_BAR;
        }
        PG8_STAMP();
        if constexpr (Epi::SEG) { E.fin(acc, cur, wr, wc, fr, fq, ui, lds); } else if constexpr (!Epi::AFTER_DRAIN) { E(acc, cur, wr, wc, fr, fq); S.done(cur); }
        PG8_STAMP();
        if (!has_next) break;
#pragma unroll
        for (int a = 0; a < 2; ++a)
#pragma unroll
            for (int b = 0; b < 2; ++b)
#pragma unroll
                for (int m = 0; m < 4; ++m)
#pragma unroll
                    for (int n = 0; n < 2; ++n) acc[a][b][m][n] = (f32x4){0.f, 0.f, 0.f, 0.f};
        cur = nxt; cA = nA; cB = nB; ++ui;
    }
    PG8_WAIT_V(0);
    if (wr == 0) PG8_BAR;
    PG8_BAR;
    if constexpr (Epi::AFTER_DRAIN) { E.fused(acc, cur, wr, wc, fr, fq, lds, wid, lane); S.done(cur); }
    PG8_STAMP();
    if (STAMP && wid == 0) { stamps[lane] = lane < nts ? (((unsigned long long)(unsigned)ts_hi << 32) | (unsigned)ts_lo) : 0ull;
        if (lane == 62) stamps[62] = rt_entry; if (lane == 63) stamps[63] = (unsigned long long)wall_clock64(); }
#undef PG8_STAMP
#undef PG8_SA
#undef PG8_SB
#undef PG8_STAGE
#undef PG8_LDA
#undef PG8_LDB
#undef PG8_MMA
#undef PG8_WAIT_V
#undef PG8_WAIT_L
#undef PG8_BAR
#undef PG8_SCHED
}
}

using pg8::bf16_t; using pg8::bf16x8; using pg8::f32x4;
constexpr int NTOK = 32768, SEQL = 2048, DM = 1024, LDP = 5632, INC = 5648;
constexpr int C_Z = 0, C_G = 1024, C_SG = 1536, C_XBC = 2048, C_Q = 3584, C_F = 4096, C_I = 4608, C_U = 5120, C_O = 2048;
constexpr float EPSN = 1e-6f;

struct Params {
    const float *x, *pre_w, *post_w, *w_in, *w_out, *conv_w, *conv_b, *dt_bias, *a_log, *ssd_d, *ssd_nw, *hg_lb, *hg_nw,
        *lam_re, *lam_im, *log_step, *b_re, *b_im, *c_re, *c_im, *s5_d, *glu_w, *glu_b, *s5_nw;
    float* out;
    bf16_t *proj, *xb, *winT, *woutT, *wgluT, *ktab, *woff, *wst;
    float *wdt, *aT, *lb, *rstd, *dtraw, *ss_ssd, *ss_hg, *ss_s5;
    unsigned* bar;
    bf16_t* bcb;
};

#define CPAR const __attribute__((address_space(4))) Params&
#define GETP() ({ const __attribute__((address_space(4))) Params* _pp = (const __attribute__((address_space(4))) Params*)__builtin_amdgcn_kernarg_segment_ptr(); asm volatile("" : "+s"(_pp)); _pp; })
__device__ __forceinline__ unsigned f2bf(float f) { unsigned u = __float_as_uint(f); u += 0x7FFFu + ((u >> 16) & 1u); return u >> 16; }
__device__ __forceinline__ float bf2f(unsigned b) { return __uint_as_float(b << 16); }
__device__ __forceinline__ float bflo(unsigned w) { return __uint_as_float(w << 16); }
__device__ __forceinline__ float bfhi(unsigned w) { return __uint_as_float(w & 0xffff0000u); }
__device__ __forceinline__ unsigned pk2(float a, float b) { unsigned r; asm("v_cvt_pk_bf16_f32 %0, %1, %2" : "=v"(r) : "v"(a), "v"(b)); return r; }
__device__ __forceinline__ float sigmoidf_(float v) { return 1.f / (1.f + __expf(-v)); }
__device__ __forceinline__ float siluf_(float v) { return v / (1.f + __expf(-v)); }
__device__ __forceinline__ float wave_sum(float v) {
#pragma unroll
    for (int o = 32; o >= 1; o >>= 1) v += __shfl_xor(v, o);
    return v;
}
__device__ __forceinline__ f32x4 mma_lds(const bf16_t* A, int lda, const bf16_t* Bt, int ldb, int K, f32x4 acc, int lane) {
    const bf16_t* ap = A + (lane & 15) * lda + (lane >> 4) * 8;
    const bf16_t* bp = Bt + (lane & 15) * ldb + (lane >> 4) * 8;
#pragma unroll 4
    for (int k0 = 0; k0 < K; k0 += 32) {
        bf16x8 a = *(const bf16x8*)(ap + k0), b = *(const bf16x8*)(bp + k0);
        acc = __builtin_amdgcn_mfma_f32_16x16x32_bf16(a, b, acc, 0, 0, 0);
    }
    return acc;
}

template <int NT, int K>
__device__ __forceinline__ void mma_lds_n(const bf16_t* A, int lda, const bf16_t* Bt, int ldb, int bstride, f32x4 (&acc)[NT], int lane) {
    const bf16_t* ap = A + (lane & 15) * lda + (lane >> 4) * 8;
    const bf16_t* bp = Bt + (lane & 15) * ldb + (lane >> 4) * 8;
    constexpr int KS = K / 32;
    bf16x8 a[2], b[2][NT];
    a[0] = *(const bf16x8*)ap;
#pragma unroll
    for (int i = 0; i < NT; ++i) b[0][i] = *(const bf16x8*)(bp + i * bstride);
#pragma unroll
    for (int ks = 0; ks < KS; ++ks) { const int cur = ks & 1, nxt = cur ^ 1;
        if (ks + 1 < KS) { a[nxt] = *(const bf16x8*)(ap + (ks + 1) * 32);
#pragma unroll
            for (int i = 0; i < NT; ++i) b[nxt][i] = *(const bf16x8*)(bp + i * bstride + (ks + 1) * 32); }
        __builtin_amdgcn_sched_barrier(0);
#pragma unroll
        for (int i = 0; i < NT; ++i) acc[i] = __builtin_amdgcn_mfma_f32_16x16x32_bf16(a[cur], b[cur][i], acc[i], 0, 0, 0);
        __builtin_amdgcn_sched_barrier(0); }
}

template <int NT, int K>
__device__ __forceinline__ void mma_lds_s(const bf16_t* A, int lda, const bf16_t* Bt, int ldb, int bstride, f32x4 (&acc)[NT], int lane) {
    const bf16_t* ap = A + (lane & 15) * lda + (lane >> 4) * 8;
    const bf16_t* bp = Bt + (lane & 15) * ldb + (lane >> 4) * 8;
#pragma unroll
    for (int k0 = 0; k0 < K; k0 += 32) { const bf16x8 a = *(const bf16x8*)(ap + k0);
#pragma unroll
        for (int i = 0; i < NT; ++i) { const bf16x8 b = *(const bf16x8*)(bp + i * bstride + k0); acc[i] = __builtin_amdgcn_mfma_f32_16x16x32_bf16(a, b, acc[i], 0, 0, 0); } }
}

#define XB_TMO      128
#define XB_XCNT(j)  (256  + 64 * (j))
#define XB_XSUB(j)  (1280 + 64 * (j))
#define XB_XGEN(j)  (2304 + 64 * (j))
#define XB_TOP      3328
#define XB_TOPGEN   3392
#define XCD_BAR_WORDS 3456
#define XB_SPIN_CAP (1u << 18)
#define LAS __attribute__((address_space(3)))

__device__ __forceinline__ unsigned xb_ld(unsigned* p)              { return __hip_atomic_load(p, __ATOMIC_RELAXED, __HIP_MEMORY_SCOPE_AGENT); }
__device__ __forceinline__ unsigned xb_add(unsigned* p, unsigned v) { return __hip_atomic_fetch_add(p, v, __ATOMIC_RELAXED, __HIP_MEMORY_SCOPE_AGENT); }
__device__ __forceinline__ unsigned xb_xcc_id() { return (unsigned)__builtin_amdgcn_s_getreg((3 << 11) | 20) & 0xFu; }
#define XB_SPIN(cond, bar) do { unsigned _sp = 0; while (cond) { __builtin_amdgcn_s_sleep(1); \
    if ((++_sp & 255u) == 0u) { if (xb_ld(&(bar)[XB_TMO])) break; if (_sp > XB_SPIN_CAP) { atomicAdd(&(bar)[XB_TMO], 1u); break; } } } } while (0)

struct XcdBarrier {
    unsigned* bar;
    bf16_t* bcb; unsigned x;
    volatile LAS unsigned* st;
};

__device__ __forceinline__ XcdBarrier xcd_barrier_post(unsigned* bar, volatile LAS unsigned* st) {
    XcdBarrier b; b.bar = bar; b.x = xb_xcc_id(); b.st = st;
    if (threadIdx.x == 0) (void)xb_add(&bar[XB_XCNT(b.x)], 1u);
    return b;
}
__device__ __forceinline__ void xcd_barrier_complete(unsigned* bar, unsigned x, unsigned& nloc, unsigned& nx) {
    const unsigned G = gridDim.x * gridDim.y * gridDim.z;
    unsigned sum, cnt, mine, sp = 0u;
    for (;;) {
        sum = 0u; cnt = 0u; mine = 0u;
#pragma unroll
        for (unsigned j = 0; j < 16; ++j) { const unsigned c = xb_ld(&bar[XB_XCNT(j)]); sum += c; cnt += (c > 0u) ? 1u : 0u; mine = (j == x) ? c : mine; }
        if (sum == G) break;
        __builtin_amdgcn_s_sleep(1);
        if ((++sp & 255u) == 0u) { if (xb_ld(&bar[XB_TMO])) break; if (sp > XB_SPIN_CAP) { atomicAdd(&bar[XB_TMO], 1u); break; } }
    }
    nloc = mine > 0u ? mine : 1u; nx = cnt > 0u ? cnt : 1u;
}

__device__ __forceinline__ void xcd_barrier(const XcdBarrier& b) {
    asm volatile("s_waitcnt vmcnt(0)" ::: "memory");
    __syncthreads();
    if (threadIdx.x == 0) {
        unsigned* bar = b.bar;
        __builtin_amdgcn_s_waitcnt(0);
        unsigned nloc = b.st[0], nx = b.st[1];
        if (nloc == 0u) { xcd_barrier_complete(bar, b.x, nloc, nx); b.st[0] = nloc; b.st[1] = nx; }
        const unsigned old = xb_add(&bar[XB_XSUB(b.x)], 1u);
        const unsigned gen = old / nloc;
        if (old + 1u == (gen + 1u) * nloc) {
            __builtin_amdgcn_fence(__ATOMIC_RELEASE, "agent");
            asm volatile("s_waitcnt vmcnt(0)" ::: "memory");
            const unsigned og = xb_add(&bar[XB_TOP], 1u);
            const unsigned tg = og / nx;
            if (og + 1u == (tg + 1u) * nx) xb_add(&bar[XB_TOPGEN], 1u);
            else XB_SPIN(xb_ld(&bar[XB_TOPGEN]) == tg, bar);
            __builtin_amdgcn_fence(__ATOMIC_ACQUIRE, "agent");
            xb_add(&bar[XB_XGEN(b.x)], 1u);
            asm volatile("s_waitcnt vmcnt(0)" ::: "memory");
        } else {
            XB_SPIN(xb_ld(&bar[XB_XGEN(b.x)]) == gen, bar);
            __builtin_amdgcn_fence(__ATOMIC_ACQUIRE, "agent");
            asm volatile("s_waitcnt vmcnt(0)" ::: "memory");
        }
    }
    __syncthreads();
}


struct EpiIn {
    static constexpr bool PERM = false, AFTER_DRAIN = false, SEG = false;
    bf16_t* O; const float* rstd;
    __device__ __forceinline__ void operator()(const f32x4 (&acc)[2][2][4][2], const pg8::Unit& u, int wr, int wc, int fr, int fq) const {
        const int row0 = u.pm * 256 + wr * 64 + fr, col0 = u.pn * 256 + wc * 32 + 4 * fq;
#pragma unroll
        for (int ai = 0; ai < 2; ++ai)
#pragma unroll
            for (int m = 0; m < 4; ++m) { const int row = row0 + ai * 128 + m * 16; const float rs = rstd[row]; bf16_t* rowp = O + (size_t)row * LDP + col0;
#pragma unroll
                for (int bj = 0; bj < 2; ++bj)
#pragma unroll
                    for (int n = 0; n < 2; ++n) { const f32x4 v = acc[ai][bj][m][n] * rs; uint2 w; w.x = pk2(v[0], v[1]); w.y = pk2(v[2], v[3]); *(uint2*)(rowp + bj * 128 + n * 16) = w; } }
    }
};
struct EpiOut {
    static constexpr bool PERM = false, AFTER_DRAIN = false, SEG = false;
    bf16_t* O;
    __device__ __forceinline__ void operator()(const f32x4 (&acc)[2][2][4][2], const pg8::Unit& u, int wr, int wc, int fr, int fq) const {
        const int row0 = u.pm * 256 + wr * 64 + fr, col0 = u.pn * 256 + wc * 32 + 4 * fq;
#pragma unroll
        for (int ai = 0; ai < 2; ++ai)
#pragma unroll
            for (int m = 0; m < 4; ++m) { const int row = row0 + ai * 128 + m * 16; bf16_t* rowp = O + (size_t)row * LDP + C_O + col0;
#pragma unroll
                for (int bj = 0; bj < 2; ++bj)
#pragma unroll
                    for (int n = 0; n < 2; ++n) { const f32x4 v = acc[ai][bj][m][n]; uint2 w; w.x = pk2(v[0], v[1]); w.y = pk2(v[2], v[3]); *(uint2*)(rowp + bj * 128 + n * 16) = w; } }
    }
};
struct EpiOutSeg {
    static constexpr bool PERM = false, AFTER_DRAIN = false, SEG = true;
    bf16_t* O;
    __device__ __forceinline__ bool boundary(int t) const { return t == 8 || t == 16 || t == 18 || t == 20 || t == 22 || t == 24; }
    __device__ __forceinline__ void rescale(f32x4 (&acc)[2][2][4][2], int t, int ui, int wr, int fr, PG8_LAS unsigned char* lds) const {
        const int b = (t == 8) ? 0 : (t == 16) ? 1 : ((t - 14) >> 1);
        const PG8_LAS float* rt = (const PG8_LAS float*)(lds + 131072) + ((ui & 1) * 7 + b) * 256 + wr * 64 + fr;
#pragma unroll
        for (int ai = 0; ai < 2; ++ai)
#pragma unroll
            for (int m = 0; m < 4; ++m) { const float r = rt[ai * 128 + m * 16];
#pragma unroll
                for (int bj = 0; bj < 2; ++bj)
#pragma unroll
                    for (int n = 0; n < 2; ++n) acc[ai][bj][m][n] *= r; }
    }
    __device__ __forceinline__ void fin(const f32x4 (&acc)[2][2][4][2], const pg8::Unit& u, int wr, int wc, int fr, int fq, int ui, PG8_LAS unsigned char* lds) const {
        const PG8_LAS float* rt = (const PG8_LAS float*)(lds + 131072) + ((ui & 1) * 7 + 6) * 256 + wr * 64 + fr;
        const int row0 = u.pm * 256 + wr * 64 + fr, col0 = u.pn * 256 + wc * 32 + 4 * fq;
#pragma unroll
        for (int ai = 0; ai < 2; ++ai)
#pragma unroll
            for (int m = 0; m < 4; ++m) { const int row = row0 + ai * 128 + m * 16; const float r = rt[ai * 128 + m * 16]; bf16_t* rowp = O + (size_t)row * LDP + C_O + col0;
#pragma unroll
                for (int bj = 0; bj < 2; ++bj)
#pragma unroll
                    for (int n = 0; n < 2; ++n) { const f32x4 v = acc[ai][bj][m][n] * r; uint2 w; w.x = pk2(v[0], v[1]); w.y = pk2(v[2], v[3]); *(uint2*)(rowp + bj * 128 + n * 16) = w; } }
    }
    __device__ __forceinline__ void operator()(const f32x4 (&acc)[2][2][4][2], const pg8::Unit& u, int wr, int wc, int fr, int fq) const {}
};
struct EpiGlu {
    static constexpr bool PERM = false, AFTER_DRAIN = false, SEG = false;
    bf16_t* P; const float* bias; float* ss;
    __device__ __forceinline__ void operator()(const f32x4 (&acc)[2][2][4][2], const pg8::Unit& u, int wr, int wc, int fr, int fq) const {
        const int row0 = u.pm * 256 + wr * 64 + fr, c0 = u.pn * 128 + wc * 32 + 4 * fq;
        f32x4 bv[2], bg[2];
#pragma unroll
        for (int n = 0; n < 2; ++n) { bv[n] = *(const f32x4*)(bias + c0 + n * 16); bg[n] = *(const f32x4*)(bias + 512 + c0 + n * 16); }
#pragma unroll
        for (int ai = 0; ai < 2; ++ai)
#pragma unroll
            for (int m = 0; m < 4; ++m) { const int row = row0 + ai * 128 + m * 16; bf16_t* rowp = P + (size_t)row * LDP + C_SG + c0; float sq = 0.f;
#pragma unroll
                for (int n = 0; n < 2; ++n) { const f32x4 val = acc[ai][0][m][n] + bv[n], gt = acc[ai][1][m][n] + bg[n]; const uint2 gw = *(const uint2*)(rowp + n * 16);
                    float g[4] = {bflo(gw.x), bfhi(gw.x), bflo(gw.y), bfhi(gw.y)}; float y[4];
#pragma unroll
                    for (int j = 0; j < 4; ++j) { y[j] = val[j] * sigmoidf_(gt[j]) * siluf_(g[j]); sq += y[j] * y[j]; }
                    uint2 w; w.x = pk2(y[0], y[1]); w.y = pk2(y[2], y[3]); *(uint2*)(rowp + n * 16) = w; }
                sq += __shfl_xor(sq, 16); sq += __shfl_xor(sq, 32);
                if (fq == 0) ss[(size_t)row * 16 + u.pn * 4 + wc] = sq; }
    }
};

__device__ __forceinline__ int src_col(int n) {
    if (n < 1024) return n; if (n < 1536) return 4112 + (n - 1024); if (n < 2048) return 5136 + (n - 1536); if (n < 3584) return 1024 + (n - 2048);
    if (n < 4096) return 2576 + (n - 3584); if (n < 4608) return 3088 + (n - 4096); if (n < 5120) return 3600 + (n - 4608); return 4624 + (n - 5120);
}
template <int NSUB>
__device__ __forceinline__ void tr_tile(const float* src, int lds_, int col0, int k0, const float* sc, bf16_t* dst, int ldd, int row0, float* tile) {
    const int tid = lt_tid();
    constexpr int W = 64 * NSUB, STR = W + 1;
#pragma unroll
    for (int i = 0; i < 2 * NSUB; ++i) { const int idx = tid + i * 512, k = idx / (W / 4), n4 = idx % (W / 4);
        float4 v = *(const float4*)(src + (size_t)(k0 + k) * lds_ + col0 + n4 * 4); if (sc) { const float f = sc[k0 + k]; v.x *= f; v.y *= f; v.z *= f; v.w *= f; }
        float* tp = tile + k * STR + n4 * 4; tp[0] = v.x; tp[1] = v.y; tp[2] = v.z; tp[3] = v.w; }
    __syncthreads();
#pragma unroll
    for (int i = 0; i < NSUB; ++i) { const int idx = tid + i * 512, n = idx % W, kg = idx / W; const float* tp = tile + (kg * 8) * STR + n;
        uint4 w; w.x = pk2(tp[0], tp[STR]); w.y = pk2(tp[2 * STR], tp[3 * STR]); w.z = pk2(tp[4 * STR], tp[5 * STR]); w.w = pk2(tp[6 * STR], tp[7 * STR]);
        *(uint4*)(dst + (size_t)(row0 + n) * ldd + k0 + kg * 8) = w; }
    __syncthreads();
}

__device__ void s5_tables(CPAR p, int l, int g, int part, unsigned char* shm) {
    float* apre = (float*)shm;
    float* apim = apre + 33 * 64;
    float* bbre = apim + 33 * 64;
    float* bbim = bbre + 1024;
    float* core = bbim + 1024;
    float* coim = core + 64;
    float* cres = coim + 64;
    float* cims = cres + 1024;
    const int tid = lt_tid();
    if (tid < 64) {
        const int pp = tid; const int gi = (l * 32 + g) * 64 + pp;
        const double lr = fmin((double)p.lam_re[gi], -1e-4), li = (double)p.lam_im[gi], st = (double)expf(p.log_step[l * 32 + g]);
        const double xe = lr * st; double mag = 1.0, term = 1.0;
        for (int q = 1; q <= 12; ++q) { term *= xe / (double)q; mag += term; }
        double ang = li * st; ang -= 6.283185307179586476925 * rint(ang / 6.283185307179586476925);
        const double are = mag * (double)cosf((float)ang), aim = mag * (double)sinf((float)ang);
        double pr = 1.0, pi = 0.0;
        for (int j = 0; j <= 32; ++j) { apre[j * 64 + pp] = (float)pr; apim[j * 64 + pp] = (float)pi; const double nr = pr * are - pi * aim, ni = pr * aim + pi * are; pr = nr; pi = ni; }
        const double den = lr * lr + li * li, nre = are - 1.0, nim = aim;
        core[pp] = (float)((nre * lr + nim * li) / den); coim[pp] = (float)((nim * lr - nre * li) / den);
        if (part == 0) { float* aT = p.aT + (l & 1) * 32 * 64 * 2; aT[(g * 64 + pp) * 2 + 0] = apre[32 * 64 + pp]; aT[(g * 64 + pp) * 2 + 1] = apim[32 * 64 + pp]; }
    }
    __syncthreads();
    for (int i = tid; i < 1024; i += 512) { const int pp = i >> 4; const size_t gi = ((size_t)(l * 32 + g) * 64) * 16 + i;
        const float br = p.b_re[gi], bi = p.b_im[gi]; bbre[i] = core[pp] * br - coim[pp] * bi; bbim[i] = core[pp] * bi + coim[pp] * br; }
    __syncthreads();
    for (int i = tid; i < 1024; i += 512) { cres[i] = p.c_re[(size_t)(l * 32 + g) * 1024 + i]; cims[i] = p.c_im[(size_t)(l * 32 + g) * 1024 + i]; }
    __syncthreads();
    const float* cre = cres;
    const float* cim = cims;
    bf16_t* kt = p.ktab + (size_t)(l & 1) * 32 * 8192 + (size_t)g * 8192;
    for (int e = part * 1024 + tid; e < part * 1024 + 1024; e += 512) { const int lag = e >> 8, h = (e >> 4) & 15, h2 = e & 15; float s = 0.f;
        for (int pp = 0; pp < 64; ++pp) { const float cr = cre[h * 64 + pp], ci = cim[h * 64 + pp], ar = apre[lag * 64 + pp], ai = apim[lag * 64 + pp];
            const float car = cr * ar - ci * ai, cai = cr * ai + ci * ar; s += car * bbre[pp * 16 + h2] - cai * bbim[pp * 16 + h2]; }
        kt[e] = (bf16_t)f2bf(s); }
    bf16_t* wo = p.woff + (size_t)(l & 1) * 32 * 65536 + (size_t)g * 65536;
    for (int e = part * 8192 + tid; e < part * 8192 + 8192; e += 512) { const int row = e >> 7, k = e & 127, t = row >> 4, h = row & 15, pp = k & 63;
        const float cr = cre[h * 64 + pp], ci = cim[h * 64 + pp], ar = apre[(t + 1) * 64 + pp], ai = apim[(t + 1) * 64 + pp];
        const float v = (k < 64) ? (cr * ar - ci * ai) : -(cr * ai + ci * ar); wo[e] = (bf16_t)f2bf(v); }
    bf16_t* ws = p.wst + (size_t)(l & 1) * 32 * 65536 + (size_t)g * 65536;
    for (int e = part * 8192 + tid; e < part * 8192 + 8192; e += 512) { const int m = e >> 9, k = e & 511, s = k >> 4, h2 = k & 15, pp = m & 63;
        const float ar = apre[(31 - s) * 64 + pp], ai = apim[(31 - s) * 64 + pp], br = bbre[pp * 16 + h2], bi = bbim[pp * 16 + h2];
        const float v = (m < 64) ? (ar * br - ai * bi) : (ar * bi + ai * br); ws[e] = (bf16_t)f2bf(v); }
    __syncthreads();
}

__device__ __forceinline__ void convert_weights(CPAR p, int l, int part, int nparts, unsigned char* shm) {
    float* tile = (float*)shm; const int par = l & 1;
    bf16_t* winT = p.winT + (size_t)par * LDP * DM; bf16_t* woutT = p.woutT + (size_t)par * 1024 * 2048; bf16_t* wgluT = p.wgluT + (size_t)par * 1024 * 512;
    for (int t = part; t < 544; t += nparts) {
        if (t < 352) { const int nt = t >> 4, kt = t & 15; tr_tile<4>(p.w_in + (size_t)l * DM * INC, INC, src_col(nt * 256), kt * 64, p.pre_w + l * DM, winT, DM, nt * 256, tile); }
        else if (t < 480) { const int u = t - 352, nt = u >> 5, kt = u & 31, k0 = kt * 64;
            const float* sc = (k0 < 1024) ? (p.ssd_nw + l * 1024) : (k0 < 1536) ? (p.hg_nw + l * 512 - 1024) : (p.s5_nw + l * 512 - 1536);
            tr_tile<4>(p.w_out + (size_t)l * 2048 * DM, DM, nt * 256, k0, sc, woutT, 2048, nt * 256, tile); }
        else { const int u = t - 480, nt = u >> 3, kt = u & 7, row0 = nt * 128, pn = row0 >> 8, half = (row0 >> 7) & 1;
            tr_tile<2>(p.glu_w + (size_t)l * 512 * 1024, 1024, half * 512 + pn * 128, kt * 64, nullptr, wgluT, 512, row0, tile); }
    }
    for (int u = part; u < 256; u += nparts) s5_tables(p, l, u >> 3, u & 7, shm);
}

__device__ void phase_prep(CPAR p, int l, unsigned char* shm) {
    const int tid = lt_tid(), lane = tid & 63, wv = tid >> 6;
    const int G = gridDim.x, bid = lt_bid();
    if (l == 0) {
        convert_weights(p, 0, bid, G, shm);
        if (bid == G - 1) {
            const float a0 = p.hg_lb[tid], a1 = p.hg_lb[512 + tid], a2 = p.hg_lb[1024 + tid], a3 = p.hg_lb[1536 + tid];
            const float mx = fmaxf(fmaxf(a0, a1), fmaxf(a2, a3)); const float e0 = expf(a0 - mx), e1 = expf(a1 - mx), e2 = expf(a2 - mx), e3 = expf(a3 - mx), inv = 1.f / (e0 + e1 + e2 + e3);
            p.lb[tid] = 0.f; p.lb[512 + tid] = e1 * inv; p.lb[1024 + tid] = (e1 + e2) * inv; p.lb[1536 + tid] = (e1 + e2 + e3) * inv;
        }
    }
    __syncthreads();
    float* wdt_s = (float*)(shm + 32768);
    if (l < 4) { for (int e = tid; e < 16384; e += 512) { const int k = e >> 4, j = e & 15; wdt_s[j * 1024 + k] = p.w_in[(size_t)l * DM * INC + (size_t)k * INC + 2560 + j] * p.pre_w[l * DM + k]; } }
    __syncthreads();
    float pw[16];
#pragma unroll
    for (int i = 0; i < 4; ++i) { const float4 w = (l > 0) ? *(const float4*)(p.post_w + (l - 1) * DM + i * 256 + lane * 4) : make_float4(0.f, 0.f, 0.f, 0.f); pw[4 * i] = w.x; pw[4 * i + 1] = w.y; pw[4 * i + 2] = w.z; pw[4 * i + 3] = w.w; }
    const int rstep = G * 8; int row = bid * 8 + wv;
    float4 xn[4]; uint2 xq[4], on[4];
#pragma unroll
    for (int i = 0; i < 4; ++i) { xn[i] = make_float4(0.f, 0.f, 0.f, 0.f); xq[i] = make_uint2(0u, 0u); on[i] = make_uint2(0u, 0u); }
    if (row < NTOK) {
        if (l == 0) {
#pragma unroll
            for (int i = 0; i < 4; ++i) xn[i] = *(const float4*)(p.x + (size_t)row * DM + i * 256 + lane * 4);
        } else {
#pragma unroll
            for (int i = 0; i < 4; ++i) { xq[i] = *(const uint2*)(p.xb + (size_t)row * DM + i * 256 + lane * 4); on[i] = *(const uint2*)(p.proj + (size_t)row * LDP + C_O + i * 256 + lane * 4); }
        }
    }
    for (; row < NTOK; row += rstep) {
        float xv[16]; uint2 oc[4];
        if (l == 0) {
#pragma unroll
            for (int i = 0; i < 4; ++i) { xv[4 * i] = xn[i].x; xv[4 * i + 1] = xn[i].y; xv[4 * i + 2] = xn[i].z; xv[4 * i + 3] = xn[i].w; oc[i] = make_uint2(0u, 0u); }
        } else {
#pragma unroll
            for (int i = 0; i < 4; ++i) { xv[4 * i] = bflo(xq[i].x); xv[4 * i + 1] = bfhi(xq[i].x); xv[4 * i + 2] = bflo(xq[i].y); xv[4 * i + 3] = bfhi(xq[i].y); oc[i] = on[i]; }
        }
        if (row + rstep < NTOK) {
            if (l == 0) {
#pragma unroll
                for (int i = 0; i < 4; ++i) xn[i] = *(const float4*)(p.x + (size_t)(row + rstep) * DM + i * 256 + lane * 4);
            } else {
#pragma unroll
                for (int i = 0; i < 4; ++i) { xq[i] = *(const uint2*)(p.xb + (size_t)(row + rstep) * DM + i * 256 + lane * 4); on[i] = *(const uint2*)(p.proj + (size_t)(row + rstep) * LDP + C_O + i * 256 + lane * 4); }
            }
        }
        if (l > 0) {
            float ov[16]; float ss = 0.f;
#pragma unroll
            for (int i = 0; i < 4; ++i) { ov[4 * i] = bflo(oc[i].x); ov[4 * i + 1] = bfhi(oc[i].x); ov[4 * i + 2] = bflo(oc[i].y); ov[4 * i + 3] = bfhi(oc[i].y); }
#pragma unroll
            for (int i = 0; i < 16; ++i) ss += ov[i] * ov[i];
            ss = wave_sum(ss); const float rs = rsqrtf(ss * (1.f / 1024.f) + EPSN);
#pragma unroll
            for (int i = 0; i < 16; ++i) xv[i] += ov[i] * rs * pw[i];
            if (l == 4) {
#pragma unroll
                for (int i = 0; i < 4; ++i) *(float4*)(p.out + (size_t)row * DM + i * 256 + lane * 4) = make_float4(xv[4 * i], xv[4 * i + 1], xv[4 * i + 2], xv[4 * i + 3]);
            }
        }
        if (l < 4) {
            float ss = 0.f;
#pragma unroll
            for (int i = 0; i < 16; ++i) ss += xv[i] * xv[i];
            ss = wave_sum(ss); const float rs = rsqrtf(ss * (1.f / 1024.f) + EPSN);
            if (lane == 0) p.rstd[row] = rs;
#pragma unroll
            for (int i = 0; i < 4; ++i) { uint2 w; w.x = pk2(xv[4 * i], xv[4 * i + 1]); w.y = pk2(xv[4 * i + 2], xv[4 * i + 3]); *(uint2*)(p.xb + (size_t)row * DM + i * 256 + lane * 4) = w; }
            float d[16];
#pragma unroll
            for (int j = 0; j < 16; ++j) { float a = 0.f;
#pragma unroll
                for (int i = 0; i < 4; ++i) { const float4 w = *(const float4*)(wdt_s + j * 1024 + i * 256 + lane * 4); a += xv[4 * i] * w.x + xv[4 * i + 1] * w.y + xv[4 * i + 2] * w.z + xv[4 * i + 3] * w.w; }
                d[j] = a; }
            float e8[8], e4[4], e2[2];
#pragma unroll
            for (int j = 0; j < 8; ++j) { const bool hi = lane & 32; const float mine = hi ? d[j + 8] : d[j], send = hi ? d[j] : d[j + 8]; e8[j] = mine + __shfl_xor(send, 32); }
#pragma unroll
            for (int j = 0; j < 4; ++j) { const bool hi = lane & 16; const float mine = hi ? e8[j + 4] : e8[j], send = hi ? e8[j] : e8[j + 4]; e4[j] = mine + __shfl_xor(send, 16); }
#pragma unroll
            for (int j = 0; j < 2; ++j) { const bool hi = lane & 8; const float mine = hi ? e4[j + 2] : e4[j], send = hi ? e4[j] : e4[j + 2]; e2[j] = mine + __shfl_xor(send, 8); }
            float e1; { const bool hi = lane & 4; const float mine = hi ? e2[1] : e2[0], send = hi ? e2[0] : e2[1]; e1 = mine + __shfl_xor(send, 4); }
            e1 += __shfl_xor(e1, 2); e1 += __shfl_xor(e1, 1);
            if ((lane & 3) == 0) { const int j = ((lane >> 5) & 1) * 8 + ((lane >> 4) & 1) * 4 + ((lane >> 3) & 1) * 2 + ((lane >> 2) & 1); p.dtraw[(size_t)row * 16 + j] = e1 * rs; }
        }
    }
}

#ifndef PH
#define PH 63
#endif
#ifndef TPROBE
#define TPROBE -1
#endif
#if TPROBE >= 0
#ifndef TBLK
#define TBLK 0
#endif
#define TSTAMP(k) do { if (blockIdx.x == TBLK && threadIdx.x == 0) { CPAR _p = *GETP(); unsigned long long* _w = (unsigned long long*)_p.wdt; const unsigned long long _t = wall_clock64(); if ((k) == TPROBE) _w[1] += (_t - _w[0]); _w[0] = _t; } } while (0)
#else
#define TSTAMP(k) do { } while (0)
#endif
#define BAR_LDS() do { asm volatile("s_waitcnt lgkmcnt(0)" ::: "memory"); __builtin_amdgcn_s_barrier(); asm volatile("" ::: "memory"); } while (0)
#define MFMA16(a, b, c) __builtin_amdgcn_mfma_f32_16x16x32_bf16(a, b, c, 0, 0, 0)

__device__ void bcconv_unit(CPAR p, int l, int u) {
    const int tid = lt_tid();
    const int bg = u >> 3, tr = u & 7, b = bg >> 1, g = bg & 1;
    bf16_t* Bn = p.bcb; bf16_t* Cn = Bn + (size_t)32 * 2048 * 128; bf16_t* BT = Cn + (size_t)32 * 2048 * 128;
    const int cp = tid & 63, kind = (tid >> 6) & 1, tgl = tid >> 7;
    const int ch = (kind ? 1280 : 1024) + g * 128 + cp * 2;
    const float* cw = p.conv_w + (size_t)l * 4 * 1536 + ch; const float* cb = p.conv_b + l * 1536 + ch;
    const float w00 = cw[0], w01 = cw[1536], w02 = cw[3072], w03 = cw[4608], w10 = cw[1], w11 = cw[1537], w12 = cw[3073], w13 = cw[4609], b0 = cb[0], b1 = cb[1];
    unsigned raw[2][11];
    { const int t = tr * 256 + tgl * 8; const bf16_t* src = p.proj + ((size_t)b * SEQL + t) * LDP + C_XBC + ch;
#pragma unroll
      for (int j = 0; j < 11; ++j) { unsigned w = 0u; if (t + j - 3 >= 0) w = *(const unsigned*)(src + (ptrdiff_t)(j - 3) * LDP); raw[0][j] = w; } }
#pragma unroll
    for (int it = 0; it < 8; ++it) {
        const int t = tr * 256 + (it * 4 + tgl) * 8;
        if (it < 7) { const int tn = t + 32; const bf16_t* srcn = p.proj + ((size_t)b * SEQL + tn) * LDP + C_XBC + ch;
#pragma unroll
            for (int j = 0; j < 11; ++j) raw[(it + 1) & 1][j] = *(const unsigned*)(srcn + (ptrdiff_t)(j - 3) * LDP); }
        float r0[11], r1[11];
#pragma unroll
        for (int j = 0; j < 11; ++j) { r0[j] = bflo(raw[it & 1][j]); r1[j] = bfhi(raw[it & 1][j]); }
        float o0[8], o1[8];
#pragma unroll
        for (int j = 0; j < 8; ++j) { o0[j] = siluf_(b0 + w00 * r0[j] + w01 * r0[j + 1] + w02 * r0[j + 2] + w03 * r0[j + 3]); o1[j] = siluf_(b1 + w10 * r1[j] + w11 * r1[j + 1] + w12 * r1[j + 2] + w13 * r1[j + 3]); }
        bf16_t* dstn = (kind ? Cn : Bn) + ((size_t)bg * 2048 + t) * 128 + cp * 2;
#pragma unroll
        for (int j = 0; j < 8; ++j) *(unsigned*)(dstn + j * 128) = pk2(o0[j], o1[j]);
        if (!kind) { uint4 q0, q1; q0.x = pk2(o0[0], o0[1]); q0.y = pk2(o0[2], o0[3]); q0.z = pk2(o0[4], o0[5]); q0.w = pk2(o0[6], o0[7]);
            q1.x = pk2(o1[0], o1[1]); q1.y = pk2(o1[2], o1[3]); q1.z = pk2(o1[4], o1[5]); q1.w = pk2(o1[6], o1[7]);
            *(uint4*)(BT + ((size_t)bg * 128 + cp * 2) * 2048 + t) = q0; *(uint4*)(BT + ((size_t)bg * 128 + cp * 2 + 1) * 2048 + t) = q1; }
    }
}

__device__ void ssd_unit(CPAR p, int l, int b, int hd, unsigned char* shm) {
    const int tid = lt_tid(), lane = tid & 63, wv = __builtin_amdgcn_readfirstlane(tid >> 6), quad = lane >> 4, l15 = lane & 15;
    constexpr int OSET = 64 * 136 * 2 + 128 * 72 + 64 * 72;
    bf16_t* OB = (bf16_t*)shm;
    bf16_t* Ls = OB + 2 * OSET;
    bf16_t* Ss = Ls + 64 * 72;
    bf16_t* Yw = Ss + 64 * 136;
    float* dtb = (float*)(Yw + 64 * 72);
    const int g = hd >> 3, bg = b * 2 + g;
    const float a = -expf(p.a_log[l * 16 + hd]), dbias = p.dt_bias[l * 16 + hd], dsk = p.ssd_d[l * 16 + hd];
    for (int i = tid; i < 64 * 136 / 2; i += 512) ((unsigned*)Ss)[i] = 0u;
    const size_t row_base = (size_t)b * SEQL;
    const bf16_t* Bn = p.bcb + (size_t)bg * 2048 * 128; const bf16_t* Cn = Bn + (size_t)32 * 2048 * 128; const bf16_t* BT = p.bcb + (size_t)2 * 32 * 2048 * 128 + (size_t)bg * 128 * 2048;
#define SSD_SCAN(DST) do { float* _d = (DST); const float v = dtr + dbias; const float dt = v > 20.f ? v : __logf(1.f + __expf(v)); float da = dt * a; \
        _Pragma("unroll") for (int o = 1; o < 64; o <<= 1) { const float n = __shfl_up(da, o); if (lane >= o) da += n; } \
        const float al = __shfl(da, 63); _d[lane] = dt; _d[64 + lane] = da; _d[128 + lane] = dt * __expf(al - da); _d[192 + lane] = __expf(da); } while (0)
    if (wv < 4) {
        const int st = tid;
        const int xcp = st & 31, xtg = st >> 5, xch = hd * 64 + xcp * 2;
        const float* cw = p.conv_w + (size_t)l * 4 * 1536 + xch; const float* cb = p.conv_b + l * 1536 + xch;
        const float w00 = cw[0], w01 = cw[1536], w02 = cw[3072], w03 = cw[4608], w10 = cw[1], w11 = cw[1537], w12 = cw[3073], w13 = cw[4609], b0 = cb[0], b1 = cb[1];
        const bf16_t* xsrc = p.proj + (row_base + xtg * 8) * LDP + C_XBC + xch;
        uint4 pb0, pb1, pb2, pb3, pc0, pc1, pc2, pc3, pt0, pt1, pt2, pt3; unsigned xr[11]; float dtr = 0.f;
#define SSD_LD1(I, PB, PC, T0) do { const int q = st + (I) * 256; PB = *(const uint4*)(Bn + (size_t)(T0) * 128 + q * 8); PC = *(const uint4*)(Cn + (size_t)(T0) * 128 + q * 8); } while (0)
#define SSD_LDT(I, PT, T0) do { const int q = st + (I) * 256; PT = *(const uint4*)(BT + (size_t)(q >> 3) * 2048 + (T0) + (q & 7) * 8); } while (0)
#define SSD_LOAD_T(T0) do { SSD_LDT(0, pt0, T0); SSD_LDT(1, pt1, T0); SSD_LDT(2, pt2, T0); SSD_LDT(3, pt3, T0); } while (0)
#define SSD_LOAD(T0) do { SSD_LD1(0, pb0, pc0, T0); SSD_LD1(1, pb1, pc1, T0); SSD_LD1(2, pb2, pc2, T0); SSD_LD1(3, pb3, pc3, T0); \
            xr[0] = ((T0) + xtg * 8 - 3 >= 0) ? *(const unsigned*)(xsrc + ((ptrdiff_t)(T0) - 3) * LDP) : 0u; \
            xr[1] = ((T0) + xtg * 8 - 2 >= 0) ? *(const unsigned*)(xsrc + ((ptrdiff_t)(T0) - 2) * LDP) : 0u; \
            xr[2] = ((T0) + xtg * 8 - 1 >= 0) ? *(const unsigned*)(xsrc + ((ptrdiff_t)(T0) - 1) * LDP) : 0u; \
            xr[3] = *(const unsigned*)(xsrc + ((ptrdiff_t)(T0) + 0) * LDP); xr[4] = *(const unsigned*)(xsrc + ((ptrdiff_t)(T0) + 1) * LDP); \
            xr[5] = *(const unsigned*)(xsrc + ((ptrdiff_t)(T0) + 2) * LDP); xr[6] = *(const unsigned*)(xsrc + ((ptrdiff_t)(T0) + 3) * LDP); \
            xr[7] = *(const unsigned*)(xsrc + ((ptrdiff_t)(T0) + 4) * LDP); xr[8] = *(const unsigned*)(xsrc + ((ptrdiff_t)(T0) + 5) * LDP); \
            xr[9] = *(const unsigned*)(xsrc + ((ptrdiff_t)(T0) + 6) * LDP); xr[10] = *(const unsigned*)(xsrc + ((ptrdiff_t)(T0) + 7) * LDP); \
            if (wv == 0) dtr = p.dtraw[(row_base + (T0) + lane) * 16 + hd]; } while (0)
#define SSD_CB1(I, PB, PC, SET) do { const int q = st + (I) * 256; const int row = q >> 4, c16 = q & 15; *(uint4*)((SET) + row * 136 + c16 * 8) = PC; *(uint4*)((SET) + 64 * 136 + row * 136 + c16 * 8) = PB; } while (0)
#define SSD_PART1(SET) do { bf16_t* _s = (SET); SSD_CB1(0, pb0, pc0, _s); SSD_CB1(1, pb1, pc1, _s); SSD_CB1(2, pb2, pc2, _s); SSD_CB1(3, pb3, pc3, _s); \
            float o0[8], o1[8]; \
            _Pragma("unroll") for (int j = 0; j < 8; ++j) { o0[j] = siluf_(b0 + w00 * bflo(xr[j]) + w01 * bflo(xr[j + 1]) + w02 * bflo(xr[j + 2]) + w03 * bflo(xr[j + 3])); o1[j] = siluf_(b1 + w10 * bfhi(xr[j]) + w11 * bfhi(xr[j + 1]) + w12 * bfhi(xr[j + 2]) + w13 * bfhi(xr[j + 3])); } \
            uint4 q0, q1; q0.x = pk2(o0[0], o0[1]); q0.y = pk2(o0[2], o0[3]); q0.z = pk2(o0[4], o0[5]); q0.w = pk2(o0[6], o0[7]); \
            q1.x = pk2(o1[0], o1[1]); q1.y = pk2(o1[2], o1[3]); q1.z = pk2(o1[4], o1[5]); q1.w = pk2(o1[6], o1[7]); \
            bf16_t* _xt = _s + 2 * 64 * 136 + 128 * 72; *(uint4*)(_xt + (xcp * 2) * 72 + xtg * 8) = q0; *(uint4*)(_xt + (xcp * 2 + 1) * 72 + xtg * 8) = q1; } while (0)
#define SSD_BT1(I, PT, SET, SCV) do { const int q = st + (I) * 256; const int n = q >> 3, tg = q & 7; const float* sv = (SCV) + tg * 8; uint4 r; \
            r.x = pk2(bflo(PT.x) * sv[0], bfhi(PT.x) * sv[1]); r.y = pk2(bflo(PT.y) * sv[2], bfhi(PT.y) * sv[3]); r.z = pk2(bflo(PT.z) * sv[4], bfhi(PT.z) * sv[5]); r.w = pk2(bflo(PT.w) * sv[6], bfhi(PT.w) * sv[7]); \
            *(uint4*)((SET) + 2 * 64 * 136 + n * 72 + tg * 8) = r; } while (0)
#define SSD_PART2(SET, SCV) do { bf16_t* _s = (SET); const float* _v = (SCV); SSD_BT1(0, pt0, _s, _v); SSD_BT1(1, pt1, _s, _v); SSD_BT1(2, pt2, _s, _v); SSD_BT1(3, pt3, _s, _v); } while (0)
        SSD_LOAD(0); SSD_LOAD_T(0);
        if (wv == 0) SSD_SCAN(dtb);
        SSD_PART1(OB);
        SSD_LOAD(64);
        BAR_LDS();
        SSD_PART2(OB, dtb + 128);
        SSD_LOAD_T(64);
        BAR_LDS();
        for (int c = 0; c < 32; ++c) {
            bf16_t* nset = OB + ((c + 1) & 1) * OSET; float* ndt = dtb + ((c + 1) & 1) * 256;
            if (c < 31) { if (wv == 0) SSD_SCAN(ndt); SSD_PART1(nset); if (c < 30) SSD_LOAD((c + 2) * 64); }
            BAR_LDS();
            if (c < 31) { SSD_PART2(nset, ndt + 128); if (c < 30) SSD_LOAD_T((c + 2) * 64); }
            BAR_LDS();
        }
#undef SSD_LD1
#undef SSD_LDT
#undef SSD_LOAD_T
#undef SSD_LOAD
#undef SSD_CB1
#undef SSD_PART1
#undef SSD_BT1
#undef SSD_PART2
    } else {
        const int mt = wv - 4;
        f32x4 accS[8];
#pragma unroll
        for (int i = 0; i < 8; ++i) accS[i] = (f32x4){0.f, 0.f, 0.f, 0.f};
        const int orow = mt * 16 + (lane >> 2), ocol = (lane & 3) * 16;
        bf16_t* zbase = p.proj + (row_base + orow) * LDP + C_Z + hd * 64 + ocol;
        uint4 zc0, zc1;
        BAR_LDS();
        zc0 = *(const uint4*)zbase; zc1 = *(const uint4*)(zbase + 8);
        BAR_LDS();
        for (int c = 0; c < 32; ++c) {
            const int t0 = c * 64;
            const bf16_t* Cs = OB + (c & 1) * OSET; const bf16_t* Bs = Cs + 64 * 136; const bf16_t* BscT = Bs + 64 * 136; const bf16_t* XT = BscT + 128 * 72;
            const float* dtv = dtb + (c & 1) * 256; const float* acum = dtv + 64; const float* eav = dtv + 192;
            f32x4 accY[4], accT[4];
#pragma unroll
            for (int i = 0; i < 4; ++i) { accY[i] = (f32x4){0.f, 0.f, 0.f, 0.f}; accT[i] = (f32x4){0.f, 0.f, 0.f, 0.f}; }
            { const bf16_t* ap = Cs + (mt * 16 + l15) * 136 + quad * 8; const bf16_t* bp = Bs + l15 * 136 + quad * 8; const bf16_t* sp = Ss + l15 * 136 + quad * 8;
              bf16x8 fa[2], fb[2][4], fs[2][4];
              fa[0] = *(const bf16x8*)ap;
#pragma unroll
              for (int nt = 0; nt < 4; ++nt) { fb[0][nt] = *(const bf16x8*)(bp + nt * 16 * 136); fs[0][nt] = *(const bf16x8*)(sp + nt * 16 * 136); }
#pragma unroll
              for (int ks = 0; ks < 4; ++ks) { const int cur = ks & 1, nxt = cur ^ 1;
                  if (ks < 3) { fa[nxt] = *(const bf16x8*)(ap + (ks + 1) * 32);
#pragma unroll
                      for (int nt = 0; nt < 4; ++nt) { fb[nxt][nt] = *(const bf16x8*)(bp + nt * 16 * 136 + (ks + 1) * 32); fs[nxt][nt] = *(const bf16x8*)(sp + nt * 16 * 136 + (ks + 1) * 32); } }
                  __builtin_amdgcn_sched_barrier(0);
#pragma unroll
                  for (int nt = 0; nt < 4; ++nt) { accT[nt] = MFMA16(fa[cur], fb[cur][nt], accT[nt]); accY[nt] = MFMA16(fa[cur], fs[cur][nt], accY[nt]); }
                  __builtin_amdgcn_sched_barrier(0); } }
#pragma unroll
            for (int nt = 0; nt < 4; ++nt) { const int scol = nt * 16 + l15; const float as = acum[scol], ds = dtv[scol];
#pragma unroll
                for (int j = 0; j < 4; ++j) { const int lrow = mt * 16 + quad * 4 + j; const float v = (scol <= lrow) ? accT[nt][j] * __expf(acum[lrow] - as) * ds : 0.f; Ls[lrow * 72 + scol] = (bf16_t)f2bf(v); accY[nt][j] *= eav[lrow]; } }
            BAR_LDS();
            mma_lds_n<4, 64>(Ls + mt * 16 * 72, 72, XT, 72, 16 * 72, accY, lane);
#pragma unroll
            for (int nt = 0; nt < 4; ++nt) { const int pcol = nt * 16 + l15;
#pragma unroll
                for (int j = 0; j < 4; ++j) { const int lrow = mt * 16 + quad * 4 + j; Yw[lrow * 72 + pcol] = (bf16_t)f2bf(accY[nt][j] + dsk * bf2f(XT[pcol * 72 + lrow])); } }
            { const float cdec = __expf(acum[63]);
#pragma unroll
              for (int i = 0; i < 8; ++i) accS[i] *= cdec;
              mma_lds_n<8, 64>(XT + mt * 16 * 72, 72, BscT, 72, 16 * 72, accS, lane);
#pragma unroll
              for (int i = 0; i < 8; ++i)
#pragma unroll
                  for (int j = 0; j < 4; ++j) Ss[(mt * 16 + quad * 4 + j) * 136 + i * 16 + l15] = (bf16_t)f2bf(accS[i][j]); }
            { const uint4 y0 = *(const uint4*)(Yw + orow * 72 + ocol), y1 = *(const uint4*)(Yw + orow * 72 + ocol + 8); float sq = 0.f; uint4 r0, r1;
#define SSD_OUT(DST, YW, ZW) do { const float z0 = bflo(ZW), z1 = bfhi(ZW); const float v0 = bflo(YW) * z0 * __builtin_amdgcn_rcpf(1.f + __expf(-z0)), v1 = bfhi(YW) * z1 * __builtin_amdgcn_rcpf(1.f + __expf(-z1)); sq += v0 * v0 + v1 * v1; DST = pk2(v0, v1); } while (0)
              SSD_OUT(r0.x, y0.x, zc0.x); SSD_OUT(r0.y, y0.y, zc0.y); SSD_OUT(r0.z, y0.z, zc0.z); SSD_OUT(r0.w, y0.w, zc0.w);
              SSD_OUT(r1.x, y1.x, zc1.x); SSD_OUT(r1.y, y1.y, zc1.y); SSD_OUT(r1.z, y1.z, zc1.z); SSD_OUT(r1.w, y1.w, zc1.w);
#undef SSD_OUT
              sq += __shfl_xor(sq, 1); sq += __shfl_xor(sq, 2);
              if ((lane & 3) == 0) *(float2*)(p.ss_ssd + (row_base + t0 + orow) * 32 + hd * 2) = make_float2(sq, 0.f);
              bf16_t* zp = zbase + (size_t)t0 * LDP; *(uint4*)zp = r0; *(uint4*)(zp + 8) = r1;
              if (c < 31) { zc0 = *(const uint4*)(zp + (size_t)64 * LDP); zc1 = *(const uint4*)(zp + (size_t)64 * LDP + 8); } }
            BAR_LDS();
        }
    }
#undef SSD_SCAN
    __syncthreads();
}

__device__ void hgrn_unit(CPAR p, int l, int b, int head, int vh, unsigned char* shm) {
    const int tid = lt_tid(), lane = tid & 63, wv = tid >> 6, quad = lane >> 4, l15 = lane & 15;
    bf16_t* Qm = (bf16_t*)shm;
    bf16_t* Km = Qm + 64 * 136;
    bf16_t* Qs = Km + 64 * 136;
    bf16_t* KhT = Qs + 64 * 136;
    bf16_t* VT = KhT + 128 * 72;
    bf16_t* At = VT + 64 * 72;
    bf16_t* Ob = At + 64 * 72;
    bf16_t* ST = Ob + 64 * 72;
    float* dec = (float*)(ST + 64 * 136);
    float* seg = dec + 128;
    for (int i = tid; i < 64 * 136 / 2; i += 512) ((unsigned*)ST)[i] = 0u;
    f32x4 accS[4];
#pragma unroll
    for (int i = 0; i < 4; ++i) accS[i] = (f32x4){0.f, 0.f, 0.f, 0.f};
    const int kp = tid & 63, lq = tid >> 6, k0 = 2 * kp, vp = tid & 31, vl = tid >> 5, orow = (wv >> 1) * 16 + (lane >> 2), oc8 = (wv & 1) * 4 + (lane & 3);
    const float lb0 = p.lb[l * 512 + head * 128 + k0], lb1 = p.lb[l * 512 + head * 128 + k0 + 1], om0 = 1.f - lb0, om1 = 1.f - lb1;
    const size_t row_base = (size_t)b * SEQL;
    const bf16_t* qbase = p.proj + (row_base + lq * 8) * LDP + C_Q + head * 128 + k0;
    const bf16_t* vbase = p.proj + (row_base + vl * 4) * LDP + C_I + head * 128 + vh * 64 + 2 * vp;
    bf16_t* gbase = p.proj + (row_base + orow) * LDP + C_G + head * 128 + vh * 64 + oc8 * 8;
    unsigned qr[8], fr[8], vr[4]; uint4 gr;
#pragma unroll
    for (int i = 0; i < 8; ++i) { qr[i] = *(const unsigned*)(qbase + (size_t)i * LDP); fr[i] = *(const unsigned*)(qbase + (size_t)i * LDP + (C_F - C_Q)); }
#pragma unroll
    for (int i = 0; i < 4; ++i) vr[i] = *(const unsigned*)(vbase + (size_t)i * LDP);
    gr = *(const uint4*)gbase;
    for (int c = 0; c < 32; ++c) {
        const int t0 = c * 64;
        float qv0[8], qv1[8], P0[8], P1[8], kk0[8], kk1[8];
#pragma unroll
        for (int i = 0; i < 8; ++i) { const float q0 = bflo(qr[i]), q1 = bfhi(qr[i]), f0 = fmaxf(bflo(fr[i]), -80.f), f1 = fmaxf(bfhi(fr[i]), -80.f);
            const float fv0 = lb0 + om0 * __builtin_amdgcn_rcpf(1.f + __expf(-f0)), fv1 = lb1 + om1 * __builtin_amdgcn_rcpf(1.f + __expf(-f1));
            P0[i] = fv0; P1[i] = fv1; kk0[i] = 1.f - fv0; kk1[i] = 1.f - fv1;
            qv0[i] = q0 * __builtin_amdgcn_rcpf(1.f + __expf(-q0)); qv1[i] = q1 * __builtin_amdgcn_rcpf(1.f + __expf(-q1)); }
        P0[0] = fmaxf(P0[0], 1e-37f); P1[0] = fmaxf(P1[0], 1e-37f);
#pragma unroll
        for (int i = 1; i < 8; ++i) { P0[i] = fmaxf(P0[i] * P0[i - 1], 1e-37f); P1[i] = fmaxf(P1[i] * P1[i - 1], 1e-37f); }
        const float lfl0 = __logf(P0[7]), lfl1 = __logf(P1[7]);
        *(float2*)(seg + lq * 128 + k0) = make_float2(lfl0, lfl1);
        const unsigned v0 = vr[0], v1 = vr[1], v2 = vr[2], v3 = vr[3]; const uint4 gcur = gr;
        if (c < 31) {
            const size_t adv = (size_t)(t0 + 64) * LDP;
#pragma unroll
            for (int i = 0; i < 8; ++i) { qr[i] = *(const unsigned*)(qbase + adv + (size_t)i * LDP); fr[i] = *(const unsigned*)(qbase + adv + (size_t)i * LDP + (C_F - C_Q)); }
#pragma unroll
            for (int i = 0; i < 4; ++i) vr[i] = *(const unsigned*)(vbase + adv + (size_t)i * LDP);
            gr = *(const uint4*)(gbase + adv);
        }
        BAR_LDS();
        float off0 = 0.f, off1 = 0.f, tot0 = 0.f, tot1 = 0.f, mid0 = 0.f, mid1 = 0.f;
#pragma unroll
        for (int j = 0; j < 8; ++j) { const float2 s = *(const float2*)(seg + j * 128 + k0); if (j < lq) { off0 += s.x; off1 += s.y; } if (j < 4) { mid0 += s.x; mid1 += s.y; } tot0 += s.x; tot1 += s.y; }
        const float emid0 = __expf(mid0), emid1 = __expf(mid1), etm0 = __expf(tot0 - mid0), etm1 = __expf(tot1 - mid1);
        float kh0[8], kh1[8];
        const float a0 = off0 - mid0, a1 = off1 - mid1;
        if (fabsf(a0) <= 80.f && fabsf(a0 + lfl0) <= 80.f && fabsf(a1) <= 80.f && fabsf(a1 + lfl1) <= 80.f) {
            const float E0 = __expf(a0), E1 = __expf(a1);
            float r0 = __builtin_amdgcn_rcpf(E0 * P0[7]), r1 = __builtin_amdgcn_rcpf(E1 * P1[7]);
#pragma unroll
            for (int i = 7; i >= 0; --i) { const int lrow = lq * 8 + i; const float e0 = E0 * P0[i], e1 = E1 * P1[i];
                const float qm0 = qv0[i] * e0, qm1 = qv1[i] * e1, km0 = kk0[i] * r0, km1 = kk1[i] * r1;
                kh0[i] = km0 * etm0; kh1[i] = km1 * etm1;
                *(unsigned*)(Qm + lrow * 136 + k0) = pk2(qm0, qm1); *(unsigned*)(Km + lrow * 136 + k0) = pk2(km0, km1); *(unsigned*)(Qs + lrow * 136 + k0) = pk2(qm0 * emid0, qm1 * emid1);
                r0 *= (1.f - kk0[i]); r1 *= (1.f - kk1[i]); }
        } else {
#pragma unroll
            for (int i = 0; i < 8; ++i) { const int lrow = lq * 8 + i; const float cum0 = off0 + __logf(P0[i]), cum1 = off1 + __logf(P1[i]), d0 = cum0 - mid0, d1 = cum1 - mid1;
                const float qm0 = qv0[i] * __expf(fminf(fmaxf(d0, -80.f), 80.f)), km0 = kk0[i] * __expf(fminf(fmaxf(-d0, -80.f), 80.f)), qs0 = qv0[i] * __expf(cum0);
                const float qm1 = qv1[i] * __expf(fminf(fmaxf(d1, -80.f), 80.f)), km1 = kk1[i] * __expf(fminf(fmaxf(-d1, -80.f), 80.f)), qs1 = qv1[i] * __expf(cum1);
                kh0[i] = kk0[i] * __expf(tot0 - cum0); kh1[i] = kk1[i] * __expf(tot1 - cum1);
                *(unsigned*)(Qm + lrow * 136 + k0) = pk2(qm0, qm1); *(unsigned*)(Km + lrow * 136 + k0) = pk2(km0, km1); *(unsigned*)(Qs + lrow * 136 + k0) = pk2(qs0, qs1); }
        }
        { uint4 q0, q1; q0.x = pk2(kh0[0], kh0[1]); q0.y = pk2(kh0[2], kh0[3]); q0.z = pk2(kh0[4], kh0[5]); q0.w = pk2(kh0[6], kh0[7]);
          q1.x = pk2(kh1[0], kh1[1]); q1.y = pk2(kh1[2], kh1[3]); q1.z = pk2(kh1[4], kh1[5]); q1.w = pk2(kh1[6], kh1[7]);
          *(uint4*)(KhT + k0 * 72 + lq * 8) = q0; *(uint4*)(KhT + (k0 + 1) * 72 + lq * 8) = q1; }
        if (lq == 0) *(float2*)(dec + k0) = make_float2(__expf(tot0), __expf(tot1));
        { uint2 a, bq; a.x = (v0 & 0xffffu) | (v1 << 16); a.y = (v2 & 0xffffu) | (v3 << 16); bq.x = (v0 >> 16) | (v1 & 0xffff0000u); bq.y = (v2 >> 16) | (v3 & 0xffff0000u);
          *(uint2*)(VT + (2 * vp) * 72 + vl * 4) = a; *(uint2*)(VT + (2 * vp + 1) * 72 + vl * 4) = bq; }
        BAR_LDS();
        const int mt = wv >> 1, vtb = (wv & 1) * 2;
        f32x4 accO[2], accA[2];
#pragma unroll
        for (int i = 0; i < 2; ++i) { accO[i] = (f32x4){0.f, 0.f, 0.f, 0.f}; accA[i] = (f32x4){0.f, 0.f, 0.f, 0.f}; }
        mma_lds_s<2, 128>(Qm + mt * 16 * 136, 136, Km + vtb * 16 * 136, 136, 16 * 136, accA, lane);
        mma_lds_s<2, 128>(Qs + mt * 16 * 136, 136, ST + vtb * 16 * 136, 136, 16 * 136, accO, lane);
#pragma unroll
        for (int i = 0; i < 2; ++i) { const int scol = (vtb + i) * 16 + l15;
#pragma unroll
            for (int j = 0; j < 4; ++j) { const int lrow = mt * 16 + quad * 4 + j; At[lrow * 72 + scol] = (bf16_t)f2bf(scol <= lrow ? accA[i][j] : 0.f); } }
        BAR_LDS();
        mma_lds_s<2, 64>(At + mt * 16 * 72, 72, VT + vtb * 16 * 72, 72, 16 * 72, accO, lane);
#pragma unroll
        for (int i = 0; i < 2; ++i) { const int nt = vtb + i;
#pragma unroll
            for (int j = 0; j < 4; ++j) Ob[(mt * 16 + quad * 4 + j) * 72 + nt * 16 + l15] = (bf16_t)f2bf(accO[i][j]); }
        const int vts = wv & 3;
#pragma unroll
        for (int i = 0; i < 4; ++i) accS[i] *= dec[((wv >> 2) * 4 + i) * 16 + l15];
        mma_lds_s<4, 64>(VT + vts * 16 * 72, 72, KhT + (wv >> 2) * 4 * 16 * 72, 72, 16 * 72, accS, lane);
#pragma unroll
        for (int i = 0; i < 4; ++i) { const int ktile = (wv >> 2) * 4 + i;
#pragma unroll
            for (int j = 0; j < 4; ++j) ST[(vts * 16 + quad * 4 + j) * 136 + ktile * 16 + l15] = (bf16_t)f2bf(accS[i][j]); }
        { const uint4 ow = *(const uint4*)(Ob + orow * 72 + oc8 * 8); const unsigned ou[4] = {ow.x, ow.y, ow.z, ow.w}, gu[4] = {gcur.x, gcur.y, gcur.z, gcur.w}; unsigned res[4]; float sq = 0.f;
#pragma unroll
          for (int i = 0; i < 4; ++i) { const float o0 = bflo(ou[i]), o1 = bfhi(ou[i]), g0 = bflo(gu[i]), g1 = bfhi(gu[i]); sq += o0 * o0 + o1 * o1;
              res[i] = pk2(o0 * g0 * __builtin_amdgcn_rcpf(1.f + __expf(-g0)), o1 * g1 * __builtin_amdgcn_rcpf(1.f + __expf(-g1))); }
          sq += __shfl_xor(sq, 1); sq += __shfl_xor(sq, 2);
          if ((lane & 3) == 0) p.ss_hg[(row_base + t0 + orow) * 16 + head * 4 + vh * 2 + (wv & 1)] = sq;
          *(uint4*)(gbase + (size_t)t0 * LDP) = make_uint4(res[0], res[1], res[2], res[3]); }
    }
    __syncthreads();
}

__device__ void s5_unit(CPAR p, int l, int g, int b, unsigned char* shm) {
    const int tid = lt_tid(), lane = tid & 63, wv = tid >> 6, quad = lane >> 4, l15 = lane & 15;
    bf16_t* U = (bf16_t*)shm;
    float* St = (float*)(shm + 66560);
    bf16_t* Sin = (bf16_t*)(shm + 66560 + 33280);
    const size_t row_base = (size_t)b * SEQL;
    for (int i = tid; i < 4096; i += 512) { const int tok = i >> 1, hf = i & 1; const uint4 v = *(const uint4*)(p.proj + (row_base + tok) * LDP + C_U + g * 16 + hf * 8);
        *(uint4*)(U + (tok >> 5) * 520 + (tok & 31) * 16 + hf * 8) = v; }
    __syncthreads();
    {
        f32x4 acc[4];
#pragma unroll
        for (int n = 0; n < 4; ++n) acc[n] = (f32x4){0.f, 0.f, 0.f, 0.f};
        const bf16_t* ap = p.wst + (size_t)(l & 1) * 32 * 65536 + (size_t)g * 65536 + (wv * 16 + l15) * 512 + quad * 8;
        bf16x8 af[16];
#pragma unroll
        for (int ks = 0; ks < 16; ++ks) af[ks] = *(const bf16x8*)(ap + ks * 32);
        const bf16_t* ub = U + l15 * 520 + quad * 8;
        bf16x8 fb[2][4];
#pragma unroll
        for (int n = 0; n < 4; ++n) fb[0][n] = *(const bf16x8*)(ub + n * 16 * 520);
#pragma unroll
        for (int ks = 0; ks < 16; ++ks) { const int cur = ks & 1, nxt = cur ^ 1;
            if (ks < 15) {
#pragma unroll
                for (int n = 0; n < 4; ++n) fb[nxt][n] = *(const bf16x8*)(ub + n * 16 * 520 + (ks + 1) * 32); }
            __builtin_amdgcn_sched_barrier(0);
#pragma unroll
            for (int n = 0; n < 4; ++n) acc[n] = MFMA16(af[ks], fb[cur][n], acc[n]);
            __builtin_amdgcn_sched_barrier(0); }
#pragma unroll
        for (int n = 0; n < 4; ++n)
#pragma unroll
            for (int j = 0; j < 4; ++j) St[(wv * 16 + quad * 4 + j) * 65 + n * 16 + l15] = acc[n][j];
    }
    __syncthreads();
    if (tid < 64) { const float* aT = p.aT + (l & 1) * 32 * 64 * 2; const float ar = aT[(g * 64 + tid) * 2], ai = aT[(g * 64 + tid) * 2 + 1]; float sr = 0.f, si = 0.f;
#pragma unroll 8
        for (int c = 0; c < 64; ++c) { Sin[c * 136 + tid] = (bf16_t)f2bf(sr); Sin[c * 136 + 64 + tid] = (bf16_t)f2bf(si);
            const float lr = St[tid * 65 + c], li = St[(64 + tid) * 65 + c]; const float nr = ar * sr - ai * si + lr, ni = ar * si + ai * sr + li; sr = nr; si = ni; } }
    __syncthreads();
    bf16_t* Kt = (bf16_t*)St;
    { const uint4* ksrc = (const uint4*)(p.ktab + (size_t)(l & 1) * 32 * 8192 + (size_t)g * 8192); uint4* kdst = (uint4*)Kt; kdst[tid] = ksrc[tid]; kdst[tid + 512] = ksrc[tid + 512]; }
    __syncthreads();
    const float4 dsk = *(const float4*)(p.s5_d + l * 512 + g * 16 + quad * 4);
    for (int it = 0; it < 4; ++it) {
        const int t = (it & 1) ? (8 * it + 7 - wv) : (8 * it + wv);
        f32x4 acc[4];
#pragma unroll
        for (int n = 0; n < 4; ++n) acc[n] = (f32x4){0.f, 0.f, 0.f, 0.f};
        const bf16_t* wp = p.woff + (size_t)(l & 1) * 32 * 65536 + (size_t)g * 65536 + (t * 16 + l15) * 128 + quad * 8;
        bf16x8 wf[4];
#pragma unroll
        for (int ks = 0; ks < 4; ++ks) wf[ks] = *(const bf16x8*)(wp + ks * 32);
        const bf16_t* kt = Kt + l15 * 16 + (quad & 1) * 8;
        {
            const bf16_t* ub = U + l15 * 520 + quad * 8; const int jmax = t >> 1; const bf16x8 zf = (bf16x8){0, 0, 0, 0, 0, 0, 0, 0};
            bf16x8 ac, an = zf, bc[4], bn[4];
            { const int lag = t - (quad >> 1); ac = zf; if (lag >= 0) ac = *(const bf16x8*)(kt + lag * 256); }
#pragma unroll
            for (int n = 0; n < 4; ++n) { bc[n] = *(const bf16x8*)(ub + n * 16 * 520); bn[n] = zf; }
            for (int j = 0; j <= jmax; ++j) {
                if (j < jmax) { const int lag = t - 2 * (j + 1) - (quad >> 1); an = zf; if (lag >= 0) an = *(const bf16x8*)(kt + lag * 256);
#pragma unroll
                    for (int n = 0; n < 4; ++n) bn[n] = *(const bf16x8*)(ub + n * 16 * 520 + (j + 1) * 32); }
                __builtin_amdgcn_sched_barrier(0);
#pragma unroll
                for (int n = 0; n < 4; ++n) acc[n] = MFMA16(ac, bc[n], acc[n]);
                __builtin_amdgcn_sched_barrier(0);
                ac = an;
#pragma unroll
                for (int n = 0; n < 4; ++n) bc[n] = bn[n]; }
        }
        {
            const bf16_t* sb = Sin + l15 * 136 + quad * 8;
            bf16x8 fb[2][4];
#pragma unroll
            for (int n = 0; n < 4; ++n) fb[0][n] = *(const bf16x8*)(sb + n * 16 * 136);
#pragma unroll
            for (int ks = 0; ks < 4; ++ks) { const int cur = ks & 1, nxt = cur ^ 1;
                if (ks < 3) {
#pragma unroll
                    for (int n = 0; n < 4; ++n) fb[nxt][n] = *(const bf16x8*)(sb + n * 16 * 136 + (ks + 1) * 32); }
                __builtin_amdgcn_sched_barrier(0);
#pragma unroll
                for (int n = 0; n < 4; ++n) acc[n] = MFMA16(wf[ks], fb[cur][n], acc[n]);
                __builtin_amdgcn_sched_barrier(0); }
        }
#pragma unroll
        for (int n = 0; n < 4; ++n) { const int c = n * 16 + l15; const uint2 uw = *(const uint2*)(U + c * 520 + t * 16 + quad * 4);
            float y[4] = {acc[n][0] + dsk.x * bflo(uw.x), acc[n][1] + dsk.y * bfhi(uw.x), acc[n][2] + dsk.z * bflo(uw.y), acc[n][3] + dsk.w * bfhi(uw.y)};
#pragma unroll
            for (int j = 0; j < 4; ++j) { const float z = 0.7978845608f * (y[j] + 0.044715f * y[j] * y[j] * y[j]); const float th = 1.f - 2.f / (__expf(2.f * z) + 1.f); y[j] = 0.5f * y[j] * (1.f + th); }
            uint2 w; w.x = pk2(y[0], y[1]); w.y = pk2(y[2], y[3]);
            *(uint2*)(p.proj + (row_base + c * 32 + t) * LDP + C_U + g * 16 + quad * 4) = w; }
    }
    __syncthreads();
}

__device__ void phase_mixA(CPAR p, int l, unsigned char* shm) {
    const int G = gridDim.x, bid = lt_bid();
    const bool split = (G == 256);
    for (int u = bid; u < 256; u += G) bcconv_unit(p, l, u);
    TSTAMP(6);
    for (int u = (split && bid >= 128) ? 128 : bid; u < 128; u += G) { const int pi = (u & 7) * 8 + (u >> 4), vh = (u >> 3) & 1;
        hgrn_unit(p, l, pi >> 2, pi & 3, vh, shm); }
    TSTAMP(7);
    { int u0 = bid, u1 = 512, st = G; if (split) { const int k = bid - 128, gq = ((k & 7) * 4 + (k >> 5)) * 4 + ((k >> 3) & 3);
        u0 = bid >= 128 ? gq * 4 : 512; u1 = bid >= 128 ? u0 + 4 : 512; st = 1; }
      for (int u = u0; u < u1; u += st) s5_unit(p, l, u >> 4, u & 15, shm); }
    TSTAMP(8);
    if (l < 3 && (!split || bid >= 128)) convert_weights(p, l + 1, split ? bid - 128 : bid, split ? 128 : G, shm);
    TSTAMP(10);
}
__device__ void phase_mixB(CPAR p, int l, unsigned char* shm) {
    const int G = gridDim.x, bid = lt_bid();
    for (int u = bid; u < 256; u += G) { const int bg = (u & 7) * 4 + (u >> 6), r = (u >> 3) & 7;
        ssd_unit(p, l, bg >> 1, (bg & 1) * 8 + r, shm); }
    TSTAMP(9);
}

__device__ __forceinline__ void fin_scales(CPAR p, int row, int lane, float (&sc)[4]) {
    float a0 = 0.f, a1 = 0.f, hh = 0.f, cc = 0.f;
    const float4* s1 = (const float4*)(p.ss_ssd + (size_t)row * 32);
#pragma unroll
    for (int i = 0; i < 4; ++i) { const float4 u = s1[i], v = s1[4 + i]; a0 += u.x + u.y + u.z + u.w; a1 += v.x + v.y + v.z + v.w; }
    { const float4 u = *(const float4*)(p.ss_hg + (size_t)row * 16 + (lane >> 4) * 4); hh = u.x + u.y + u.z + u.w; }
    const float4* s3 = (const float4*)(p.ss_s5 + (size_t)row * 16);
#pragma unroll
    for (int i = 0; i < 4; ++i) { const float4 u = s3[i]; cc += u.x + u.y + u.z + u.w; }
    sc[0] = rsqrtf(a0 * (1.f / 512.f) + EPSN); sc[1] = rsqrtf(a1 * (1.f / 512.f) + EPSN); sc[2] = rsqrtf(hh * (1.f / 128.f) + EPSN); sc[3] = rsqrtf(cc * (1.f / 512.f) + EPSN);
}
__device__ __forceinline__ uint4 scale8(uint4 v, float s) {
    v.x = pk2(bflo(v.x) * s, bfhi(v.x) * s); v.y = pk2(bflo(v.y) * s, bfhi(v.y) * s); v.z = pk2(bflo(v.z) * s, bfhi(v.z) * s); v.w = pk2(bflo(v.w) * s, bfhi(v.w) * s); return v;
}
__device__ void phase_fin(CPAR p) {
    const int tid = lt_tid(), lane = tid & 63, wv = tid >> 6;
    const int rstep = gridDim.x * 8;
    for (int row = lt_bid() * 8 + wv; row < NTOK; row += 2 * rstep) {
        const int row2 = row + rstep; const bool two = row2 < NTOK;
        uint4 va[4], vb[4]; float sa[4], sb[4];
#pragma unroll
        for (int i = 0; i < 4; ++i) { va[i] = *(const uint4*)(p.proj + (size_t)row * LDP + i * 512 + lane * 8); if (two) vb[i] = *(const uint4*)(p.proj + (size_t)row2 * LDP + i * 512 + lane * 8); }
        fin_scales(p, row, lane, sa); if (two) fin_scales(p, row2, lane, sb);
#pragma unroll
        for (int i = 0; i < 4; ++i) { *(uint4*)(p.proj + (size_t)row * LDP + i * 512 + lane * 8) = scale8(va[i], sa[i]); if (two) *(uint4*)(p.proj + (size_t)row2 * LDP + i * 512 + lane * 8) = scale8(vb[i], sb[i]); }
    }
}

__device__ void fill_seg_table(CPAR p, unsigned char* shm) {
    const int tid = lt_tid(), slot = tid >> 8, r = tid & 255;
    pg8::StaticOrder S; S.init(NTOK, 1024, (int)gridDim.x, lt_bid());
    pg8::Unit un; float* rt = (float*)(shm + 131072);
    if (S.next(slot, un)) {
        const size_t row = (size_t)un.pm * 256 + r; float ms[7];
        const float4* s1 = (const float4*)(p.ss_ssd + row * 32); float a0 = 0.f, a1 = 0.f;
#pragma unroll
        for (int i = 0; i < 4; ++i) { const float4 u = s1[i], v = s1[4 + i]; a0 += u.x + u.y + u.z + u.w; a1 += v.x + v.y + v.z + v.w; }
        ms[0] = a0 * (1.f / 512.f); ms[1] = a1 * (1.f / 512.f);
        const float4* s2 = (const float4*)(p.ss_hg + row * 16);
#pragma unroll
        for (int h = 0; h < 4; ++h) { const float4 u = s2[h]; ms[2 + h] = (u.x + u.y + u.z + u.w) * (1.f / 128.f); }
        const float4* s3 = (const float4*)(p.ss_s5 + row * 16); float cc = 0.f;
#pragma unroll
        for (int i = 0; i < 4; ++i) { const float4 u = s3[i]; cc += u.x + u.y + u.z + u.w; }
        ms[6] = cc * (1.f / 512.f);
        float sc[7];
#pragma unroll
        for (int i = 0; i < 7; ++i) sc[i] = rsqrtf(ms[i] + EPSN);
#pragma unroll
        for (int i = 0; i < 6; ++i) rt[(slot * 7 + i) * 256 + r] = sc[i] / sc[i + 1];
        rt[(slot * 7 + 6) * 256 + r] = sc[6];
    }
    __syncthreads();
}

template <class Epi> __device__ __forceinline__ void run_gemm(unsigned char* shm, const pg8::Gemm& g, const Epi& E) {
    pg8::StaticOrder S; S.init(g.M, g.N, (int)gridDim.x, lt_bid());
    pg8::gemm_phase<Epi, pg8::StaticOrder, false>((PG8_LAS unsigned char*)shm, g, S, E, nullptr);
}

__global__ __launch_bounds__(512, 2) void mega(Params p_unused) {
    extern __shared__ __attribute__((aligned(16))) unsigned char shm[];
    __shared__ uint4 xb_words;
    cg::grid_group grid = cg::this_grid();
    if (threadIdx.x == 0) xb_words = make_uint4(0u, 0u, 0u, 0u);
    __syncthreads();
    { CPAR p = *GETP(); (void)xcd_barrier_post(p.bar, (volatile LAS unsigned*)&xb_words); }
#define GSYNC() do { CPAR _q = *GETP(); XcdBarrier _b; _b.bar = _q.bar; _b.x = xb_xcc_id(); _b.st = (volatile LAS unsigned*)&xb_words; xcd_barrier(_b); } while (0)
#if TPROBE >= 0
    if (blockIdx.x == TBLK && threadIdx.x == 0) { CPAR _p = *GETP(); unsigned long long* _w = (unsigned long long*)_p.wdt; _w[0] = wall_clock64(); _w[1] = 0; }
#endif
#pragma unroll 1
    for (int l = 0; l < 4; ++l) {
#if PH & 1
        { CPAR p = *GETP(); phase_prep(p, l, shm); }
#endif
        if (l == 0) grid.sync(); else GSYNC();
        TSTAMP(0);
#if PH & 2
        { CPAR p = *GETP(); pg8::Gemm g{p.xb, p.winT + (size_t)(l & 1) * LDP * DM, NTOK, LDP, DM, DM}; EpiIn e{p.proj, p.rstd}; run_gemm(shm, g, e); }
#endif
        GSYNC(); TSTAMP(1);
#if PH & 4
        { CPAR p = *GETP(); phase_mixA(p, l, shm); }
#endif
        GSYNC(); TSTAMP(2);
#if PH & 4
        { CPAR p = *GETP(); phase_mixB(p, l, shm); }
#endif
#if PH & 8
        { CPAR p = *GETP(); pg8::Gemm g{p.proj + C_U, p.wgluT + (size_t)(l & 1) * 1024 * 512, NTOK, 1024, 512, LDP}; EpiGlu e{p.proj, p.glu_b + l * 1024, p.ss_s5}; run_gemm(shm, g, e); }
#endif
        GSYNC(); TSTAMP(3);
        { CPAR p = *GETP(); fill_seg_table(p, shm); }
        { CPAR p = *GETP(); pg8::Gemm g{p.proj, p.woutT + (size_t)(l & 1) * 1024 * 2048, NTOK, 1024, 2048, LDP}; EpiOutSeg e{p.proj}; run_gemm(shm, g, e); }
        GSYNC(); TSTAMP(5);
    }
#if PH & 1
    { CPAR p = *GETP(); phase_prep(p, 4, shm); }
#endif
#if TPROBE >= 0
    __syncthreads(); TSTAMP(0);
    grid.sync();
    if (blockIdx.x == TBLK && threadIdx.x == 0) { CPAR p = *GETP(); p.out[0] = (float)(((unsigned long long*)p.wdt)[1]) * 0.001f; }
#endif
}

extern "C" void kernel_launch(void* const* d_in, const int* in_sizes, int n_in, void* d_out, int out_size, void* d_ws, size_t ws_size, hipStream_t stream) {
    constexpr size_t kLds = 162816;
    static int grid_blocks = 0;
    if (!grid_blocks) {
        int dev = 0, cus = 0, per_cu = 0;
        hipGetDevice(&dev);
        hipDeviceGetAttribute(&cus, hipDeviceAttributeMultiprocessorCount, dev);
        hipFuncSetAttribute((const void*)mega, hipFuncAttributeMaxDynamicSharedMemorySize, (int)kLds);
        hipOccupancyMaxActiveBlocksPerMultiprocessor(&per_cu, mega, 512, kLds);
        if (per_cu < 1) per_cu = 1;
        grid_blocks = cus * per_cu;
        if (grid_blocks > 256) grid_blocks = 256;
        if (grid_blocks != 256) fprintf(stderr, "this build assumes a 256-workgroup grid (got %d)\n", grid_blocks);
    }
    Params p{};
    const float** f = (const float**)&p;
    for (int i = 0; i < 24; ++i) f[i] = (const float*)d_in[i];
    p.out = (float*)d_out;
    p.bcb = (bf16_t*)d_out;
    unsigned char* w = (unsigned char*)d_ws; size_t off = 0;
    auto take = [&](size_t bytes) { unsigned char* r = w + off; off += (bytes + 255) & ~(size_t)255; return r; };
    p.proj = (bf16_t*)take((size_t)NTOK * LDP * 2);
    p.xb = (bf16_t*)take((size_t)NTOK * DM * 2);
    p.winT = (bf16_t*)take((size_t)2 * LDP * DM * 2);
    p.woutT = (bf16_t*)take((size_t)2 * 1024 * 2048 * 2);
    p.wgluT = (bf16_t*)take((size_t)2 * 1024 * 512 * 2);
    p.ktab = (bf16_t*)take((size_t)2 * 32 * 8192 * 2);
    p.woff = (bf16_t*)take((size_t)2 * 32 * 65536 * 2);
    p.wst = (bf16_t*)take((size_t)2 * 32 * 65536 * 2);
    p.wdt = (float*)take(256);
    p.aT = (float*)take((size_t)2 * 32 * 64 * 2 * 4);
    p.lb = (float*)take((size_t)4 * 512 * 4);
    p.rstd = (float*)take((size_t)NTOK * 4);
    p.dtraw = (float*)take((size_t)NTOK * 16 * 4);
    p.ss_ssd = (float*)take((size_t)NTOK * 32 * 4);
    p.ss_hg = (float*)take((size_t)NTOK * 32 * 4);
    p.ss_s5 = (float*)take((size_t)NTOK * 16 * 4);
    p.bar = (unsigned*)take((size_t)XCD_BAR_WORDS * 4);
    if (off > ws_size) { fprintf(stderr, "workspace too small: need %zu have %zu\n", off, ws_size); return; }
    hipMemsetAsync(p.bar, 0, (size_t)XCD_BAR_WORDS * 4, stream);
    void* args[] = {&p};
    hipError_t e = hipLaunchCooperativeKernel((const void*)mega, dim3(grid_blocks), dim3(512), args, kLds, stream);
    if (e != hipSuccess) fprintf(stderr, "cooperative launch failed: %s (grid %d)\n", hipGetErrorString(e), grid_blocks);
}
```

```cpp
#include <hip/hip_runtime.h>
#include <hip/hip_cooperative_groups.h>
#include <cstdio>
namespace cg = cooperative_groups;
__device__ __forceinline__ int lt_tid() { int t = threadIdx.x; asm volatile("" : "+v"(t)); return t; }
__device__ __forceinline__ int lt_bid() { int t = blockIdx.x; asm volatile("" : "+s"(t)); return t; }
namespace pg8 {
#define PG8_LAS __attribute__((address_space(3)))
typedef unsigned short bf16_t;
typedef short bf16x8 __attribute__((ext_vector_type(8)));
typedef float f32x4 __attribute__((ext_vector_type(4)));
typedef unsigned u32x4 __attribute__((ext_vector_type(4)));
constexpr int BM = 256, BK = 64, HALF = 128, HTB = HALF * BK * 2  , STAGE_BYTES = 8 * HTB, NXCD = 8, WGM = 8;

__host__ __device__ __forceinline__ int lds_byte(int r, int c) { const int st = (r >> 4) * 2 + (c >> 5), rr = r & 15, cc = c & 31, ob = rr * 64 + cc * 2; return st * 1024 + (ob ^ (((ob >> 9) & 1) << 5)); }
__host__ __device__ __forceinline__ void stage_rc(int b, int& R, int& C) { const int st = b / 1024, sb = b % 1024, swz = sb ^ (((sb >> 9) & 1) << 5); R = (st >> 1) * 16 + swz / 64; C = (st & 1) * 32 + (swz % 64) / 2; }
__host__ __device__ __forceinline__ int perm32(int rho) { const int n = rho >> 4, i = rho & 15; return 8 * (i >> 2) + 4 * n + (i & 3); }

struct Unit { int pm, pn; };
struct Gemm { const bf16_t* A; const bf16_t* Bt; int M, N, K, lda; };

struct StaticOrder {
    int nM, nN, nwg, G, c;
    __host__ __device__ void init(int M, int N, int G_, int c_) { nM = M / BM; nN = N / BM; nwg = nM * nN; G = G_; c = c_; }
    __host__ __device__ bool next(int i, Unit& u) const {
        const long L = (long)i * G + c; if (L >= nwg) return false;
        int wgid = (int)L; { const int q = nwg / NXCD, r = nwg % NXCD, xcd = wgid % NXCD, off = wgid / NXCD; wgid = (xcd < r ? xcd * (q + 1) : r * (q + 1) + (xcd - r) * q) + off; }
        const int nig = WGM * nN, gid = wgid / nig, fm = gid * WGM, gsz = (nM - fm) < WGM ? (nM - fm) : WGM;
        u.pm = fm + ((wgid % nig) % gsz); u.pn = (wgid % nig) / gsz; return true;
    }
    __device__ __forceinline__ void a_ready(const Unit&) const {}
    __device__ __forceinline__ void done(const Unit&) const {}
};

__device__ __forceinline__ unsigned cvt_pk_bf16(float lo, float hi) { unsigned r; asm volatile("v_cvt_pk_bf16_f32 %0, %1, %2" : "=v"(r) : "v"(lo), "v"(hi)); return r; }
template <class Epi, class Sched, bool STAMP = false>
__device__ __forceinline__ void gemm_phase(PG8_LAS unsigned char* lds, const Gemm g, const Sched& S, const Epi& E, unsigned long long* stamps) {
    const int tid = lt_tid(), wid = __builtin_amdgcn_readfirstlane(tid >> 6), lane = tid & 63, wr = wid >> 2, wc = wid & 3, fr = lane & 15, fq = lane >> 4;
    const int K = g.K, nt = K / BK;
    int ts_lo = 0, ts_hi = 0, nts = 0; const unsigned long long rt_entry = STAMP ? (unsigned long long)wall_clock64() : 0ull;
#define PG8_STAMP() do { if (STAMP && wid == 0 && nts < 64) { const unsigned long long _c = (unsigned long long)clock64(); \
        ts_lo = (lane == nts) ? (int)(unsigned)_c : ts_lo; ts_hi = (lane == nts) ? (int)(unsigned)(_c >> 32) : ts_hi; ++nts; } } while (0)
    PG8_STAMP();
    unsigned voffA[2], voffB[2];
#pragma unroll
    for (int i = 0; i < 2; ++i) { int R, C; stage_rc(tid * 16 + i * 8192, R, C); const int Rb = Epi::PERM ? ((R & ~31) + perm32(R & 31)) : R;
        voffA[i] = (unsigned)(R * g.lda + C) * 2u; voffB[i] = (unsigned)(Rb * K + C) * 2u; }
    const size_t kstep = (size_t)(BK * 2);
    const size_t hstep = (size_t)HALF * K * 2;
    const size_t tstep = 2 * hstep; const size_t hstepA = (size_t)HALF * g.lda * 2; const size_t tstepA = 2 * hstepA;
    const unsigned ldsw = (unsigned)wid * 1024u;
    const int aoff = lds_byte(wr * 64 + fr, fq * 8), boff = lds_byte(wc * 32 + fr, fq * 8);
#define PG8_SA(b, h) (((b) * 2 + (h)) * HTB)
#define PG8_SB(b, h) ((4 + (b) * 2 + (h)) * HTB)
#define PG8_STAGE(bufoff, gbase, voff) do { _Pragma("unroll") for (int _i = 0; _i < 2; ++_i) \
        __builtin_amdgcn_global_load_lds((const unsigned*)((const char*)(gbase) + (voff)[_i]), (PG8_LAS unsigned*)(lds + (bufoff) + ldsw + _i * 8192), 16, 0, 0); } while (0)
#define PG8_LDA(dst, b, h) do { _Pragma("unroll") for (int m = 0; m < 4; ++m) _Pragma("unroll") for (int k = 0; k < 2; ++k) dst[m][k] = *(const PG8_LAS bf16x8*)(lds + PG8_SA(b, h) + aoff + m * 2048 + k * 1024); } while (0)
#define PG8_LDB(dst, b, h) do { _Pragma("unroll") for (int n = 0; n < 2; ++n) _Pragma("unroll") for (int k = 0; k < 2; ++k) dst[n][k] = *(const PG8_LAS bf16x8*)(lds + PG8_SB(b, h) + boff + n * 2048 + k * 1024); } while (0)
#define PG8_MMA(ai, bj, At, Bt) do { __builtin_amdgcn_s_setprio(1); _Pragma("unroll") for (int m = 0; m < 4; ++m) _Pragma("unroll") for (int n = 0; n < 2; ++n) _Pragma("unroll") for (int k = 0; k < 2; ++k) \
        acc[ai][bj][m][n] = __builtin_amdgcn_mfma_f32_16x16x32_bf16(Bt[n][k], At[m][k], acc[ai][bj][m][n], 0, 0, 0); __builtin_amdgcn_s_setprio(0); } while (0)
#define PG8_WAIT_V(n) asm volatile("s_waitcnt vmcnt(" #n ")" ::: "memory")
#define PG8_WAIT_L(n) asm volatile("s_waitcnt lgkmcnt(" #n ")" ::: "memory")
#define PG8_BAR __builtin_amdgcn_s_barrier()
#define PG8_SCHED __builtin_amdgcn_sched_barrier(0)
    Unit cur, nxt; int ui = 0;
    if (!S.next(0, cur)) return;
    f32x4 acc[2][2][4][2];
#pragma unroll
    for (int a = 0; a < 2; ++a)
#pragma unroll
        for (int b = 0; b < 2; ++b)
#pragma unroll
            for (int m = 0; m < 4; ++m)
#pragma unroll
                for (int n = 0; n < 2; ++n) acc[a][b][m][n] = (f32x4){0.f, 0.f, 0.f, 0.f};
    bf16x8 At[4][2], B0[2][2], B1[2][2];
    const char* cA = (const char*)g.A + (size_t)cur.pm * tstepA; const char* cB = (const char*)g.Bt + (size_t)cur.pn * tstep;
    S.a_ready(cur);
    PG8_STAGE(PG8_SB(0, 0), cB, voffB); PG8_STAGE(PG8_SA(0, 0), cA, voffA); PG8_STAGE(PG8_SB(0, 1), cB + hstep, voffB); PG8_STAGE(PG8_SA(0, 1), cA + hstepA, voffA);
    if (wr == 1) PG8_BAR;
    PG8_WAIT_V(4); PG8_BAR;
    PG8_STAGE(PG8_SB(1, 0), cB + kstep, voffB); PG8_STAGE(PG8_SA(1, 0), cA + kstep, voffA); PG8_STAGE(PG8_SB(1, 1), cB + hstep + kstep, voffB);
    PG8_WAIT_V(6); PG8_BAR;
    PG8_STAMP();
    for (;;) {
        const bool has_next = S.next(ui + 1, nxt);
        const char* nA = has_next ? (const char*)g.A + (size_t)nxt.pm * tstepA : cA; const char* nB = has_next ? (const char*)g.Bt + (size_t)nxt.pn * tstep : cB;
        for (int t = 0; t < nt; t += 2) {
            if constexpr (Epi::SEG) { if (t >= 8 && E.boundary(t)) E.rescale(acc, t, ui, wr, fr, lds); }
            const bool last = (t == nt - 2);
            const char* a1 = cA + (size_t)(t + 1) * kstep;
            const char* a2 = last ? nA : cA + (size_t)(t + 2) * kstep; const char* b2 = last ? nB : cB + (size_t)(t + 2) * kstep;
            const char* a3 = a2 + kstep; const char* b3 = b2 + kstep;
            if (last && has_next) S.a_ready(nxt);
            PG8_LDB(B0, 0, 0); PG8_SCHED; PG8_LDA(At, 0, 0); PG8_STAGE(PG8_SA(1, 1), a1 + hstepA, voffA);
            PG8_WAIT_L(8); PG8_BAR; PG8_WAIT_L(0); PG8_MMA(0, 0, At, B0); PG8_BAR; PG8_SCHED;
            PG8_LDB(B1, 0, 1); PG8_STAGE(PG8_SB(0, 0), b2, voffB);
            PG8_BAR; PG8_WAIT_L(0); PG8_MMA(0, 1, At, B1); PG8_BAR;
            PG8_LDA(At, 0, 1); PG8_STAGE(PG8_SA(0, 0), a2, voffA);
            PG8_BAR; PG8_WAIT_L(0); PG8_MMA(1, 0, At, B0); PG8_BAR; PG8_SCHED;
            PG8_STAGE(PG8_SB(0, 1), b2 + hstep, voffB);
            PG8_WAIT_V(6); PG8_BAR; PG8_MMA(1, 1, At, B1); PG8_BAR;
            PG8_LDB(B0, 1, 0); PG8_SCHED; PG8_LDA(At, 1, 0); PG8_STAGE(PG8_SA(0, 1), a2 + hstepA, voffA);
            PG8_WAIT_L(8); PG8_BAR; PG8_WAIT_L(0); PG8_MMA(0, 0, At, B0); PG8_BAR; PG8_SCHED;
            PG8_LDB(B1, 1, 1); PG8_STAGE(PG8_SB(1, 0), b3, voffB);
            PG8_BAR; PG8_WAIT_L(0); PG8_MMA(0, 1, At, B1); PG8_BAR;
            PG8_LDA(At, 1, 1); PG8_STAGE(PG8_SA(1, 0), a3, voffA);
            PG8_BAR; PG8_WAIT_L(0); PG8_MMA(1, 0, At, B0); PG8_BAR; PG8_SCHED;
            PG8_STAGE(PG8_SB(1, 1), b3 + hstep, voffB);
            PG8_WAIT_V(6); PG8_BAR; PG8_MMA(1, 1, At, B1); PG8_BAR;
        }
        PG8_STAMP();
        if constexpr (Epi::SEG) { E.fin(acc, cur, wr, wc, fr, fq, ui, lds); } else if constexpr (!Epi::AFTER_DRAIN) { E(acc, cur, wr, wc, fr, fq); S.done(cur); }
        PG8_STAMP();
        if (!has_next) break;
#pragma unroll
        for (int a = 0; a < 2; ++a)
#pragma unroll
            for (int b = 0; b < 2; ++b)
#pragma unroll
                for (int m = 0; m < 4; ++m)
#pragma unroll
                    for (int n = 0; n < 2; ++n) acc[a][b][m][n] = (f32x4){0.f, 0.f, 0.f, 0.f};
        cur = nxt; cA = nA; cB = nB; ++ui;
    }
    PG8_WAIT_V(0);
    if (wr == 0) PG8_BAR;
    PG8_BAR;
    if constexpr (Epi::AFTER_DRAIN) { E.fused(acc, cur, wr, wc, fr, fq, lds, wid, lane); S.done(cur); }
    PG8_STAMP();
    if (STAMP && wid == 0) { stamps[lane] = lane < nts ? (((unsigned long long)(unsigned)ts_hi << 32) | (unsigned)ts_lo) : 0ull;
        if (lane == 62) stamps[62] = rt_entry; if (lane == 63) stamps[63] = (unsigned long long)wall_clock64(); }
#undef PG8_STAMP
#undef PG8_SA
#undef PG8_SB
#undef PG8_STAGE
#undef PG8_LDA
#undef PG8_LDB
#undef PG8_MMA
#undef PG8_WAIT_V
#undef PG8_WAIT_L
#undef PG8_BAR
#undef PG8_SCHED
}
}

using pg8::bf16_t; using pg8::bf16x8; using pg8::f32x4;
constexpr int NTOK = 32768, SEQL = 2048, DM = 1024, LDP = 5632, INC = 5648;
constexpr int C_Z = 0, C_G = 1024, C_SG = 1536, C_XBC = 2048, C_Q = 3584, C_F = 4096, C_I = 4608, C_U = 5120, C_O = 2048;
constexpr float EPSN = 1e-6f;

struct Params {
    const float *x, *pre_w, *post_w, *w_in, *w_out, *conv_w, *conv_b, *dt_bias, *a_log, *ssd_d, *ssd_nw, *hg_lb, *hg_nw,
        *lam_re, *lam_im, *log_step, *b_re, *b_im, *c_re, *c_im, *s5_d, *glu_w, *glu_b, *s5_nw;
    float* out;
    bf16_t *proj, *xb, *winT, *woutT, *wgluT, *ktab, *woff, *wst;
    float *wdt, *aT, *lb, *rstd, *dtraw, *ss_ssd, *ss_hg, *ss_s5;
    unsigned* bar; unsigned* wq;
    bf16_t* bcb;
};

#define CPAR const __attribute__((address_space(4))) Params&
#define GETP() ({ const __attribute__((address_space(4))) Params* _pp = (const __attribute__((address_space(4))) Params*)__builtin_amdgcn_kernarg_segment_ptr(); asm volatile("" : "+s"(_pp)); _pp; })
__device__ __forceinline__ unsigned f2bf(float f) { unsigned u = __float_as_uint(f); u += 0x7FFFu + ((u >> 16) & 1u); return u >> 16; }
__device__ __forceinline__ float bf2f(unsigned b) { return __uint_as_float(b << 16); }
__device__ __forceinline__ float bflo(unsigned w) { return __uint_as_float(w << 16); }
__device__ __forceinline__ float bfhi(unsigned w) { return __uint_as_float(w & 0xffff0000u); }
__device__ __forceinline__ unsigned pk2(float a, float b) { unsigned r; asm("v_cvt_pk_bf16_f32 %0, %1, %2" : "=v"(r) : "v"(a), "v"(b)); return r; }
__device__ __forceinline__ float sigmoidf_(float v) { return 1.f / (1.f + __expf(-v)); }
__device__ __forceinline__ float siluf_(float v) { return v / (1.f + __expf(-v)); }
__device__ __forceinline__ float wave_sum(float v) {
#pragma unroll
    for (int o = 32; o >= 1; o >>= 1) v += __shfl_xor(v, o);
    return v;
}
__device__ __forceinline__ f32x4 mma_lds(const bf16_t* A, int lda, const bf16_t* Bt, int ldb, int K, f32x4 acc, int lane) {
    const bf16_t* ap = A + (lane & 15) * lda + (lane >> 4) * 8;
    const bf16_t* bp = Bt + (lane & 15) * ldb + (lane >> 4) * 8;
#pragma unroll 4
    for (int k0 = 0; k0 < K; k0 += 32) {
        bf16x8 a = *(const bf16x8*)(ap + k0), b = *(const bf16x8*)(bp + k0);
        acc = __builtin_amdgcn_mfma_f32_16x16x32_bf16(a, b, acc, 0, 0, 0);
    }
    return acc;
}

template <int NT, int K>
__device__ __forceinline__ void mma_lds_n(const bf16_t* A, int lda, const bf16_t* Bt, int ldb, int bstride, f32x4 (&acc)[NT], int lane) {
    const bf16_t* ap = A + (lane & 15) * lda + (lane >> 4) * 8;
    const bf16_t* bp = Bt + (lane & 15) * ldb + (lane >> 4) * 8;
    constexpr int KS = K / 32;
    bf16x8 a[2], b[2][NT];
    a[0] = *(const bf16x8*)ap;
#pragma unroll
    for (int i = 0; i < NT; ++i) b[0][i] = *(const bf16x8*)(bp + i * bstride);
#pragma unroll
    for (int ks = 0; ks < KS; ++ks) { const int cur = ks & 1, nxt = cur ^ 1;
        if (ks + 1 < KS) { a[nxt] = *(const bf16x8*)(ap + (ks + 1) * 32);
#pragma unroll
            for (int i = 0; i < NT; ++i) b[nxt][i] = *(const bf16x8*)(bp + i * bstride + (ks + 1) * 32); }
        __builtin_amdgcn_sched_barrier(0);
#pragma unroll
        for (int i = 0; i < NT; ++i) acc[i] = __builtin_amdgcn_mfma_f32_16x16x32_bf16(a[cur], b[cur][i], acc[i], 0, 0, 0);
        __builtin_amdgcn_sched_barrier(0); }
}

template <int NT, int K>
__device__ __forceinline__ void mma_lds_s(const bf16_t* A, int lda, const bf16_t* Bt, int ldb, int bstride, f32x4 (&acc)[NT], int lane) {
    const bf16_t* ap = A + (lane & 15) * lda + (lane >> 4) * 8;
    const bf16_t* bp = Bt + (lane & 15) * ldb + (lane >> 4) * 8;
#pragma unroll
    for (int k0 = 0; k0 < K; k0 += 32) { const bf16x8 a = *(const bf16x8*)(ap + k0);
#pragma unroll
        for (int i = 0; i < NT; ++i) { const bf16x8 b = *(const bf16x8*)(bp + i * bstride + k0); acc[i] = __builtin_amdgcn_mfma_f32_16x16x32_bf16(a, b, acc[i], 0, 0, 0); } }
}

#define XB_TMO      128
#define XB_XCNT(j)  (256  + 64 * (j))
#define XB_XSUB(j)  (1280 + 64 * (j))
#define XB_XGEN(j)  (2304 + 64 * (j))
#define XB_TOP      3328
#define XB_TOPGEN   3392
#define XCD_BAR_WORDS 3456
#define XB_SPIN_CAP (1u << 18)
#define LAS __attribute__((address_space(3)))

__device__ __forceinline__ unsigned xb_ld(unsigned* p)              { return __hip_atomic_load(p, __ATOMIC_RELAXED, __HIP_MEMORY_SCOPE_AGENT); }
__device__ __forceinline__ unsigned xb_add(unsigned* p, unsigned v) { return __hip_atomic_fetch_add(p, v, __ATOMIC_RELAXED, __HIP_MEMORY_SCOPE_AGENT); }
__device__ __forceinline__ unsigned xb_xcc_id() { return (unsigned)__builtin_amdgcn_s_getreg((3 << 11) | 20) & 0xFu; }
#define XB_SPIN(cond, bar) do { unsigned _sp = 0; while (cond) { __builtin_amdgcn_s_sleep(1); \
    if ((++_sp & 255u) == 0u) { if (xb_ld(&(bar)[XB_TMO])) break; if (_sp > XB_SPIN_CAP) { atomicAdd(&(bar)[XB_TMO], 1u); break; } } } } while (0)

struct XcdBarrier {
    unsigned* bar; unsigned* wq;
    bf16_t* bcb; unsigned x;
    volatile LAS unsigned* st;
};

__device__ __forceinline__ XcdBarrier xcd_barrier_post(unsigned* bar, volatile LAS unsigned* st) {
    XcdBarrier b; b.bar = bar; b.x = xb_xcc_id(); b.st = st;
    if (threadIdx.x == 0) (void)xb_add(&bar[XB_XCNT(b.x)], 1u);
    return b;
}
__device__ __forceinline__ void xcd_barrier_complete(unsigned* bar, unsigned x, unsigned& nloc, unsigned& nx) {
    const unsigned G = gridDim.x * gridDim.y * gridDim.z;
    unsigned sum, cnt, mine, sp = 0u;
    for (;;) {
        sum = 0u; cnt = 0u; mine = 0u;
#pragma unroll
        for (unsigned j = 0; j < 16; ++j) { const unsigned c = xb_ld(&bar[XB_XCNT(j)]); sum += c; cnt += (c > 0u) ? 1u : 0u; mine = (j == x) ? c : mine; }
        if (sum == G) break;
        __builtin_amdgcn_s_sleep(1);
        if ((++sp & 255u) == 0u) { if (xb_ld(&bar[XB_TMO])) break; if (sp > XB_SPIN_CAP) { atomicAdd(&bar[XB_TMO], 1u); break; } }
    }
    nloc = mine > 0u ? mine : 1u; nx = cnt > 0u ? cnt : 1u;
}

__device__ __forceinline__ void xcd_barrier(const XcdBarrier& b) {
    asm volatile("s_waitcnt vmcnt(0)" ::: "memory");
    __syncthreads();
    if (threadIdx.x == 0) {
        unsigned* bar = b.bar;
        __builtin_amdgcn_s_waitcnt(0);
        unsigned nloc = b.st[0], nx = b.st[1];
        if (nloc == 0u) { xcd_barrier_complete(bar, b.x, nloc, nx); b.st[0] = nloc; b.st[1] = nx; }
        const unsigned old = xb_add(&bar[XB_XSUB(b.x)], 1u);
        const unsigned gen = old / nloc;
        if (old + 1u == (gen + 1u) * nloc) {
            __builtin_amdgcn_fence(__ATOMIC_RELEASE, "agent");
            asm volatile("s_waitcnt vmcnt(0)" ::: "memory");
            const unsigned og = xb_add(&bar[XB_TOP], 1u);
            const unsigned tg = og / nx;
            if (og + 1u == (tg + 1u) * nx) xb_add(&bar[XB_TOPGEN], 1u);
            else XB_SPIN(xb_ld(&bar[XB_TOPGEN]) == tg, bar);
            __builtin_amdgcn_fence(__ATOMIC_ACQUIRE, "agent");
            xb_add(&bar[XB_XGEN(b.x)], 1u);
            asm volatile("s_waitcnt vmcnt(0)" ::: "memory");
        } else {
            XB_SPIN(xb_ld(&bar[XB_XGEN(b.x)]) == gen, bar);
            __builtin_amdgcn_fence(__ATOMIC_ACQUIRE, "agent");
            asm volatile("s_waitcnt vmcnt(0)" ::: "memory");
        }
    }
    __syncthreads();
}


struct EpiIn {
    static constexpr bool PERM = false, AFTER_DRAIN = false, SEG = false;
    bf16_t* O; const float* rstd;
    __device__ __forceinline__ void operator()(const f32x4 (&acc)[2][2][4][2], const pg8::Unit& u, int wr, int wc, int fr, int fq) const {
        const int row0 = u.pm * 256 + wr * 64 + fr, col0 = u.pn * 256 + wc * 32 + 4 * fq;
#pragma unroll
        for (int ai = 0; ai < 2; ++ai)
#pragma unroll
            for (int m = 0; m < 4; ++m) { const int row = row0 + ai * 128 + m * 16; const float rs = rstd[row]; bf16_t* rowp = O + (size_t)row * LDP + col0;
#pragma unroll
                for (int bj = 0; bj < 2; ++bj)
#pragma unroll
                    for (int n = 0; n < 2; ++n) { const f32x4 v = acc[ai][bj][m][n] * rs; uint2 w; w.x = pk2(v[0], v[1]); w.y = pk2(v[2], v[3]); *(uint2*)(rowp + bj * 128 + n * 16) = w; } }
    }
};
struct EpiOut {
    static constexpr bool PERM = false, AFTER_DRAIN = false, SEG = false;
    bf16_t* O;
    __device__ __forceinline__ void operator()(const f32x4 (&acc)[2][2][4][2], const pg8::Unit& u, int wr, int wc, int fr, int fq) const {
        const int row0 = u.pm * 256 + wr * 64 + fr, col0 = u.pn * 256 + wc * 32 + 4 * fq;
#pragma unroll
        for (int ai = 0; ai < 2; ++ai)
#pragma unroll
            for (int m = 0; m < 4; ++m) { const int row = row0 + ai * 128 + m * 16; bf16_t* rowp = O + (size_t)row * LDP + C_O + col0;
#pragma unroll
                for (int bj = 0; bj < 2; ++bj)
#pragma unroll
                    for (int n = 0; n < 2; ++n) { const f32x4 v = acc[ai][bj][m][n]; uint2 w; w.x = pk2(v[0], v[1]); w.y = pk2(v[2], v[3]); *(uint2*)(rowp + bj * 128 + n * 16) = w; } }
    }
};
struct EpiOutSeg {
    static constexpr bool PERM = false, AFTER_DRAIN = false, SEG = true;
    bf16_t* O;
    __device__ __forceinline__ bool boundary(int t) const { return t == 8 || t == 16 || t == 18 || t == 20 || t == 22 || t == 24; }
    __device__ __forceinline__ void rescale(f32x4 (&acc)[2][2][4][2], int t, int ui, int wr, int fr, PG8_LAS unsigned char* lds) const {
        const int b = (t == 8) ? 0 : (t == 16) ? 1 : ((t - 14) >> 1);
        const PG8_LAS float* rt = (const PG8_LAS float*)(lds + 131072) + ((ui & 1) * 7 + b) * 256 + wr * 64 + fr;
#pragma unroll
        for (int ai = 0; ai < 2; ++ai)
#pragma unroll
            for (int m = 0; m < 4; ++m) { const float r = rt[ai * 128 + m * 16];
#pragma unroll
                for (int bj = 0; bj < 2; ++bj)
#pragma unroll
                    for (int n = 0; n < 2; ++n) acc[ai][bj][m][n] *= r; }
    }
    __device__ __forceinline__ void fin(const f32x4 (&acc)[2][2][4][2], const pg8::Unit& u, int wr, int wc, int fr, int fq, int ui, PG8_LAS unsigned char* lds) const {
        const PG8_LAS float* rt = (const PG8_LAS float*)(lds + 131072) + ((ui & 1) * 7 + 6) * 256 + wr * 64 + fr;
        const int row0 = u.pm * 256 + wr * 64 + fr, col0 = u.pn * 256 + wc * 32 + 4 * fq;
#pragma unroll
        for (int ai = 0; ai < 2; ++ai)
#pragma unroll
            for (int m = 0; m < 4; ++m) { const int row = row0 + ai * 128 + m * 16; const float r = rt[ai * 128 + m * 16]; bf16_t* rowp = O + (size_t)row * LDP + C_O + col0;
#pragma unroll
                for (int bj = 0; bj < 2; ++bj)
#pragma unroll
                    for (int n = 0; n < 2; ++n) { const f32x4 v = acc[ai][bj][m][n] * r; uint2 w; w.x = pk2(v[0], v[1]); w.y = pk2(v[2], v[3]); *(uint2*)(rowp + bj * 128 + n * 16) = w; } }
    }
    __device__ __forceinline__ void operator()(const f32x4 (&acc)[2][2][4][2], const pg8::Unit& u, int wr, int wc, int fr, int fq) const {}
};
struct EpiGlu {
    static constexpr bool PERM = false, AFTER_DRAIN = false, SEG = false;
    bf16_t* P; const float* bias; float* ss;
    __device__ __forceinline__ void operator()(const f32x4 (&acc)[2][2][4][2], const pg8::Unit& u, int wr, int wc, int fr, int fq) const {
        const int row0 = u.pm * 256 + wr * 64 + fr, c0 = u.pn * 128 + wc * 32 + 4 * fq;
        f32x4 bv[2], bg[2];
#pragma unroll
        for (int n = 0; n < 2; ++n) { bv[n] = *(const f32x4*)(bias + c0 + n * 16); bg[n] = *(const f32x4*)(bias + 512 + c0 + n * 16); }
#pragma unroll
        for (int ai = 0; ai < 2; ++ai)
#pragma unroll
            for (int m = 0; m < 4; ++m) { const int row = row0 + ai * 128 + m * 16; bf16_t* rowp = P + (size_t)row * LDP + C_SG + c0; float sq = 0.f;
#pragma unroll
                for (int n = 0; n < 2; ++n) { const f32x4 val = acc[ai][0][m][n] + bv[n], gt = acc[ai][1][m][n] + bg[n]; const uint2 gw = *(const uint2*)(rowp + n * 16);
                    float g[4] = {bflo(gw.x), bfhi(gw.x), bflo(gw.y), bfhi(gw.y)}; float y[4];
#pragma unroll
                    for (int j = 0; j < 4; ++j) { y[j] = val[j] * sigmoidf_(gt[j]) * siluf_(g[j]); sq += y[j] * y[j]; }
                    uint2 w; w.x = pk2(y[0], y[1]); w.y = pk2(y[2], y[3]); *(uint2*)(rowp + n * 16) = w; }
                sq += __shfl_xor(sq, 16); sq += __shfl_xor(sq, 32);
                if (fq == 0) ss[(size_t)row * 16 + u.pn * 4 + wc] = sq; }
    }
};

__device__ __forceinline__ int src_col(int n) {
    if (n < 1024) return n; if (n < 1536) return 4112 + (n - 1024); if (n < 2048) return 5136 + (n - 1536); if (n < 3584) return 1024 + (n - 2048);
    if (n < 4096) return 2576 + (n - 3584); if (n < 4608) return 3088 + (n - 4096); if (n < 5120) return 3600 + (n - 4608); return 4624 + (n - 5120);
}
template <int NSUB>
__device__ __forceinline__ void tr_tile(const float* src, int lds_, int col0, int k0, const float* sc, bf16_t* dst, int ldd, int row0, float* tile) {
    const int tid = lt_tid();
    constexpr int W = 64 * NSUB, STR = W + 1;
#pragma unroll
    for (int i = 0; i < 2 * NSUB; ++i) { const int idx = tid + i * 512, k = idx / (W / 4), n4 = idx % (W / 4);
        float4 v = *(const float4*)(src + (size_t)(k0 + k) * lds_ + col0 + n4 * 4); if (sc) { const float f = sc[k0 + k]; v.x *= f; v.y *= f; v.z *= f; v.w *= f; }
        float* tp = tile + k * STR + n4 * 4; tp[0] = v.x; tp[1] = v.y; tp[2] = v.z; tp[3] = v.w; }
    __syncthreads();
#pragma unroll
    for (int i = 0; i < NSUB; ++i) { const int idx = tid + i * 512, n = idx % W, kg = idx / W; const float* tp = tile + (kg * 8) * STR + n;
        uint4 w; w.x = pk2(tp[0], tp[STR]); w.y = pk2(tp[2 * STR], tp[3 * STR]); w.z = pk2(tp[4 * STR], tp[5 * STR]); w.w = pk2(tp[6 * STR], tp[7 * STR]);
        *(uint4*)(dst + (size_t)(row0 + n) * ldd + k0 + kg * 8) = w; }
    __syncthreads();
}

__device__ void s5_tables(CPAR p, int l, int g, int part, unsigned char* shm) {
    float* apre = (float*)shm;
    float* apim = apre + 33 * 64;
    float* bbre = apim + 33 * 64;
    float* bbim = bbre + 1024;
    float* core = bbim + 1024;
    float* coim = core + 64;
    float* cres = coim + 64;
    float* cims = cres + 1024;
    const int tid = lt_tid();
    if (tid < 64) {
        const int pp = tid; const int gi = (l * 32 + g) * 64 + pp;
        const double lr = fmin((double)p.lam_re[gi], -1e-4), li = (double)p.lam_im[gi], st = (double)expf(p.log_step[l * 32 + g]);
        const double xe = lr * st; double mag = 1.0, term = 1.0;
        for (int q = 1; q <= 12; ++q) { term *= xe / (double)q; mag += term; }
        double ang = li * st; ang -= 6.283185307179586476925 * rint(ang / 6.283185307179586476925);
        const double are = mag * (double)cosf((float)ang), aim = mag * (double)sinf((float)ang);
        double pr = 1.0, pi = 0.0;
        for (int j = 0; j <= 32; ++j) { apre[j * 64 + pp] = (float)pr; apim[j * 64 + pp] = (float)pi; const double nr = pr * are - pi * aim, ni = pr * aim + pi * are; pr = nr; pi = ni; }
        const double den = lr * lr + li * li, nre = are - 1.0, nim = aim;
        core[pp] = (float)((nre * lr + nim * li) / den); coim[pp] = (float)((nim * lr - nre * li) / den);
        if (part == 0) { float* aT = p.aT + (l & 1) * 32 * 64 * 2; aT[(g * 64 + pp) * 2 + 0] = apre[32 * 64 + pp]; aT[(g * 64 + pp) * 2 + 1] = apim[32 * 64 + pp]; }
    }
    __syncthreads();
    for (int i = tid; i < 1024; i += 512) { const int pp = i >> 4; const size_t gi = ((size_t)(l * 32 + g) * 64) * 16 + i;
        const float br = p.b_re[gi], bi = p.b_im[gi]; bbre[i] = core[pp] * br - coim[pp] * bi; bbim[i] = core[pp] * bi + coim[pp] * br; }
    __syncthreads();
    for (int i = tid; i < 1024; i += 512) { cres[i] = p.c_re[(size_t)(l * 32 + g) * 1024 + i]; cims[i] = p.c_im[(size_t)(l * 32 + g) * 1024 + i]; }
    __syncthreads();
    const float* cre = cres;
    const float* cim = cims;
    bf16_t* kt = p.ktab + (size_t)(l & 1) * 32 * 8192 + (size_t)g * 8192;
    for (int e = part * 1024 + tid; e < part * 1024 + 1024; e += 512) { const int lag = e >> 8, h = (e >> 4) & 15, h2 = e & 15; float s = 0.f;
        for (int pp = 0; pp < 64; ++pp) { const float cr = cre[h * 64 + pp], ci = cim[h * 64 + pp], ar = apre[lag * 64 + pp], ai = apim[lag * 64 + pp];
            const float car = cr * ar - ci * ai, cai = cr * ai + ci * ar; s += car * bbre[pp * 16 + h2] - cai * bbim[pp * 16 + h2]; }
        kt[e] = (bf16_t)f2bf(s); }
    bf16_t* wo = p.woff + (size_t)(l & 1) * 32 * 65536 + (size_t)g * 65536;
    for (int e = part * 8192 + tid; e < part * 8192 + 8192; e += 512) { const int row = e >> 7, k = e & 127, t = row >> 4, h = row & 15, pp = k & 63;
        const float cr = cre[h * 64 + pp], ci = cim[h * 64 + pp], ar = apre[(t + 1) * 64 + pp], ai = apim[(t + 1) * 64 + pp];
        const float v = (k < 64) ? (cr * ar - ci * ai) : -(cr * ai + ci * ar); wo[e] = (bf16_t)f2bf(v); }
    bf16_t* ws = p.wst + (size_t)(l & 1) * 32 * 65536 + (size_t)g * 65536;
    for (int e = part * 8192 + tid; e < part * 8192 + 8192; e += 512) { const int m = e >> 9, k = e & 511, s = k >> 4, h2 = k & 15, pp = m & 63;
        const float ar = apre[(31 - s) * 64 + pp], ai = apim[(31 - s) * 64 + pp], br = bbre[pp * 16 + h2], bi = bbim[pp * 16 + h2];
        const float v = (m < 64) ? (ar * br - ai * bi) : (ar * bi + ai * br); ws[e] = (bf16_t)f2bf(v); }
    __syncthreads();
}

__device__ __forceinline__ void convert_tile(CPAR p, int l, int t, unsigned char* shm) {
    float* tile = (float*)shm; const int par = l & 1;
    bf16_t* winT = p.winT + (size_t)par * LDP * DM; bf16_t* woutT = p.woutT + (size_t)par * 1024 * 2048; bf16_t* wgluT = p.wgluT + (size_t)par * 1024 * 512;
    if (t < 352) { const int nt = t >> 4, kt = t & 15; tr_tile<4>(p.w_in + (size_t)l * DM * INC, INC, src_col(nt * 256), kt * 64, p.pre_w + l * DM, winT, DM, nt * 256, tile); }
    else if (t < 480) { const int u = t - 352, nt = u >> 5, kt = u & 31, k0 = kt * 64;
        const float* sc = (k0 < 1024) ? (p.ssd_nw + l * 1024) : (k0 < 1536) ? (p.hg_nw + l * 512 - 1024) : (p.s5_nw + l * 512 - 1536);
        tr_tile<4>(p.w_out + (size_t)l * 2048 * DM, DM, nt * 256, k0, sc, woutT, 2048, nt * 256, tile); }
    else { const int u = t - 480, nt = u >> 3, kt = u & 7, row0 = nt * 128, pn = row0 >> 8, half = (row0 >> 7) & 1;
        tr_tile<2>(p.glu_w + (size_t)l * 512 * 1024, 1024, half * 512 + pn * 128, kt * 64, nullptr, wgluT, 512, row0, tile); }
}
__device__ __forceinline__ void convert_item(CPAR p, int l, int it, unsigned char* shm) {
    if (it < 544) convert_tile(p, l, it, shm); else { const int u = it - 544; s5_tables(p, l, u >> 3, u & 7, shm); }
}

__device__ void phase_prep(CPAR p, int l, unsigned char* shm) {
    const int tid = lt_tid(), lane = tid & 63, wv = tid >> 6;
    const int G = gridDim.x, bid = lt_bid();
    if (l == 0) {
        for (int it = bid; it < 800; it += G) convert_item(p, 0, it, shm);
        if (bid == G - 1) {
            const float a0 = p.hg_lb[tid], a1 = p.hg_lb[512 + tid], a2 = p.hg_lb[1024 + tid], a3 = p.hg_lb[1536 + tid];
            const float mx = fmaxf(fmaxf(a0, a1), fmaxf(a2, a3)); const float e0 = expf(a0 - mx), e1 = expf(a1 - mx), e2 = expf(a2 - mx), e3 = expf(a3 - mx), inv = 1.f / (e0 + e1 + e2 + e3);
            p.lb[tid] = 0.f; p.lb[512 + tid] = e1 * inv; p.lb[1024 + tid] = (e1 + e2) * inv; p.lb[1536 + tid] = (e1 + e2 + e3) * inv;
        }
    }
    __syncthreads();
    float* wdt_s = (float*)(shm + 32768);
    if (l < 4) { for (int e = tid; e < 16384; e += 512) { const int k = e >> 4, j = e & 15; wdt_s[j * 1024 + k] = p.w_in[(size_t)l * DM * INC + (size_t)k * INC + 2560 + j] * p.pre_w[l * DM + k]; } }
    __syncthreads();
    float pw[16];
#pragma unroll
    for (int i = 0; i < 4; ++i) { const float4 w = (l > 0) ? *(const float4*)(p.post_w + (l - 1) * DM + i * 256 + lane * 4) : make_float4(0.f, 0.f, 0.f, 0.f); pw[4 * i] = w.x; pw[4 * i + 1] = w.y; pw[4 * i + 2] = w.z; pw[4 * i + 3] = w.w; }
    const int rstep = G * 8; int row = bid * 8 + wv;
    float4 xn[4]; uint2 xq[4], on[4];
#pragma unroll
    for (int i = 0; i < 4; ++i) { xn[i] = make_float4(0.f, 0.f, 0.f, 0.f); xq[i] = make_uint2(0u, 0u); on[i] = make_uint2(0u, 0u); }
    if (row < NTOK) {
        if (l == 0) {
#pragma unroll
            for (int i = 0; i < 4; ++i) xn[i] = *(const float4*)(p.x + (size_t)row * DM + i * 256 + lane * 4);
        } else {
#pragma unroll
            for (int i = 0; i < 4; ++i) { xq[i] = *(const uint2*)(p.xb + (size_t)row * DM + i * 256 + lane * 4); on[i] = *(const uint2*)(p.proj + (size_t)row * LDP + C_O + i * 256 + lane * 4); }
        }
    }
    for (; row < NTOK; row += rstep) {
        float xv[16]; uint2 oc[4];
        if (l == 0) {
#pragma unroll
            for (int i = 0; i < 4; ++i) { xv[4 * i] = xn[i].x; xv[4 * i + 1] = xn[i].y; xv[4 * i + 2] = xn[i].z; xv[4 * i + 3] = xn[i].w; oc[i] = make_uint2(0u, 0u); }
        } else {
#pragma unroll
            for (int i = 0; i < 4; ++i) { xv[4 * i] = bflo(xq[i].x); xv[4 * i + 1] = bfhi(xq[i].x); xv[4 * i + 2] = bflo(xq[i].y); xv[4 * i + 3] = bfhi(xq[i].y); oc[i] = on[i]; }
        }
        if (row + rstep < NTOK) {
            if (l == 0) {
#pragma unroll
                for (int i = 0; i < 4; ++i) xn[i] = *(const float4*)(p.x + (size_t)(row + rstep) * DM + i * 256 + lane * 4);
            } else {
#pragma unroll
                for (int i = 0; i < 4; ++i) { xq[i] = *(const uint2*)(p.xb + (size_t)(row + rstep) * DM + i * 256 + lane * 4); on[i] = *(const uint2*)(p.proj + (size_t)(row + rstep) * LDP + C_O + i * 256 + lane * 4); }
            }
        }
        if (l > 0) {
            float ov[16]; float ss = 0.f;
#pragma unroll
            for (int i = 0; i < 4; ++i) { ov[4 * i] = bflo(oc[i].x); ov[4 * i + 1] = bfhi(oc[i].x); ov[4 * i + 2] = bflo(oc[i].y); ov[4 * i + 3] = bfhi(oc[i].y); }
#pragma unroll
            for (int i = 0; i < 16; ++i) ss += ov[i] * ov[i];
            ss = wave_sum(ss); const float rs = rsqrtf(ss * (1.f / 1024.f) + EPSN);
#pragma unroll
            for (int i = 0; i < 16; ++i) xv[i] += ov[i] * rs * pw[i];
            if (l == 4) {
#pragma unroll
                for (int i = 0; i < 4; ++i) *(float4*)(p.out + (size_t)row * DM + i * 256 + lane * 4) = make_float4(xv[4 * i], xv[4 * i + 1], xv[4 * i + 2], xv[4 * i + 3]);
            }
        }
        if (l < 4) {
            float ss = 0.f;
#pragma unroll
            for (int i = 0; i < 16; ++i) ss += xv[i] * xv[i];
            ss = wave_sum(ss); const float rs = rsqrtf(ss * (1.f / 1024.f) + EPSN);
            if (lane == 0) p.rstd[row] = rs;
#pragma unroll
            for (int i = 0; i < 4; ++i) { uint2 w; w.x = pk2(xv[4 * i], xv[4 * i + 1]); w.y = pk2(xv[4 * i + 2], xv[4 * i + 3]); *(uint2*)(p.xb + (size_t)row * DM + i * 256 + lane * 4) = w; }
            float d[16];
#pragma unroll
            for (int j = 0; j < 16; ++j) { float a = 0.f;
#pragma unroll
                for (int i = 0; i < 4; ++i) { const float4 w = *(const float4*)(wdt_s + j * 1024 + i * 256 + lane * 4); a += xv[4 * i] * w.x + xv[4 * i + 1] * w.y + xv[4 * i + 2] * w.z + xv[4 * i + 3] * w.w; }
                d[j] = a; }
            float e8[8], e4[4], e2[2];
#pragma unroll
            for (int j = 0; j < 8; ++j) { const bool hi = lane & 32; const float mine = hi ? d[j + 8] : d[j], send = hi ? d[j] : d[j + 8]; e8[j] = mine + __shfl_xor(send, 32); }
#pragma unroll
            for (int j = 0; j < 4; ++j) { const bool hi = lane & 16; const float mine = hi ? e8[j + 4] : e8[j], send = hi ? e8[j] : e8[j + 4]; e4[j] = mine + __shfl_xor(send, 16); }
#pragma unroll
            for (int j = 0; j < 2; ++j) { const bool hi = lane & 8; const float mine = hi ? e4[j + 2] : e4[j], send = hi ? e4[j] : e4[j + 2]; e2[j] = mine + __shfl_xor(send, 8); }
            float e1; { const bool hi = lane & 4; const float mine = hi ? e2[1] : e2[0], send = hi ? e2[0] : e2[1]; e1 = mine + __shfl_xor(send, 4); }
            e1 += __shfl_xor(e1, 2); e1 += __shfl_xor(e1, 1);
            if ((lane & 3) == 0) { const int j = ((lane >> 5) & 1) * 8 + ((lane >> 4) & 1) * 4 + ((lane >> 3) & 1) * 2 + ((lane >> 2) & 1); p.dtraw[(size_t)row * 16 + j] = e1 * rs; }
        }
    }
}

#ifndef PH
#define PH 63
#endif
#ifndef TPROBE
#define TPROBE -1
#endif
#if TPROBE >= 0
#ifndef TBLK
#define TBLK 0
#endif
#define TSTAMP(k) do { if (blockIdx.x == TBLK && threadIdx.x == 0) { CPAR _p = *GETP(); unsigned long long* _w = (unsigned long long*)_p.wdt; const unsigned long long _t = wall_clock64(); if ((k) == TPROBE) _w[1] += (_t - _w[0]); _w[0] = _t; } } while (0)
#else
#define TSTAMP(k) do { } while (0)
#endif
#define BAR_LDS() do { asm volatile("s_waitcnt lgkmcnt(0)" ::: "memory"); __builtin_amdgcn_s_barrier(); asm volatile("" ::: "memory"); } while (0)
#define MFMA16(a, b, c) __builtin_amdgcn_mfma_f32_16x16x32_bf16(a, b, c, 0, 0, 0)

__device__ void bcconv_unit(CPAR p, int l, int u) {
    const int tid = lt_tid();
    const int bg = u >> 3, tr = u & 7, b = bg >> 1, g = bg & 1;
    bf16_t* Bn = p.bcb; bf16_t* Cn = Bn + (size_t)32 * 2048 * 128; bf16_t* BT = Cn + (size_t)32 * 2048 * 128;
    const int cp = tid & 63, kind = (tid >> 6) & 1, tgl = tid >> 7;
    const int ch = (kind ? 1280 : 1024) + g * 128 + cp * 2;
    const float* cw = p.conv_w + (size_t)l * 4 * 1536 + ch; const float* cb = p.conv_b + l * 1536 + ch;
    const float w00 = cw[0], w01 = cw[1536], w02 = cw[3072], w03 = cw[4608], w10 = cw[1], w11 = cw[1537], w12 = cw[3073], w13 = cw[4609], b0 = cb[0], b1 = cb[1];
    unsigned raw[2][11];
    { const int t = tr * 256 + tgl * 8; const bf16_t* src = p.proj + ((size_t)b * SEQL + t) * LDP + C_XBC + ch;
#pragma unroll
      for (int j = 0; j < 11; ++j) { unsigned w = 0u; if (t + j - 3 >= 0) w = *(const unsigned*)(src + (ptrdiff_t)(j - 3) * LDP); raw[0][j] = w; } }
#pragma unroll
    for (int it = 0; it < 8; ++it) {
        const int t = tr * 256 + (it * 4 + tgl) * 8;
        if (it < 7) { const int tn = t + 32; const bf16_t* srcn = p.proj + ((size_t)b * SEQL + tn) * LDP + C_XBC + ch;
#pragma unroll
            for (int j = 0; j < 11; ++j) raw[(it + 1) & 1][j] = *(const unsigned*)(srcn + (ptrdiff_t)(j - 3) * LDP); }
        float r0[11], r1[11];
#pragma unroll
        for (int j = 0; j < 11; ++j) { r0[j] = bflo(raw[it & 1][j]); r1[j] = bfhi(raw[it & 1][j]); }
        float o0[8], o1[8];
#pragma unroll
        for (int j = 0; j < 8; ++j) { o0[j] = siluf_(b0 + w00 * r0[j] + w01 * r0[j + 1] + w02 * r0[j + 2] + w03 * r0[j + 3]); o1[j] = siluf_(b1 + w10 * r1[j] + w11 * r1[j + 1] + w12 * r1[j + 2] + w13 * r1[j + 3]); }
        bf16_t* dstn = (kind ? Cn : Bn) + ((size_t)bg * 2048 + t) * 128 + cp * 2;
#pragma unroll
        for (int j = 0; j < 8; ++j) *(unsigned*)(dstn + j * 128) = pk2(o0[j], o1[j]);
        if (!kind) { uint4 q0, q1; q0.x = pk2(o0[0], o0[1]); q0.y = pk2(o0[2], o0[3]); q0.z = pk2(o0[4], o0[5]); q0.w = pk2(o0[6], o0[7]);
            q1.x = pk2(o1[0], o1[1]); q1.y = pk2(o1[2], o1[3]); q1.z = pk2(o1[4], o1[5]); q1.w = pk2(o1[6], o1[7]);
            *(uint4*)(BT + ((size_t)bg * 128 + cp * 2) * 2048 + t) = q0; *(uint4*)(BT + ((size_t)bg * 128 + cp * 2 + 1) * 2048 + t) = q1; }
    }
}

__device__ void ssd_unit(CPAR p, int l, int b, int hd, unsigned char* shm) {
    const int tid = lt_tid(), lane = tid & 63, wv = __builtin_amdgcn_readfirstlane(tid >> 6), quad = lane >> 4, l15 = lane & 15;
    constexpr int OSET = 64 * 136 * 2 + 128 * 72 + 64 * 72;
    bf16_t* OB = (bf16_t*)shm;
    bf16_t* Ls = OB + 2 * OSET;
    bf16_t* Ss = Ls + 64 * 72;
    bf16_t* Yw = Ss + 64 * 136;
    float* dtb = (float*)(Yw + 64 * 72);
    const int g = hd >> 3, bg = b * 2 + g;
    const float a = -expf(p.a_log[l * 16 + hd]), dbias = p.dt_bias[l * 16 + hd], dsk = p.ssd_d[l * 16 + hd];
    for (int i = tid; i < 64 * 136 / 2; i += 512) ((unsigned*)Ss)[i] = 0u;
    const size_t row_base = (size_t)b * SEQL;
    const bf16_t* Bn = p.bcb + (size_t)bg * 2048 * 128; const bf16_t* Cn = Bn + (size_t)32 * 2048 * 128; const bf16_t* BT = p.bcb + (size_t)2 * 32 * 2048 * 128 + (size_t)bg * 128 * 2048;
#define SSD_SCAN(DST) do { float* _d = (DST); const float v = dtr + dbias; const float dt = v > 20.f ? v : __logf(1.f + __expf(v)); float da = dt * a; \
        _Pragma("unroll") for (int o = 1; o < 64; o <<= 1) { const float n = __shfl_up(da, o); if (lane >= o) da += n; } \
        const float al = __shfl(da, 63); _d[lane] = dt; _d[64 + lane] = da; _d[128 + lane] = dt * __expf(al - da); _d[192 + lane] = __expf(da); } while (0)
    if (wv < 4) {
        const int st = tid;
        const int xcp = st & 31, xtg = st >> 5, xch = hd * 64 + xcp * 2;
        const float* cw = p.conv_w + (size_t)l * 4 * 1536 + xch; const float* cb = p.conv_b + l * 1536 + xch;
        const float w00 = cw[0], w01 = cw[1536], w02 = cw[3072], w03 = cw[4608], w10 = cw[1], w11 = cw[1537], w12 = cw[3073], w13 = cw[4609], b0 = cb[0], b1 = cb[1];
        const bf16_t* xsrc = p.proj + (row_base + xtg * 8) * LDP + C_XBC + xch;
        uint4 pb0, pb1, pb2, pb3, pc0, pc1, pc2, pc3, pt0, pt1, pt2, pt3; unsigned xr[11]; float dtr = 0.f;
#define SSD_LD1(I, PB, PC, T0) do { const int q = st + (I) * 256; PB = *(const uint4*)(Bn + (size_t)(T0) * 128 + q * 8); PC = *(const uint4*)(Cn + (size_t)(T0) * 128 + q * 8); } while (0)
#define SSD_LDT(I, PT, T0) do { const int q = st + (I) * 256; PT = *(const uint4*)(BT + (size_t)(q >> 3) * 2048 + (T0) + (q & 7) * 8); } while (0)
#define SSD_LOAD_T(T0) do { SSD_LDT(0, pt0, T0); SSD_LDT(1, pt1, T0); SSD_LDT(2, pt2, T0); SSD_LDT(3, pt3, T0); } while (0)
#define SSD_LOAD(T0) do { SSD_LD1(0, pb0, pc0, T0); SSD_LD1(1, pb1, pc1, T0); SSD_LD1(2, pb2, pc2, T0); SSD_LD1(3, pb3, pc3, T0); \
            xr[0] = ((T0) + xtg * 8 - 3 >= 0) ? *(const unsigned*)(xsrc + ((ptrdiff_t)(T0) - 3) * LDP) : 0u; \
            xr[1] = ((T0) + xtg * 8 - 2 >= 0) ? *(const unsigned*)(xsrc + ((ptrdiff_t)(T0) - 2) * LDP) : 0u; \
            xr[2] = ((T0) + xtg * 8 - 1 >= 0) ? *(const unsigned*)(xsrc + ((ptrdiff_t)(T0) - 1) * LDP) : 0u; \
            xr[3] = *(const unsigned*)(xsrc + ((ptrdiff_t)(T0) + 0) * LDP); xr[4] = *(const unsigned*)(xsrc + ((ptrdiff_t)(T0) + 1) * LDP); \
            xr[5] = *(const unsigned*)(xsrc + ((ptrdiff_t)(T0) + 2) * LDP); xr[6] = *(const unsigned*)(xsrc + ((ptrdiff_t)(T0) + 3) * LDP); \
            xr[7] = *(const unsigned*)(xsrc + ((ptrdiff_t)(T0) + 4) * LDP); xr[8] = *(const unsigned*)(xsrc + ((ptrdiff_t)(T0) + 5) * LDP); \
            xr[9] = *(const unsigned*)(xsrc + ((ptrdiff_t)(T0) + 6) * LDP); xr[10] = *(const unsigned*)(xsrc + ((ptrdiff_t)(T0) + 7) * LDP); \
            if (wv == 0) dtr = p.dtraw[(row_base + (T0) + lane) * 16 + hd]; } while (0)
#define SSD_CB1(I, PB, PC, SET) do { const int q = st + (I) * 256; const int row = q >> 4, c16 = q & 15; *(uint4*)((SET) + row * 136 + c16 * 8) = PC; *(uint4*)((SET) + 64 * 136 + row * 136 + c16 * 8) = PB; } while (0)
#define SSD_PART1(SET) do { bf16_t* _s = (SET); SSD_CB1(0, pb0, pc0, _s); SSD_CB1(1, pb1, pc1, _s); SSD_CB1(2, pb2, pc2, _s); SSD_CB1(3, pb3, pc3, _s); \
            float o0[8], o1[8]; \
            _Pragma("unroll") for (int j = 0; j < 8; ++j) { o0[j] = siluf_(b0 + w00 * bflo(xr[j]) + w01 * bflo(xr[j + 1]) + w02 * bflo(xr[j + 2]) + w03 * bflo(xr[j + 3])); o1[j] = siluf_(b1 + w10 * bfhi(xr[j]) + w11 * bfhi(xr[j + 1]) + w12 * bfhi(xr[j + 2]) + w13 * bfhi(xr[j + 3])); } \
            uint4 q0, q1; q0.x = pk2(o0[0], o0[1]); q0.y = pk2(o0[2], o0[3]); q0.z = pk2(o0[4], o0[5]); q0.w = pk2(o0[6], o0[7]); \
            q1.x = pk2(o1[0], o1[1]); q1.y = pk2(o1[2], o1[3]); q1.z = pk2(o1[4], o1[5]); q1.w = pk2(o1[6], o1[7]); \
            bf16_t* _xt = _s + 2 * 64 * 136 + 128 * 72; *(uint4*)(_xt + (xcp * 2) * 72 + xtg * 8) = q0; *(uint4*)(_xt + (xcp * 2 + 1) * 72 + xtg * 8) = q1; } while (0)
#define SSD_BT1(I, PT, SET, SCV) do { const int q = st + (I) * 256; const int n = q >> 3, tg = q & 7; const float* sv = (SCV) + tg * 8; uint4 r; \
            r.x = pk2(bflo(PT.x) * sv[0], bfhi(PT.x) * sv[1]); r.y = pk2(bflo(PT.y) * sv[2], bfhi(PT.y) * sv[3]); r.z = pk2(bflo(PT.z) * sv[4], bfhi(PT.z) * sv[5]); r.w = pk2(bflo(PT.w) * sv[6], bfhi(PT.w) * sv[7]); \
            *(uint4*)((SET) + 2 * 64 * 136 + n * 72 + tg * 8) = r; } while (0)
#define SSD_PART2(SET, SCV) do { bf16_t* _s = (SET); const float* _v = (SCV); SSD_BT1(0, pt0, _s, _v); SSD_BT1(1, pt1, _s, _v); SSD_BT1(2, pt2, _s, _v); SSD_BT1(3, pt3, _s, _v); } while (0)
        SSD_LOAD(0); SSD_LOAD_T(0);
        if (wv == 0) SSD_SCAN(dtb);
        SSD_PART1(OB);
        SSD_LOAD(64);
        BAR_LDS();
        SSD_PART2(OB, dtb + 128);
        SSD_LOAD_T(64);
        BAR_LDS();
        for (int c = 0; c < 32; ++c) {
            bf16_t* nset = OB + ((c + 1) & 1) * OSET; float* ndt = dtb + ((c + 1) & 1) * 256;
            if (c < 31) { if (wv == 0) SSD_SCAN(ndt); SSD_PART1(nset); if (c < 30) SSD_LOAD((c + 2) * 64); }
            BAR_LDS();
            if (c < 31) { SSD_PART2(nset, ndt + 128); if (c < 30) SSD_LOAD_T((c + 2) * 64); }
            BAR_LDS();
        }
#undef SSD_LD1
#undef SSD_LDT
#undef SSD_LOAD_T
#undef SSD_LOAD
#undef SSD_CB1
#undef SSD_PART1
#undef SSD_BT1
#undef SSD_PART2
    } else {
        const int mt = wv - 4;
        f32x4 accS[8];
#pragma unroll
        for (int i = 0; i < 8; ++i) accS[i] = (f32x4){0.f, 0.f, 0.f, 0.f};
        const int orow = mt * 16 + (lane >> 2), ocol = (lane & 3) * 16;
        bf16_t* zbase = p.proj + (row_base + orow) * LDP + C_Z + hd * 64 + ocol;
        uint4 zc0, zc1;
        BAR_LDS();
        zc0 = *(const uint4*)zbase; zc1 = *(const uint4*)(zbase + 8);
        BAR_LDS();
        for (int c = 0; c < 32; ++c) {
            const int t0 = c * 64;
            const bf16_t* Cs = OB + (c & 1) * OSET; const bf16_t* Bs = Cs + 64 * 136; const bf16_t* BscT = Bs + 64 * 136; const bf16_t* XT = BscT + 128 * 72;
            const float* dtv = dtb + (c & 1) * 256; const float* acum = dtv + 64; const float* eav = dtv + 192;
            f32x4 accY[4], accT[4];
#pragma unroll
            for (int i = 0; i < 4; ++i) { accY[i] = (f32x4){0.f, 0.f, 0.f, 0.f}; accT[i] = (f32x4){0.f, 0.f, 0.f, 0.f}; }
            { const bf16_t* ap = Cs + (mt * 16 + l15) * 136 + quad * 8; const bf16_t* bp = Bs + l15 * 136 + quad * 8; const bf16_t* sp = Ss + l15 * 136 + quad * 8;
              bf16x8 fa[2], fb[2][4], fs[2][4];
              fa[0] = *(const bf16x8*)ap;
#pragma unroll
              for (int nt = 0; nt < 4; ++nt) { fb[0][nt] = *(const bf16x8*)(bp + nt * 16 * 136); fs[0][nt] = *(const bf16x8*)(sp + nt * 16 * 136); }
#pragma unroll
              for (int ks = 0; ks < 4; ++ks) { const int cur = ks & 1, nxt = cur ^ 1;
                  if (ks < 3) { fa[nxt] = *(const bf16x8*)(ap + (ks + 1) * 32);
#pragma unroll
                      for (int nt = 0; nt < 4; ++nt) { fb[nxt][nt] = *(const bf16x8*)(bp + nt * 16 * 136 + (ks + 1) * 32); fs[nxt][nt] = *(const bf16x8*)(sp + nt * 16 * 136 + (ks + 1) * 32); } }
                  __builtin_amdgcn_sched_barrier(0);
#pragma unroll
                  for (int nt = 0; nt < 4; ++nt) { accT[nt] = MFMA16(fa[cur], fb[cur][nt], accT[nt]); accY[nt] = MFMA16(fa[cur], fs[cur][nt], accY[nt]); }
                  __builtin_amdgcn_sched_barrier(0); } }
#pragma unroll
            for (int nt = 0; nt < 4; ++nt) { const int scol = nt * 16 + l15; const float as = acum[scol], ds = dtv[scol];
#pragma unroll
                for (int j = 0; j < 4; ++j) { const int lrow = mt * 16 + quad * 4 + j; const float v = (scol <= lrow) ? accT[nt][j] * __expf(acum[lrow] - as) * ds : 0.f; Ls[lrow * 72 + scol] = (bf16_t)f2bf(v); accY[nt][j] *= eav[lrow]; } }
            BAR_LDS();
            mma_lds_n<4, 64>(Ls + mt * 16 * 72, 72, XT, 72, 16 * 72, accY, lane);
#pragma unroll
            for (int nt = 0; nt < 4; ++nt) { const int pcol = nt * 16 + l15;
#pragma unroll
                for (int j = 0; j < 4; ++j) { const int lrow = mt * 16 + quad * 4 + j; Yw[lrow * 72 + pcol] = (bf16_t)f2bf(accY[nt][j] + dsk * bf2f(XT[pcol * 72 + lrow])); } }
            { const float cdec = __expf(acum[63]);
#pragma unroll
              for (int i = 0; i < 8; ++i) accS[i] *= cdec;
              mma_lds_n<8, 64>(XT + mt * 16 * 72, 72, BscT, 72, 16 * 72, accS, lane);
#pragma unroll
              for (int i = 0; i < 8; ++i)
#pragma unroll
                  for (int j = 0; j < 4; ++j) Ss[(mt * 16 + quad * 4 + j) * 136 + i * 16 + l15] = (bf16_t)f2bf(accS[i][j]); }
            { const uint4 y0 = *(const uint4*)(Yw + orow * 72 + ocol), y1 = *(const uint4*)(Yw + orow * 72 + ocol + 8); float sq = 0.f; uint4 r0, r1;
#define SSD_OUT(DST, YW, ZW) do { const float z0 = bflo(ZW), z1 = bfhi(ZW); const float v0 = bflo(YW) * z0 * __builtin_amdgcn_rcpf(1.f + __expf(-z0)), v1 = bfhi(YW) * z1 * __builtin_amdgcn_rcpf(1.f + __expf(-z1)); sq += v0 * v0 + v1 * v1; DST = pk2(v0, v1); } while (0)
              SSD_OUT(r0.x, y0.x, zc0.x); SSD_OUT(r0.y, y0.y, zc0.y); SSD_OUT(r0.z, y0.z, zc0.z); SSD_OUT(r0.w, y0.w, zc0.w);
              SSD_OUT(r1.x, y1.x, zc1.x); SSD_OUT(r1.y, y1.y, zc1.y); SSD_OUT(r1.z, y1.z, zc1.z); SSD_OUT(r1.w, y1.w, zc1.w);
#undef SSD_OUT
              sq += __shfl_xor(sq, 1); sq += __shfl_xor(sq, 2);
              if ((lane & 3) == 0) *(float2*)(p.ss_ssd + (row_base + t0 + orow) * 32 + hd * 2) = make_float2(sq, 0.f);
              bf16_t* zp = zbase + (size_t)t0 * LDP; *(uint4*)zp = r0; *(uint4*)(zp + 8) = r1;
              if (c < 31) { zc0 = *(const uint4*)(zp + (size_t)64 * LDP); zc1 = *(const uint4*)(zp + (size_t)64 * LDP + 8); } }
            BAR_LDS();
        }
    }
#undef SSD_SCAN
    __syncthreads();
}

__device__ void hgrn_unit(CPAR p, int l, int b, int head, int vh, unsigned char* shm) {
    const int tid = lt_tid(), lane = tid & 63, wv = tid >> 6, quad = lane >> 4, l15 = lane & 15;
    bf16_t* Qm = (bf16_t*)shm;
    bf16_t* Km = Qm + 64 * 136;
    bf16_t* Qs = Km + 64 * 136;
    bf16_t* KhT = Qs + 64 * 136;
    bf16_t* VT = KhT + 128 * 72;
    bf16_t* At = VT + 64 * 72;
    bf16_t* Ob = At + 64 * 72;
    bf16_t* ST = Ob + 64 * 72;
    float* dec = (float*)(ST + 64 * 136);
    float* seg = dec + 128;
    for (int i = tid; i < 64 * 136 / 2; i += 512) ((unsigned*)ST)[i] = 0u;
    f32x4 accS[4];
#pragma unroll
    for (int i = 0; i < 4; ++i) accS[i] = (f32x4){0.f, 0.f, 0.f, 0.f};
    const int kp = tid & 63, lq = tid >> 6, k0 = 2 * kp, vp = tid & 31, vl = tid >> 5, orow = (wv >> 1) * 16 + (lane >> 2), oc8 = (wv & 1) * 4 + (lane & 3);
    const float lb0 = p.lb[l * 512 + head * 128 + k0], lb1 = p.lb[l * 512 + head * 128 + k0 + 1], om0 = 1.f - lb0, om1 = 1.f - lb1;
    const size_t row_base = (size_t)b * SEQL;
    const bf16_t* qbase = p.proj + (row_base + lq * 8) * LDP + C_Q + head * 128 + k0;
    const bf16_t* vbase = p.proj + (row_base + vl * 4) * LDP + C_I + head * 128 + vh * 64 + 2 * vp;
    bf16_t* gbase = p.proj + (row_base + orow) * LDP + C_G + head * 128 + vh * 64 + oc8 * 8;
    unsigned qr[8], fr[8], vr[4]; uint4 gr;
#pragma unroll
    for (int i = 0; i < 8; ++i) { qr[i] = *(const unsigned*)(qbase + (size_t)i * LDP); fr[i] = *(const unsigned*)(qbase + (size_t)i * LDP + (C_F - C_Q)); }
#pragma unroll
    for (int i = 0; i < 4; ++i) vr[i] = *(const unsigned*)(vbase + (size_t)i * LDP);
    gr = *(const uint4*)gbase;
    for (int c = 0; c < 32; ++c) {
        const int t0 = c * 64;
        float qv0[8], qv1[8], P0[8], P1[8], kk0[8], kk1[8];
#pragma unroll
        for (int i = 0; i < 8; ++i) { const float q0 = bflo(qr[i]), q1 = bfhi(qr[i]), f0 = fmaxf(bflo(fr[i]), -80.f), f1 = fmaxf(bfhi(fr[i]), -80.f);
            const float fv0 = lb0 + om0 * __builtin_amdgcn_rcpf(1.f + __expf(-f0)), fv1 = lb1 + om1 * __builtin_amdgcn_rcpf(1.f + __expf(-f1));
            P0[i] = fv0; P1[i] = fv1; kk0[i] = 1.f - fv0; kk1[i] = 1.f - fv1;
            qv0[i] = q0 * __builtin_amdgcn_rcpf(1.f + __expf(-q0)); qv1[i] = q1 * __builtin_amdgcn_rcpf(1.f + __expf(-q1)); }
        P0[0] = fmaxf(P0[0], 1e-37f); P1[0] = fmaxf(P1[0], 1e-37f);
#pragma unroll
        for (int i = 1; i < 8; ++i) { P0[i] = fmaxf(P0[i] * P0[i - 1], 1e-37f); P1[i] = fmaxf(P1[i] * P1[i - 1], 1e-37f); }
        const float lfl0 = __logf(P0[7]), lfl1 = __logf(P1[7]);
        *(float2*)(seg + lq * 128 + k0) = make_float2(lfl0, lfl1);
        const unsigned v0 = vr[0], v1 = vr[1], v2 = vr[2], v3 = vr[3]; const uint4 gcur = gr;
        if (c < 31) {
            const size_t adv = (size_t)(t0 + 64) * LDP;
#pragma unroll
            for (int i = 0; i < 8; ++i) { qr[i] = *(const unsigned*)(qbase + adv + (size_t)i * LDP); fr[i] = *(const unsigned*)(qbase + adv + (size_t)i * LDP + (C_F - C_Q)); }
#pragma unroll
            for (int i = 0; i < 4; ++i) vr[i] = *(const unsigned*)(vbase + adv + (size_t)i * LDP);
            gr = *(const uint4*)(gbase + adv);
        }
        BAR_LDS();
        float off0 = 0.f, off1 = 0.f, tot0 = 0.f, tot1 = 0.f, mid0 = 0.f, mid1 = 0.f;
#pragma unroll
        for (int j = 0; j < 8; ++j) { const float2 s = *(const float2*)(seg + j * 128 + k0); if (j < lq) { off0 += s.x; off1 += s.y; } if (j < 4) { mid0 += s.x; mid1 += s.y; } tot0 += s.x; tot1 += s.y; }
        const float emid0 = __expf(mid0), emid1 = __expf(mid1), etm0 = __expf(tot0 - mid0), etm1 = __expf(tot1 - mid1);
        float kh0[8], kh1[8];
        const float a0 = off0 - mid0, a1 = off1 - mid1;
        if (fabsf(a0) <= 80.f && fabsf(a0 + lfl0) <= 80.f && fabsf(a1) <= 80.f && fabsf(a1 + lfl1) <= 80.f) {
            const float E0 = __expf(a0), E1 = __expf(a1);
            float r0 = __builtin_amdgcn_rcpf(E0 * P0[7]), r1 = __builtin_amdgcn_rcpf(E1 * P1[7]);
#pragma unroll
            for (int i = 7; i >= 0; --i) { const int lrow = lq * 8 + i; const float e0 = E0 * P0[i], e1 = E1 * P1[i];
                const float qm0 = qv0[i] * e0, qm1 = qv1[i] * e1, km0 = kk0[i] * r0, km1 = kk1[i] * r1;
                kh0[i] = km0 * etm0; kh1[i] = km1 * etm1;
                *(unsigned*)(Qm + lrow * 136 + k0) = pk2(qm0, qm1); *(unsigned*)(Km + lrow * 136 + k0) = pk2(km0, km1); *(unsigned*)(Qs + lrow * 136 + k0) = pk2(qm0 * emid0, qm1 * emid1);
                r0 *= (1.f - kk0[i]); r1 *= (1.f - kk1[i]); }
        } else {
#pragma unroll
            for (int i = 0; i < 8; ++i) { const int lrow = lq * 8 + i; const float cum0 = off0 + __logf(P0[i]), cum1 = off1 + __logf(P1[i]), d0 = cum0 - mid0, d1 = cum1 - mid1;
                const float qm0 = qv0[i] * __expf(fminf(fmaxf(d0, -80.f), 80.f)), km0 = kk0[i] * __expf(fminf(fmaxf(-d0, -80.f), 80.f)), qs0 = qv0[i] * __expf(cum0);
                const float qm1 = qv1[i] * __expf(fminf(fmaxf(d1, -80.f), 80.f)), km1 = kk1[i] * __expf(fminf(fmaxf(-d1, -80.f), 80.f)), qs1 = qv1[i] * __expf(cum1);
                kh0[i] = kk0[i] * __expf(tot0 - cum0); kh1[i] = kk1[i] * __expf(tot1 - cum1);
                *(unsigned*)(Qm + lrow * 136 + k0) = pk2(qm0, qm1); *(unsigned*)(Km + lrow * 136 + k0) = pk2(km0, km1); *(unsigned*)(Qs + lrow * 136 + k0) = pk2(qs0, qs1); }
        }
        { uint4 q0, q1; q0.x = pk2(kh0[0], kh0[1]); q0.y = pk2(kh0[2], kh0[3]); q0.z = pk2(kh0[4], kh0[5]); q0.w = pk2(kh0[6], kh0[7]);
          q1.x = pk2(kh1[0], kh1[1]); q1.y = pk2(kh1[2], kh1[3]); q1.z = pk2(kh1[4], kh1[5]); q1.w = pk2(kh1[6], kh1[7]);
          *(uint4*)(KhT + k0 * 72 + lq * 8) = q0; *(uint4*)(KhT + (k0 + 1) * 72 + lq * 8) = q1; }
        if (lq == 0) *(float2*)(dec + k0) = make_float2(__expf(tot0), __expf(tot1));
        { uint2 a, bq; a.x = (v0 & 0xffffu) | (v1 << 16); a.y = (v2 & 0xffffu) | (v3 << 16); bq.x = (v0 >> 16) | (v1 & 0xffff0000u); bq.y = (v2 >> 16) | (v3 & 0xffff0000u);
          *(uint2*)(VT + (2 * vp) * 72 + vl * 4) = a; *(uint2*)(VT + (2 * vp + 1) * 72 + vl * 4) = bq; }
        BAR_LDS();
        const int mt = wv >> 1, vtb = (wv & 1) * 2;
        f32x4 accO[2], accA[2];
#pragma unroll
        for (int i = 0; i < 2; ++i) { accO[i] = (f32x4){0.f, 0.f, 0.f, 0.f}; accA[i] = (f32x4){0.f, 0.f, 0.f, 0.f}; }
        mma_lds_s<2, 128>(Qm + mt * 16 * 136, 136, Km + vtb * 16 * 136, 136, 16 * 136, accA, lane);
        mma_lds_s<2, 128>(Qs + mt * 16 * 136, 136, ST + vtb * 16 * 136, 136, 16 * 136, accO, lane);
#pragma unroll
        for (int i = 0; i < 2; ++i) { const int scol = (vtb + i) * 16 + l15;
#pragma unroll
            for (int j = 0; j < 4; ++j) { const int lrow = mt * 16 + quad * 4 + j; At[lrow * 72 + scol] = (bf16_t)f2bf(scol <= lrow ? accA[i][j] : 0.f); } }
        BAR_LDS();
        mma_lds_s<2, 64>(At + mt * 16 * 72, 72, VT + vtb * 16 * 72, 72, 16 * 72, accO, lane);
#pragma unroll
        for (int i = 0; i < 2; ++i) { const int nt = vtb + i;
#pragma unroll
            for (int j = 0; j < 4; ++j) Ob[(mt * 16 + quad * 4 + j) * 72 + nt * 16 + l15] = (bf16_t)f2bf(accO[i][j]); }
        const int vts = wv & 3;
#pragma unroll
        for (int i = 0; i < 4; ++i) accS[i] *= dec[((wv >> 2) * 4 + i) * 16 + l15];
        mma_lds_s<4, 64>(VT + vts * 16 * 72, 72, KhT + (wv >> 2) * 4 * 16 * 72, 72, 16 * 72, accS, lane);
#pragma unroll
        for (int i = 0; i < 4; ++i) { const int ktile = (wv >> 2) * 4 + i;
#pragma unroll
            for (int j = 0; j < 4; ++j) ST[(vts * 16 + quad * 4 + j) * 136 + ktile * 16 + l15] = (bf16_t)f2bf(accS[i][j]); }
        { const uint4 ow = *(const uint4*)(Ob + orow * 72 + oc8 * 8); const unsigned ou[4] = {ow.x, ow.y, ow.z, ow.w}, gu[4] = {gcur.x, gcur.y, gcur.z, gcur.w}; unsigned res[4]; float sq = 0.f;
#pragma unroll
          for (int i = 0; i < 4; ++i) { const float o0 = bflo(ou[i]), o1 = bfhi(ou[i]), g0 = bflo(gu[i]), g1 = bfhi(gu[i]); sq += o0 * o0 + o1 * o1;
              res[i] = pk2(o0 * g0 * __builtin_amdgcn_rcpf(1.f + __expf(-g0)), o1 * g1 * __builtin_amdgcn_rcpf(1.f + __expf(-g1))); }
          sq += __shfl_xor(sq, 1); sq += __shfl_xor(sq, 2);
          if ((lane & 3) == 0) p.ss_hg[(row_base + t0 + orow) * 16 + head * 4 + vh * 2 + (wv & 1)] = sq;
          *(uint4*)(gbase + (size_t)t0 * LDP) = make_uint4(res[0], res[1], res[2], res[3]); }
    }
    __syncthreads();
}

__device__ void s5_unit(CPAR p, int l, int g, int b, unsigned char* shm) {
    const int tid = lt_tid(), lane = tid & 63, wv = tid >> 6, quad = lane >> 4, l15 = lane & 15;
    bf16_t* U = (bf16_t*)shm;
    float* St = (float*)(shm + 66560);
    bf16_t* Sin = (bf16_t*)(shm + 66560 + 33280);
    const size_t row_base = (size_t)b * SEQL;
    for (int i = tid; i < 4096; i += 512) { const int tok = i >> 1, hf = i & 1; const uint4 v = *(const uint4*)(p.proj + (row_base + tok) * LDP + C_U + g * 16 + hf * 8);
        *(uint4*)(U + (tok >> 5) * 520 + (tok & 31) * 16 + hf * 8) = v; }
    __syncthreads();
    {
        f32x4 acc[4];
#pragma unroll
        for (int n = 0; n < 4; ++n) acc[n] = (f32x4){0.f, 0.f, 0.f, 0.f};
        const bf16_t* ap = p.wst + (size_t)(l & 1) * 32 * 65536 + (size_t)g * 65536 + (wv * 16 + l15) * 512 + quad * 8;
        bf16x8 af[16];
#pragma unroll
        for (int ks = 0; ks < 16; ++ks) af[ks] = *(const bf16x8*)(ap + ks * 32);
        const bf16_t* ub = U + l15 * 520 + quad * 8;
        bf16x8 fb[2][4];
#pragma unroll
        for (int n = 0; n < 4; ++n) fb[0][n] = *(const bf16x8*)(ub + n * 16 * 520);
#pragma unroll
        for (int ks = 0; ks < 16; ++ks) { const int cur = ks & 1, nxt = cur ^ 1;
            if (ks < 15) {
#pragma unroll
                for (int n = 0; n < 4; ++n) fb[nxt][n] = *(const bf16x8*)(ub + n * 16 * 520 + (ks + 1) * 32); }
            __builtin_amdgcn_sched_barrier(0);
#pragma unroll
            for (int n = 0; n < 4; ++n) acc[n] = MFMA16(af[ks], fb[cur][n], acc[n]);
            __builtin_amdgcn_sched_barrier(0); }
#pragma unroll
        for (int n = 0; n < 4; ++n)
#pragma unroll
            for (int j = 0; j < 4; ++j) St[(wv * 16 + quad * 4 + j) * 65 + n * 16 + l15] = acc[n][j];
    }
    __syncthreads();
    if (tid < 64) { const float* aT = p.aT + (l & 1) * 32 * 64 * 2; const float ar = aT[(g * 64 + tid) * 2], ai = aT[(g * 64 + tid) * 2 + 1]; float sr = 0.f, si = 0.f;
#pragma unroll 8
        for (int c = 0; c < 64; ++c) { Sin[c * 136 + tid] = (bf16_t)f2bf(sr); Sin[c * 136 + 64 + tid] = (bf16_t)f2bf(si);
            const float lr = St[tid * 65 + c], li = St[(64 + tid) * 65 + c]; const float nr = ar * sr - ai * si + lr, ni = ar * si + ai * sr + li; sr = nr; si = ni; } }
    __syncthreads();
    bf16_t* Kt = (bf16_t*)St;
    { const uint4* ksrc = (const uint4*)(p.ktab + (size_t)(l & 1) * 32 * 8192 + (size_t)g * 8192); uint4* kdst = (uint4*)Kt; kdst[tid] = ksrc[tid]; kdst[tid + 512] = ksrc[tid + 512]; }
    __syncthreads();
    const float4 dsk = *(const float4*)(p.s5_d + l * 512 + g * 16 + quad * 4);
    for (int it = 0; it < 4; ++it) {
        const int t = (it & 1) ? (8 * it + 7 - wv) : (8 * it + wv);
        f32x4 acc[4];
#pragma unroll
        for (int n = 0; n < 4; ++n) acc[n] = (f32x4){0.f, 0.f, 0.f, 0.f};
        const bf16_t* wp = p.woff + (size_t)(l & 1) * 32 * 65536 + (size_t)g * 65536 + (t * 16 + l15) * 128 + quad * 8;
        bf16x8 wf[4];
#pragma unroll
        for (int ks = 0; ks < 4; ++ks) wf[ks] = *(const bf16x8*)(wp + ks * 32);
        const bf16_t* kt = Kt + l15 * 16 + (quad & 1) * 8;
        {
            const bf16_t* ub = U + l15 * 520 + quad * 8; const int jmax = t >> 1; const bf16x8 zf = (bf16x8){0, 0, 0, 0, 0, 0, 0, 0};
            bf16x8 ac, an = zf, bc[4], bn[4];
            { const int lag = t - (quad >> 1); ac = zf; if (lag >= 0) ac = *(const bf16x8*)(kt + lag * 256); }
#pragma unroll
            for (int n = 0; n < 4; ++n) { bc[n] = *(const bf16x8*)(ub + n * 16 * 520); bn[n] = zf; }
            for (int j = 0; j <= jmax; ++j) {
                if (j < jmax) { const int lag = t - 2 * (j + 1) - (quad >> 1); an = zf; if (lag >= 0) an = *(const bf16x8*)(kt + lag * 256);
#pragma unroll
                    for (int n = 0; n < 4; ++n) bn[n] = *(const bf16x8*)(ub + n * 16 * 520 + (j + 1) * 32); }
                __builtin_amdgcn_sched_barrier(0);
#pragma unroll
                for (int n = 0; n < 4; ++n) acc[n] = MFMA16(ac, bc[n], acc[n]);
                __builtin_amdgcn_sched_barrier(0);
                ac = an;
#pragma unroll
                for (int n = 0; n < 4; ++n) bc[n] = bn[n]; }
        }
        {
            const bf16_t* sb = Sin + l15 * 136 + quad * 8;
            bf16x8 fb[2][4];
#pragma unroll
            for (int n = 0; n < 4; ++n) fb[0][n] = *(const bf16x8*)(sb + n * 16 * 136);
#pragma unroll
            for (int ks = 0; ks < 4; ++ks) { const int cur = ks & 1, nxt = cur ^ 1;
                if (ks < 3) {
#pragma unroll
                    for (int n = 0; n < 4; ++n) fb[nxt][n] = *(const bf16x8*)(sb + n * 16 * 136 + (ks + 1) * 32); }
                __builtin_amdgcn_sched_barrier(0);
#pragma unroll
                for (int n = 0; n < 4; ++n) acc[n] = MFMA16(wf[ks], fb[cur][n], acc[n]);
                __builtin_amdgcn_sched_barrier(0); }
        }
#pragma unroll
        for (int n = 0; n < 4; ++n) { const int c = n * 16 + l15; const uint2 uw = *(const uint2*)(U + c * 520 + t * 16 + quad * 4);
            float y[4] = {acc[n][0] + dsk.x * bflo(uw.x), acc[n][1] + dsk.y * bfhi(uw.x), acc[n][2] + dsk.z * bflo(uw.y), acc[n][3] + dsk.w * bfhi(uw.y)};
#pragma unroll
            for (int j = 0; j < 4; ++j) { const float z = 0.7978845608f * (y[j] + 0.044715f * y[j] * y[j] * y[j]); const float th = 1.f - 2.f / (__expf(2.f * z) + 1.f); y[j] = 0.5f * y[j] * (1.f + th); }
            uint2 w; w.x = pk2(y[0], y[1]); w.y = pk2(y[2], y[3]);
            *(uint2*)(p.proj + (row_base + c * 32 + t) * LDP + C_U + g * 16 + quad * 4) = w; }
    }
    __syncthreads();
}

__device__ void phase_mixA(CPAR p, int l, unsigned char* shm) {
    const int G = gridDim.x, bid = lt_bid(), tid = lt_tid();
    for (int u = bid; u < 128; u += G) { const int pi = (u & 7) * 8 + (u >> 4), vh = (u >> 3) & 1;
        hgrn_unit(p, l, pi >> 2, pi & 3, vh, shm); }
    TSTAMP(7);
    const int total = (l < 3) ? 1568 : 768;
    int* slot = (int*)(shm + 131072);
    for (;;) {
        if (tid == 0) *slot = (int)atomicAdd(p.wq + l * 64, 1u);
        __syncthreads();
        const int it = *slot;
        __syncthreads();
        if (it >= total) break;
        if (it < 512) s5_unit(p, l, it >> 4, it & 15, shm);
        else if (it < 768) bcconv_unit(p, l, it - 512);
        else convert_item(p, l + 1, it - 768, shm);
    }
    TSTAMP(8);
}
__device__ void phase_mixB(CPAR p, int l, unsigned char* shm) {
    const int G = gridDim.x, bid = lt_bid();
    for (int u = bid; u < 256; u += G) { const int bg = (u & 7) * 4 + (u >> 6), r = (u >> 3) & 7;
        ssd_unit(p, l, bg >> 1, (bg & 1) * 8 + r, shm); }
    TSTAMP(9);
}

__device__ __forceinline__ void fin_scales(CPAR p, int row, int lane, float (&sc)[4]) {
    float a0 = 0.f, a1 = 0.f, hh = 0.f, cc = 0.f;
    const float4* s1 = (const float4*)(p.ss_ssd + (size_t)row * 32);
#pragma unroll
    for (int i = 0; i < 4; ++i) { const float4 u = s1[i], v = s1[4 + i]; a0 += u.x + u.y + u.z + u.w; a1 += v.x + v.y + v.z + v.w; }
    { const float4 u = *(const float4*)(p.ss_hg + (size_t)row * 16 + (lane >> 4) * 4); hh = u.x + u.y + u.z + u.w; }
    const float4* s3 = (const float4*)(p.ss_s5 + (size_t)row * 16);
#pragma unroll
    for (int i = 0; i < 4; ++i) { const float4 u = s3[i]; cc += u.x + u.y + u.z + u.w; }
    sc[0] = rsqrtf(a0 * (1.f / 512.f) + EPSN); sc[1] = rsqrtf(a1 * (1.f / 512.f) + EPSN); sc[2] = rsqrtf(hh * (1.f / 128.f) + EPSN); sc[3] = rsqrtf(cc * (1.f / 512.f) + EPSN);
}
__device__ __forceinline__ uint4 scale8(uint4 v, float s) {
    v.x = pk2(bflo(v.x) * s, bfhi(v.x) * s); v.y = pk2(bflo(v.y) * s, bfhi(v.y) * s); v.z = pk2(bflo(v.z) * s, bfhi(v.z) * s); v.w = pk2(bflo(v.w) * s, bfhi(v.w) * s); return v;
}
__device__ void phase_fin(CPAR p) {
    const int tid = lt_tid(), lane = tid & 63, wv = tid >> 6;
    const int rstep = gridDim.x * 8;
    for (int row = lt_bid() * 8 + wv; row < NTOK; row += 2 * rstep) {
        const int row2 = row + rstep; const bool two = row2 < NTOK;
        uint4 va[4], vb[4]; float sa[4], sb[4];
#pragma unroll
        for (int i = 0; i < 4; ++i) { va[i] = *(const uint4*)(p.proj + (size_t)row * LDP + i * 512 + lane * 8); if (two) vb[i] = *(const uint4*)(p.proj + (size_t)row2 * LDP + i * 512 + lane * 8); }
        fin_scales(p, row, lane, sa); if (two) fin_scales(p, row2, lane, sb);
#pragma unroll
        for (int i = 0; i < 4; ++i) { *(uint4*)(p.proj + (size_t)row * LDP + i * 512 + lane * 8) = scale8(va[i], sa[i]); if (two) *(uint4*)(p.proj + (size_t)row2 * LDP + i * 512 + lane * 8) = scale8(vb[i], sb[i]); }
    }
}

__device__ void fill_seg_table(CPAR p, unsigned char* shm) {
    const int tid = lt_tid(), slot = tid >> 8, r = tid & 255;
    pg8::StaticOrder S; S.init(NTOK, 1024, (int)gridDim.x, lt_bid());
    pg8::Unit un; float* rt = (float*)(shm + 131072);
    if (S.next(slot, un)) {
        const size_t row = (size_t)un.pm * 256 + r; float ms[7];
        const float4* s1 = (const float4*)(p.ss_ssd + row * 32); float a0 = 0.f, a1 = 0.f;
#pragma unroll
        for (int i = 0; i < 4; ++i) { const float4 u = s1[i], v = s1[4 + i]; a0 += u.x + u.y + u.z + u.w; a1 += v.x + v.y + v.z + v.w; }
        ms[0] = a0 * (1.f / 512.f); ms[1] = a1 * (1.f / 512.f);
        const float4* s2 = (const float4*)(p.ss_hg + row * 16);
#pragma unroll
        for (int h = 0; h < 4; ++h) { const float4 u = s2[h]; ms[2 + h] = (u.x + u.y + u.z + u.w) * (1.f / 128.f); }
        const float4* s3 = (const float4*)(p.ss_s5 + row * 16); float cc = 0.f;
#pragma unroll
        for (int i = 0; i < 4; ++i) { const float4 u = s3[i]; cc += u.x + u.y + u.z + u.w; }
        ms[6] = cc * (1.f / 512.f);
        float sc[7];
#pragma unroll
        for (int i = 0; i < 7; ++i) sc[i] = rsqrtf(ms[i] + EPSN);
#pragma unroll
        for (int i = 0; i < 6; ++i) rt[(slot * 7 + i) * 256 + r] = sc[i] / sc[i + 1];
        rt[(slot * 7 + 6) * 256 + r] = sc[6];
    }
    __syncthreads();
}

template <class Epi> __device__ __forceinline__ void run_gemm(unsigned char* shm, const pg8::Gemm& g, const Epi& E) {
    pg8::StaticOrder S; S.init(g.M, g.N, (int)gridDim.x, lt_bid());
    pg8::gemm_phase<Epi, pg8::StaticOrder, false>((PG8_LAS unsigned char*)shm, g, S, E, nullptr);
}

__global__ __launch_bounds__(512, 2) void mega(Params p_unused) {
    extern __shared__ __attribute__((aligned(16))) unsigned char shm[];
    __shared__ uint4 xb_words;
    cg::grid_group grid = cg::this_grid();
    if (threadIdx.x == 0) xb_words = make_uint4(0u, 0u, 0u, 0u);
    __syncthreads();
    { CPAR p = *GETP(); (void)xcd_barrier_post(p.bar, (volatile LAS unsigned*)&xb_words); }
#define GSYNC() do { CPAR _q = *GETP(); XcdBarrier _b; _b.bar = _q.bar; _b.x = xb_xcc_id(); _b.st = (volatile LAS unsigned*)&xb_words; xcd_barrier(_b); } while (0)
#if TPROBE >= 0
    if (blockIdx.x == TBLK && threadIdx.x == 0) { CPAR _p = *GETP(); unsigned long long* _w = (unsigned long long*)_p.wdt; _w[0] = wall_clock64(); _w[1] = 0; }
#endif
#pragma unroll 1
    for (int l = 0; l < 4; ++l) {
#if PH & 1
        { CPAR p = *GETP(); phase_prep(p, l, shm); }
#endif
        if (l == 0) grid.sync(); else GSYNC();
        TSTAMP(0);
#if PH & 2
        { CPAR p = *GETP(); pg8::Gemm g{p.xb, p.winT + (size_t)(l & 1) * LDP * DM, NTOK, LDP, DM, DM}; EpiIn e{p.proj, p.rstd}; run_gemm(shm, g, e); }
#endif
        GSYNC(); TSTAMP(1);
#if PH & 4
        { CPAR p = *GETP(); phase_mixA(p, l, shm); }
#endif
        GSYNC(); TSTAMP(2);
#if PH & 4
        { CPAR p = *GETP(); phase_mixB(p, l, shm); }
#endif
#if PH & 8
        { CPAR p = *GETP(); pg8::Gemm g{p.proj + C_U, p.wgluT + (size_t)(l & 1) * 1024 * 512, NTOK, 1024, 512, LDP}; EpiGlu e{p.proj, p.glu_b + l * 1024, p.ss_s5}; run_gemm(shm, g, e); }
#endif
        GSYNC(); TSTAMP(3);
        { CPAR p = *GETP(); fill_seg_table(p, shm); }
        { CPAR p = *GETP(); pg8::Gemm g{p.proj, p.woutT + (size_t)(l & 1) * 1024 * 2048, NTOK, 1024, 2048, LDP}; EpiOutSeg e{p.proj}; run_gemm(shm, g, e); }
        GSYNC(); TSTAMP(5);
    }
#if PH & 1
    { CPAR p = *GETP(); phase_prep(p, 4, shm); }
#endif
#if TPROBE >= 0
    __syncthreads(); TSTAMP(0);
    grid.sync();
    if (blockIdx.x == TBLK && threadIdx.x == 0) { CPAR p = *GETP(); p.out[0] = (float)(((unsigned long long*)p.wdt)[1]) * 0.001f; }
#endif
}

extern "C" void kernel_launch(void* const* d_in, const int* in_sizes, int n_in, void* d_out, int out_size, void* d_ws, size_t ws_size, hipStream_t stream) {
    constexpr size_t kLds = 162816;
    static int grid_blocks = 0;
    if (!grid_blocks) {
        int dev = 0, cus = 0, per_cu = 0;
        hipGetDevice(&dev);
        hipDeviceGetAttribute(&cus, hipDeviceAttributeMultiprocessorCount, dev);
        hipFuncSetAttribute((const void*)mega, hipFuncAttributeMaxDynamicSharedMemorySize, (int)kLds);
        hipOccupancyMaxActiveBlocksPerMultiprocessor(&per_cu, mega, 512, kLds);
        if (per_cu < 1) per_cu = 1;
        grid_blocks = cus * per_cu;
        if (grid_blocks > 256) grid_blocks = 256;
        if (grid_blocks != 256) fprintf(stderr, "this build assumes a 256-workgroup grid (got %d)\n", grid_blocks);
    }
    Params p{};
    const float** f = (const float**)&p;
    for (int i = 0; i < 24; ++i) f[i] = (const float*)d_in[i];
    p.out = (float*)d_out;
    p.bcb = (bf16_t*)d_out;
    unsigned char* w = (unsigned char*)d_ws; size_t off = 0;
    auto take = [&](size_t bytes) { unsigned char* r = w + off; off += (bytes + 255) & ~(size_t)255; return r; };
    p.proj = (bf16_t*)take((size_t)NTOK * LDP * 2);
    p.xb = (bf16_t*)take((size_t)NTOK * DM * 2);
    p.winT = (bf16_t*)take((size_t)2 * LDP * DM * 2);
    p.woutT = (bf16_t*)take((size_t)2 * 1024 * 2048 * 2);
    p.wgluT = (bf16_t*)take((size_t)2 * 1024 * 512 * 2);
    p.ktab = (bf16_t*)take((size_t)2 * 32 * 8192 * 2);
    p.woff = (bf16_t*)take((size_t)2 * 32 * 65536 * 2);
    p.wst = (bf16_t*)take((size_t)2 * 32 * 65536 * 2);
    p.wdt = (float*)take(256);
    p.aT = (float*)take((size_t)2 * 32 * 64 * 2 * 4);
    p.lb = (float*)take((size_t)4 * 512 * 4);
    p.rstd = (float*)take((size_t)NTOK * 4);
    p.dtraw = (float*)take((size_t)NTOK * 16 * 4);
    p.ss_ssd = (float*)take((size_t)NTOK * 32 * 4);
    p.ss_hg = (float*)take((size_t)NTOK * 32 * 4);
    p.ss_s5 = (float*)take((size_t)NTOK * 16 * 4);
    p.bar = (unsigned*)take((size_t)XCD_BAR_WORDS * 4 + 4 * 256);
    p.wq = p.bar + XCD_BAR_WORDS;
    if (off > ws_size) { fprintf(stderr, "workspace too small: need %zu have %zu\n", off, ws_size); return; }
    hipMemsetAsync(p.bar, 0, (size_t)XCD_BAR_WORDS * 4 + 4 * 256, stream);
    void* args[] = {&p};
    hipError_t e = hipLaunchCooperativeKernel((const void*)mega, dim3(grid_blocks), dim3(512), args, kLds, stream);
    if (e != hipSuccess) fprintf(stderr, "cooperative launch failed: %s (grid %d)\n", hipGetErrorString(e), grid_blocks);
}
```
